# Optimizing an MI355X kernel written in HIP

```python
import math
import jax, jax.numpy as jnp
from jax import lax
import numpy as np

D_MODEL = 1024
BATCH = 8
SEQ = 2048
DEPTH = 1

HEAD_DIM = 128
DN_HEADS = D_MODEL // HEAD_DIM
DN_WIDTH = DN_HEADS * HEAD_DIM
POOL_WINDOWS = (2, 4, 8, 16)
POOL_GROUPS = len(POOL_WINDOWS)
POOL_WIDTH = D_MODEL // 2
POOL_GROUP_DIM = POOL_WIDTH // POOL_GROUPS
MEM_LEN = 256
MEM_HEADS = 4
MEM_WIDTH = D_MODEL // 2
MEM_HEAD_DIM = MEM_WIDTH // MEM_HEADS
CONV_WIDTH = 4
CHUNK = 64
N_BRANCH = 3
EPS = 1e-6

IN_SPLITS = (POOL_WIDTH, POOL_WIDTH, DN_WIDTH, DN_WIDTH, DN_WIDTH, DN_HEADS, DN_HEADS,
             DN_WIDTH, MEM_WIDTH, MEM_WIDTH, N_BRANCH * D_MODEL)
IN_WIDTH = int(sum(IN_SPLITS))
IN_OFFSETS = [int(o) for o in np.cumsum(IN_SPLITS)[:-1]]

kernel_name = "hybrid_pool_deltanet_memxattn_gated_merge"


def rms_norm(x, w):
    xf = x.astype(jnp.float32)
    y = xf * lax.rsqrt(jnp.mean(xf * xf, axis=-1, keepdims=True) + EPS)
    return (y * w.astype(jnp.float32)).astype(x.dtype)


def l2norm(x):
    return x * lax.rsqrt(jnp.sum(x * x, axis=-1, keepdims=True) + EPS)


def pool_mixer(u, mix_w, scale):
    B, S, _ = u.shape
    uf = u.astype(jnp.float32)
    c = jnp.cumsum(uf, axis=1)
    t = jnp.arange(1, S + 1, dtype=jnp.float32)[None, :, None]
    outs = []
    for g, w in enumerate(POOL_WINDOWS):
        sl = slice(g * POOL_GROUP_DIM, (g + 1) * POOL_GROUP_DIM)
        cg = c[..., sl]
        prev = jnp.pad(cg, ((0, 0), (w, 0), (0, 0)))[:, :S]
        mean = (cg - prev) / jnp.minimum(t, float(w))
        outs.append(mean - uf[..., sl])
    p = jnp.stack(outs, axis=2).astype(u.dtype)
    m = jnp.einsum('bsgc,gcd->bsgd', p, mix_w).reshape(B, S, POOL_WIDTH)
    return m * scale


def causal_dwconv(x, w):
    K, C = w.shape
    return lax.conv_general_dilated(x, w[:, None, :].astype(x.dtype), window_strides=(1,),
                                    padding=[(K - 1, 0)],
                                    dimension_numbers=('NWC', 'WIO', 'NWC'),
                                    feature_group_count=C)


def gated_delta_rule(q, k, v, g, beta):
    B, S, H, Dk = q.shape
    Dv = v.shape[-1]
    N = S // CHUNK

    def chunks(t):
        return t.reshape(B, N, CHUNK, H, -1).transpose(0, 3, 1, 2, 4)

    q = chunks(l2norm(q) * (Dk ** -0.5))
    k = chunks(l2norm(k))
    v = chunks(v)
    g = g.reshape(B, N, CHUNK, H).transpose(0, 3, 1, 2)
    beta = beta.reshape(B, N, CHUNK, H).transpose(0, 3, 1, 2)
    gc = jnp.cumsum(g, axis=-1)

    tril = jnp.tril(jnp.ones((CHUNK, CHUNK), dtype=bool))
    stril = jnp.tril(jnp.ones((CHUNK, CHUNK), dtype=bool), k=-1)
    diff = gc[..., :, None] - gc[..., None, :]
    decay = jnp.where(tril, jnp.exp(jnp.where(tril, diff, 0.0)), 0.0)

    kb = k * beta[..., None]
    A = jnp.where(stril, jnp.einsum('bhnid,bhnjd->bhnij', kb, k) * decay, 0.0)
    eye = jnp.eye(CHUNK, dtype=A.dtype)
    T = lax.linalg.triangular_solve(eye + A, jnp.broadcast_to(eye, A.shape),
                                    left_side=True, lower=True, unit_diagonal=True)
    u = jnp.einsum('bhnij,bhnjd->bhnid', T, v * beta[..., None])
    w = jnp.einsum('bhnij,bhnjd->bhnid', T, kb * jnp.exp(gc)[..., None])
    a_qk = jnp.where(tril, jnp.einsum('bhnid,bhnjd->bhnij', q, k) * decay, 0.0)
    qg = q * jnp.exp(gc)[..., None]
    kd = k * jnp.exp(gc[..., -1:] - gc)[..., None]
    glast = jnp.exp(gc[..., -1])

    xs = tuple(jnp.moveaxis(t, 2, 0) for t in (u, w, a_qk, qg, kd, glast))

    def step(state, inp):
        u_n, w_n, a_n, qg_n, kd_n, gl_n = inp
        v_new = u_n - jnp.einsum('bhck,bhkv->bhcv', w_n, state)
        o = jnp.einsum('bhck,bhkv->bhcv', qg_n, state) + jnp.einsum('bhcj,bhjv->bhcv', a_n, v_new)
        state = state * gl_n[..., None, None] + jnp.einsum('bhck,bhcv->bhkv', kd_n, v_new)
        return state, o

    s0 = jnp.zeros((B, H, Dk, Dv), dtype=jnp.float32)
    _, o = lax.scan(step, s0, xs)
    return o.transpose(1, 0, 3, 2, 4).reshape(B, S, H, Dv)


def memory_attention(qm, mem_n, w_kv):
    B, S, _ = qm.shape
    kv = mem_n @ w_kv
    km, vm = jnp.split(kv, 2, axis=-1)
    q = qm.reshape(B, S, MEM_HEADS, MEM_HEAD_DIM)
    km = km.reshape(B, -1, MEM_HEADS, MEM_HEAD_DIM)
    vm = vm.reshape(B, -1, MEM_HEADS, MEM_HEAD_DIM)
    s = jnp.einsum('bshd,bmhd->bhsm', q, km).astype(jnp.float32) * (MEM_HEAD_DIM ** -0.5)
    p = jax.nn.softmax(s, axis=-1).astype(vm.dtype)
    return jnp.einsum('bhsm,bmhd->bshd', p, vm).reshape(B, S, MEM_WIDTH)


def hybrid_layer(x, mem, pre_norm_w, mem_norm_w, w_in, conv_w, a_log, dt_bias, dn_norm_w,
                 pool_mix_w, pool_scale, w_mem_kv, w_proj_pool, w_proj_delta, w_proj_mem,
                 w_out, post_norm_w):
    B, S, D = x.shape
    h = rms_norm(x, pre_norm_w)
    proj = h @ w_in
    (xa, za, qd, kd, vd, a_raw, b_raw, zd, qm, zm, gate_raw) = jnp.split(proj, IN_OFFSETS, axis=-1)

    ya = pool_mixer(xa, pool_mix_w, pool_scale) * jax.nn.silu(za)

    qkv = jax.nn.silu(causal_dwconv(jnp.concatenate([qd, kd, vd], axis=-1), conv_w))
    qd, kd, vd = jnp.split(qkv, 3, axis=-1)
    shp = (B, S, DN_HEADS, HEAD_DIM)
    g = -jnp.exp(a_log.astype(jnp.float32)) * jax.nn.softplus(
        a_raw.astype(jnp.float32) + dt_bias.astype(jnp.float32))
    beta = jax.nn.sigmoid(b_raw.astype(jnp.float32))
    o = gated_delta_rule(qd.reshape(shp).astype(jnp.float32), kd.reshape(shp).astype(jnp.float32),
                         vd.reshape(shp).astype(jnp.float32), g, beta)
    yb = rms_norm(o, dn_norm_w).reshape(B, S, DN_WIDTH).astype(x.dtype) * jax.nn.silu(zd)

    yc = memory_attention(qm, rms_norm(mem, mem_norm_w), w_mem_kv) * jax.nn.silu(zm)

    gates = jax.nn.sigmoid(gate_raw).reshape(B, S, N_BRANCH, D)
    y = (gates[:, :, 0] * (ya @ w_proj_pool)
         + gates[:, :, 1] * (yb @ w_proj_delta)
         + gates[:, :, 2] * (yc @ w_proj_mem))
    out = y @ w_out
    return x + rms_norm(out, post_norm_w)


def setup_inputs(seed: int = 0) -> dict:
    key = jax.random.key(seed)
    ks = jax.random.split(key, 20)
    L, D = DEPTH, D_MODEL
    f32 = jnp.float32

    def nrm(k, shape, fan_in):
        return jax.random.normal(k, shape, f32) * (fan_in ** -0.5)

    dt = jnp.exp(jax.random.uniform(ks[8], (L, DN_HEADS), f32, math.log(1e-3), math.log(1e-1)))
    return {
        "x": jax.random.normal(ks[0], (BATCH, SEQ, D), f32),
        "mem": jax.random.normal(ks[1], (BATCH, MEM_LEN, D), f32),
        "pre_norm_w": 1.0 + 0.05 * jax.random.normal(ks[2], (L, D), f32),
        "mem_norm_w": 1.0 + 0.05 * jax.random.normal(ks[3], (L, D), f32),
        "w_in": nrm(ks[4], (L, D, IN_WIDTH), D),
        "conv_w": nrm(ks[5], (L, CONV_WIDTH, 3 * DN_WIDTH), CONV_WIDTH),
        "a_log": jnp.log(jax.random.uniform(ks[6], (L, DN_HEADS), f32, 1.0, 16.0)),
        "dt_bias": dt + jnp.log(-jnp.expm1(-dt)),
        "dn_norm_w": 1.0 + 0.05 * jax.random.normal(ks[7], (L, HEAD_DIM), f32),
        "pool_mix_w": nrm(ks[9], (L, POOL_GROUPS, POOL_GROUP_DIM, POOL_GROUP_DIM), POOL_GROUP_DIM),
        "pool_scale": 1.0 + 0.1 * jax.random.normal(ks[10], (L, POOL_WIDTH), f32),
        "w_mem_kv": nrm(ks[11], (L, D, 2 * MEM_WIDTH), D),
        "w_proj_pool": nrm(ks[12], (L, POOL_WIDTH, D), POOL_WIDTH),
        "w_proj_delta": nrm(ks[13], (L, DN_WIDTH, D), DN_WIDTH),
        "w_proj_mem": nrm(ks[14], (L, MEM_WIDTH, D), MEM_WIDTH),
        "w_out": nrm(ks[15], (L, D, D), D),
        "post_norm_w": 1.0 + 0.05 * jax.random.normal(ks[16], (L, D), f32),
    }


def reference(x, mem, pre_norm_w, mem_norm_w, w_in, conv_w, a_log, dt_bias, dn_norm_w,
              pool_mix_w, pool_scale, w_mem_kv, w_proj_pool, w_proj_delta, w_proj_mem,
              w_out, post_norm_w):
    for l in range(DEPTH):
        x = hybrid_layer(x, mem, pre_norm_w[l], mem_norm_w[l], w_in[l], conv_w[l], a_log[l],
                         dt_bias[l], dn_norm_w[l], pool_mix_w[l], pool_scale[l], w_mem_kv[l],
                         w_proj_pool[l], w_proj_delta[l], w_proj_mem[l], w_out[l], post_norm_w[l])
    return x
```

```cpp
#include <hip/hip_runtime.h>
#include <hip/hip_cooperative_groups.h>
#include <cstdio>
#include <cstdint>
namespace cg = cooperative_groups;

#ifndef MK_PER_PHASE
#define MK_PER_PHASE 0
#endif

#define LAS __attribute__((address_space(3)))
typedef unsigned short bf16_t;
typedef short bf16x8 __attribute__((ext_vector_type(8)));
typedef float f32x4 __attribute__((ext_vector_type(4)));
typedef unsigned u32x4 __attribute__((ext_vector_type(4)));
typedef unsigned u32x2 __attribute__((ext_vector_type(2)));

constexpr int DM = 1024, NB = 8, SEQ = 2048, M = NB * SEQ, INW = 9232, MEML = 256;
constexpr float EPS = 1e-6f;
constexpr size_t MiB = 1u << 20;
constexpr size_t WS_WT = 0;
constexpr size_t WS_WKV = 18 * MiB;
constexpr size_t WS_WP = 20 * MiB;
constexpr size_t WS_WD = 21 * MiB;
constexpr size_t WS_WM = 23 * MiB;
constexpr size_t WS_WOUT = 24 * MiB;
constexpr size_t WS_WMIX = 26 * MiB;
constexpr size_t WS_G = 26 * MiB + 256 * 1024;
constexpr size_t WS_BETA = WS_G + 512 * 1024;
constexpr size_t WS_ROWSS = WS_BETA + 512 * 1024;
constexpr size_t WS_GL = WS_ROWSS + 64 * 1024;
constexpr size_t WS_SUMSQ = 27 * MiB + 384 * 1024;
constexpr size_t WS_H = 28 * MiB;
constexpr size_t WS_MEMN = 60 * MiB;
constexpr size_t WS_KMEM = 64 * MiB;
constexpr size_t WS_VMEMT = 66 * MiB;
constexpr size_t WS_XA = 68 * MiB;
constexpr size_t WS_QM = 84 * MiB;
constexpr size_t WS_QKV = 100 * MiB;
constexpr size_t WS_HALO = 196 * MiB;
constexpr size_t WS_U = 201 * MiB;
constexpr size_t WS_AQK = 233 * MiB;
constexpr size_t WS_CTL = 250 * MiB;
constexpr size_t WS_END = 251 * MiB;
constexpr size_t WS_Y = WS_XA;
constexpr size_t WS_GATE = WS_QKV;
constexpr int LDS_BYTES = 147456;

__device__ __forceinline__ unsigned f2bf(float f) { unsigned u = __float_as_uint(f); return (u + 0x7fffu + ((u >> 16) & 1u)) >> 16; }
typedef __bf16 bf16x2_t __attribute__((ext_vector_type(2)));
typedef float f32x2_t __attribute__((ext_vector_type(2)));
__device__ __forceinline__ unsigned pk2(float lo, float hi) { f32x2_t v = {lo, hi}; bf16x2_t b = __builtin_convertvector(v, bf16x2_t); return __builtin_bit_cast(unsigned, b); }
__device__ __forceinline__ float bflo(unsigned u) { return __uint_as_float(u << 16); }
__device__ __forceinline__ float bfhi(unsigned u) { return __uint_as_float(u & 0xffff0000u); }
__device__ __forceinline__ unsigned cvt_pk_bf16(float lo, float hi) { unsigned r; asm volatile("v_cvt_pk_bf16_f32 %0, %1, %2" : "=v"(r) : "v"(lo), "v"(hi)); return r; }
__device__ __forceinline__ float silu_f(float z) { return z * __builtin_amdgcn_rcpf(1.f + __expf(-z)); }
__device__ __forceinline__ float sigm_f(float z) { return __builtin_amdgcn_rcpf(1.f + __expf(-z)); }
#define LDS_WAIT() asm volatile("s_waitcnt lgkmcnt(0)" ::: "memory")
#define MFMA16(a, b, c) __builtin_amdgcn_mfma_f32_16x16x32_bf16((a), (b), (c), 0, 0, 0)

namespace pg8 {
constexpr int BM = 256, BK = 64, HALF = 128, HTB = HALF * BK * 2, STAGE_BYTES = 8 * HTB, NXCD = 8, WGM = 8;
__host__ __device__ __forceinline__ int lds_byte(int r, int c) { const int st = (r >> 4) * 2 + (c >> 5), rr = r & 15, cc = c & 31, ob = rr * 64 + cc * 2; return st * 1024 + (ob ^ (((ob >> 9) & 1) << 5)); }
__host__ __device__ __forceinline__ void stage_rc(int b, int& R, int& C) { const int st = b / 1024, sb = b % 1024, swz = sb ^ (((sb >> 9) & 1) << 5); R = (st >> 1) * 16 + swz / 64; C = (st & 1) * 32 + (swz % 64) / 2; }
__host__ __device__ __forceinline__ int perm32(int rho) { const int n = rho >> 4, i = rho & 15; return 8 * (i >> 2) + 4 * n + (i & 3); }
struct Unit { int pm, pn; };
struct Gemm { const bf16_t* A; const bf16_t* Bt; int lda, ldb, K; };
struct StaticOrder {
    int nM, nN, nwg, G, c;
    __device__ void init(int Mr, int Nc, int G_, int c_) { nM = Mr / BM; nN = Nc / BM; nwg = nM * nN; G = G_; c = c_; }
    __device__ bool next(int i, Unit& u) const {
        const long L = (long)i * G + c; if (L >= nwg) return false;
        int wgid = (int)L; { const int q = nwg / NXCD, r = nwg % NXCD, xcd = wgid % NXCD, off = wgid / NXCD; wgid = (xcd < r ? xcd * (q + 1) : r * (q + 1) + (xcd - r) * q) + off; }
        const int nig = WGM * nN, gid = wgid / nig, fm = gid * WGM, gsz = (nM - fm) < WGM ? (nM - fm) : WGM;
        u.pm = fm + ((wgid % nig) % gsz); u.pn = (wgid % nig) / gsz; return true;
    }
};
struct OneUnit {
    Unit u;
    __device__ bool next(int i, Unit& o) const { if (i) return false; o = u; return true; }
};

template <class Epi, class Sched>
__device__ __forceinline__ void gemm_phase(LAS unsigned char* lds, const Gemm g, const Sched& S, const Epi& E) {
    int tid_ = threadIdx.x; asm volatile("" : "+v"(tid_));
    const int tid = tid_, wid = __builtin_amdgcn_readfirstlane(tid >> 6), lane = tid & 63, wr = wid >> 2, wc = wid & 3, fr = lane & 15, fq = lane >> 4;
    const int K = g.K, nt = K / BK;
    unsigned voffA[2], voffB[2];
#pragma unroll
    for (int i = 0; i < 2; ++i) { int R, C; stage_rc(tid * 16 + i * 8192, R, C); const int Rb = (R & ~31) + perm32(R & 31);
        voffA[i] = (unsigned)(R * g.lda + C) * 2u; voffB[i] = (unsigned)(Rb * g.ldb + C) * 2u; }
    const size_t kstep = (size_t)(BK * 2);
    const size_t hstepA = (size_t)HALF * g.lda * 2, hstepB = (size_t)HALF * g.ldb * 2;
    const size_t tstepA = 2 * hstepA, tstepB = 2 * hstepB;
    const unsigned ldsw = (unsigned)wid * 1024u;
    const int aoff = lds_byte(wr * 64 + fr, fq * 8), boff = lds_byte(wc * 32 + fr, fq * 8);
#define PG8_SA(b, h) (((b) * 2 + (h)) * HTB)
#define PG8_SB(b, h) ((4 + (b) * 2 + (h)) * HTB)
#define PG8_STAGE(bufoff, gbase, voff) do { _Pragma("unroll") for (int _i = 0; _i < 2; ++_i) \
        __builtin_amdgcn_global_load_lds((const unsigned*)((const char*)(gbase) + (voff)[_i]), (LAS unsigned*)(lds + (bufoff) + ldsw + _i * 8192), 16, 0, 0); } while (0)
#define PG8_LDA(dst, b, h) do { _Pragma("unroll") for (int m = 0; m < 4; ++m) _Pragma("unroll") for (int k = 0; k < 2; ++k) dst[m][k] = *(const LAS bf16x8*)(lds + PG8_SA(b, h) + aoff + m * 2048 + k * 1024); } while (0)
#define PG8_LDB(dst, b, h) do { _Pragma("unroll") for (int n = 0; n < 2; ++n) _Pragma("unroll") for (int k = 0; k < 2; ++k) dst[n][k] = *(const LAS bf16x8*)(lds + PG8_SB(b, h) + boff + n * 2048 + k * 1024); } while (0)
#define PG8_MMA(ai, bj, At, Bt) do { __builtin_amdgcn_s_setprio(1); _Pragma("unroll") for (int m = 0; m < 4; ++m) _Pragma("unroll") for (int n = 0; n < 2; ++n) _Pragma("unroll") for (int k = 0; k < 2; ++k) \
        acc[ai][bj][m][n] = __builtin_amdgcn_mfma_f32_16x16x32_bf16(Bt[n][k], At[m][k], acc[ai][bj][m][n], 0, 0, 0); __builtin_amdgcn_s_setprio(0); } while (0)
#define PG8_WAIT_V(n) asm volatile("s_waitcnt vmcnt(" #n ")" ::: "memory")
#define PG8_WAIT_L(n) asm volatile("s_waitcnt lgkmcnt(" #n ")" ::: "memory")
#define PG8_BAR __builtin_amdgcn_s_barrier()
#define PG8_SCHED __builtin_amdgcn_sched_barrier(0)
    Unit cur, nxt; int ui = 0;
    if (!S.next(0, cur)) return;
    f32x4 acc[2][2][4][2];
#pragma unroll
    for (int a = 0; a < 2; ++a)
#pragma unroll
        for (int b = 0; b < 2; ++b)
#pragma unroll
            for (int m = 0; m < 4; ++m)
#pragma unroll
                for (int n = 0; n < 2; ++n) acc[a][b][m][n] = (f32x4){0.f, 0.f, 0.f, 0.f};
    bf16x8 At[4][2], B0[2][2], B1[2][2];
    const char* cA = (const char*)g.A + (size_t)cur.pm * tstepA; const char* cB = (const char*)g.Bt + (size_t)cur.pn * tstepB;
    {
        PG8_STAGE(PG8_SB(0, 0), cB, voffB); PG8_STAGE(PG8_SB(0, 1), cB + hstepB, voffB); PG8_STAGE(PG8_SA(0, 0), cA, voffA); PG8_STAGE(PG8_SA(0, 1), cA + hstepA, voffA);
        if (wr == 1) PG8_BAR;
        PG8_WAIT_V(2); PG8_BAR;
        PG8_STAGE(PG8_SB(1, 0), cB + kstep, voffB); PG8_STAGE(PG8_SA(1, 0), cA + kstep, voffA); PG8_STAGE(PG8_SB(1, 1), cB + hstepB + kstep, voffB);
        PG8_WAIT_V(6); PG8_BAR;
    }
    for (;;) {
        const bool has_next = S.next(ui + 1, nxt);
        const char* nA = has_next ? (const char*)g.A + (size_t)nxt.pm * tstepA : cA; const char* nB = has_next ? (const char*)g.Bt + (size_t)nxt.pn * tstepB : cB;
        for (int t = 0; t < nt; t += 2) {
            const bool last = (t == nt - 2);
            const char* a1 = cA + (size_t)(t + 1) * kstep;
            const char* a2 = last ? nA : cA + (size_t)(t + 2) * kstep; const char* b2 = last ? nB : cB + (size_t)(t + 2) * kstep;
            const char* a3 = a2 + kstep; const char* b3 = b2 + kstep;
            PG8_LDB(B0, 0, 0); PG8_LDB(B1, 0, 1); PG8_SCHED; PG8_LDA(At, 0, 0); PG8_STAGE(PG8_SA(1, 1), a1 + hstepA, voffA);
            PG8_WAIT_V(8); PG8_WAIT_L(0); PG8_BAR; PG8_MMA(0, 0, At, B0); PG8_MMA(0, 1, At, B1); PG8_BAR; PG8_SCHED;
            PG8_LDA(At, 0, 1); PG8_STAGE(PG8_SB(0, 0), b2, voffB); PG8_STAGE(PG8_SB(0, 1), b2 + hstepB, voffB); PG8_STAGE(PG8_SA(0, 0), a2, voffA);
            PG8_WAIT_V(8); PG8_WAIT_L(0); PG8_BAR; PG8_MMA(1, 0, At, B0); PG8_MMA(1, 1, At, B1); PG8_BAR; PG8_SCHED;
            PG8_LDB(B0, 1, 0); PG8_LDB(B1, 1, 1); PG8_SCHED; PG8_LDA(At, 1, 0); PG8_STAGE(PG8_SA(0, 1), a2 + hstepA, voffA);
            PG8_WAIT_V(8); PG8_WAIT_L(0); PG8_BAR; PG8_MMA(0, 0, At, B0); PG8_MMA(0, 1, At, B1); PG8_BAR; PG8_SCHED;
            PG8_LDA(At, 1, 1); PG8_STAGE(PG8_SB(1, 0), b3, voffB); PG8_STAGE(PG8_SB(1, 1), b3 + hstepB, voffB); PG8_STAGE(PG8_SA(1, 0), a3, voffA);
            PG8_WAIT_V(8); PG8_WAIT_L(0); PG8_BAR; PG8_MMA(1, 0, At, B0); PG8_MMA(1, 1, At, B1); PG8_BAR; PG8_SCHED;
        }
        if (wr == 0) PG8_BAR;
        E(acc, cur, wr, wc, fr, fq);
        if (!has_next) break;
#pragma unroll
        for (int a = 0; a < 2; ++a)
#pragma unroll
            for (int b = 0; b < 2; ++b)
#pragma unroll
                for (int m = 0; m < 4; ++m)
#pragma unroll
                    for (int n = 0; n < 2; ++n) acc[a][b][m][n] = (f32x4){0.f, 0.f, 0.f, 0.f};
        cur = nxt; cA = nA; cB = nB; ++ui;
        if (wr == 1) PG8_BAR;
    }
    PG8_WAIT_V(0);
    PG8_BAR;
#undef PG8_SA
#undef PG8_SB
#undef PG8_STAGE
#undef PG8_LDA
#undef PG8_LDB
#undef PG8_MMA
#undef PG8_WAIT_V
#undef PG8_WAIT_L
#undef PG8_BAR
#undef PG8_SCHED
}

typedef const f32x4 (&AccRef)[2][2][4][2];
__device__ __forceinline__ u32x4 pack8(f32x4 v0, f32x4 v1) { u32x4 w; w.x = pk2(v0[0], v0[1]); w.y = pk2(v0[2], v0[3]); w.z = pk2(v1[0], v1[1]); w.w = pk2(v1[2], v1[3]); return w; }

struct EpiPlain {
    bf16_t* O; int ldc;
    __device__ __forceinline__ void operator()(AccRef acc, const Unit& u, int wr, int wc, int fr, int fq) const {
        const int row0 = u.pm * BM + wr * 64 + fr, col0 = u.pn * BM + wc * 32 + 8 * fq;
#pragma unroll
        for (int ai = 0; ai < 2; ++ai)
#pragma unroll
            for (int m = 0; m < 4; ++m) { bf16_t* rowp = O + (size_t)(row0 + ai * HALF + m * 16) * ldc + col0;
#pragma unroll
                for (int bj = 0; bj < 2; ++bj) *(u32x4*)(rowp + bj * HALF) = pack8(acc[ai][bj][m][0], acc[ai][bj][m][1]); }
    }
};
struct EpiStage1 {
    bf16_t *xa, *qm, *qkv, *halo;
    __device__ __forceinline__ void operator()(AccRef acc, const Unit& u, int wr, int wc, int fr, int fq) const {
        const int pn = u.pn; bf16_t* base; int ldc, colt;
        if (pn < 2) { base = xa; ldc = 512; colt = pn * 256; }
        else if (pn < 4) { base = qm; ldc = 512; colt = (pn - 2) * 256; }
        else { const int t = (pn - 4) >> 2; base = qkv + (size_t)t * M * 1024; ldc = 1024; colt = ((pn - 4) & 3) * 256; }
        const int row0 = u.pm * BM + wr * 64 + fr, col0 = colt + wc * 32 + 8 * fq;
#pragma unroll
        for (int ai = 0; ai < 2; ++ai)
#pragma unroll
            for (int m = 0; m < 4; ++m) { const int row = row0 + ai * HALF + m * 16; bf16_t* rowp = base + (size_t)row * ldc + col0;
#pragma unroll
                for (int bj = 0; bj < 2; ++bj) { const u32x4 w = pack8(acc[ai][bj][m][0], acc[ai][bj][m][1]);
                    *(u32x4*)(rowp + bj * HALF) = w;
                    if (m == 3 && pn >= 4 && fr >= 13) *(u32x4*)(halo + ((size_t)(row >> 6) * 3 + (fr - 13)) * 3072 + (pn - 4) * 256 + bj * HALF + wc * 32 + 8 * fq) = w; } }
    }
};
struct EpiZ {
    bf16_t* Y; const float* SUMSQ;
    __device__ __forceinline__ void operator()(AccRef acc, const Unit& u, int wr, int wc, int fr, int fq) const {
        int tid = threadIdx.x; asm volatile("" : "+v"(tid)); fr = tid & 15; fq = (tid >> 4) & 3;
        const int row0 = u.pm * BM + wr * 64 + fr, col0 = u.pn * BM + wc * 32 + 8 * fq;
        const bool isdn = (col0 >= 512) && (col0 < 1536); const int hd = isdn ? ((col0 - 512) >> 7) : 0;
#pragma unroll
        for (int ai = 0; ai < 2; ++ai)
#pragma unroll
            for (int mh = 0; mh < 2; ++mh) {
                u32x4 o[2][2]; float sq[2][2];
#pragma unroll
                for (int mm = 0; mm < 2; ++mm)
#pragma unroll
                    for (int bj = 0; bj < 2; ++bj) { const size_t row = (size_t)(row0 + ai * HALF + (2 * mh + mm) * 16);
                        o[mm][bj] = *(const u32x4*)(Y + row * 2048 + col0 + bj * HALF); sq[mm][bj] = SUMSQ[row * 8 + (isdn ? hd + bj : 0)]; }
#pragma unroll
                for (int mm = 0; mm < 2; ++mm)
#pragma unroll
                    for (int bj = 0; bj < 2; ++bj) { const int m = 2 * mh + mm; const size_t row = (size_t)(row0 + ai * HALF + m * 16);
                        const f32x4 a0 = acc[ai][bj][m][0], a1 = acc[ai][bj][m][1]; const u32x4 ov = o[mm][bj];
                        const float fac = isdn ? (1.0f / sqrtf(sq[mm][bj] * (1.f / 128.f) + EPS)) : 1.f;
                        f32x4 v0, v1;
                        v0[0] = bflo(ov.x) * silu_f(a0[0]); v0[1] = bfhi(ov.x) * silu_f(a0[1]); v0[2] = bflo(ov.y) * silu_f(a0[2]); v0[3] = bfhi(ov.y) * silu_f(a0[3]);
                        v1[0] = bflo(ov.z) * silu_f(a1[0]); v1[1] = bfhi(ov.z) * silu_f(a1[1]); v1[2] = bflo(ov.w) * silu_f(a1[2]); v1[3] = bfhi(ov.w) * silu_f(a1[3]);
                        *(u32x4*)(Y + row * 2048 + col0 + bj * HALF) = pack8(v0 * fac, v1 * fac); }
                asm volatile("" ::: "memory"); __builtin_amdgcn_sched_barrier(0);
            }
    }
};
struct EpiGate {
    bf16_t* GATE;
    __device__ __forceinline__ void operator()(AccRef acc, const Unit& u, int wr, int wc, int fr, int fq) const {
        int tid = threadIdx.x; asm volatile("" : "+v"(tid)); fr = tid & 15; fq = (tid >> 4) & 3;
        const int row0 = u.pm * BM + wr * 64 + fr, col0 = u.pn * BM + wc * 32 + 8 * fq;
#pragma unroll
        for (int ai = 0; ai < 2; ++ai)
#pragma unroll
            for (int m = 0; m < 4; ++m) { bf16_t* rowp = GATE + (size_t)(row0 + ai * HALF + m * 16) * 3072 + col0;
#pragma unroll
                for (int bj = 0; bj < 2; ++bj) { const f32x4 a0 = acc[ai][bj][m][0], a1 = acc[ai][bj][m][1]; f32x4 v0, v1;
#pragma unroll
                    for (int e = 0; e < 4; ++e) { v0[e] = sigm_f(a0[e]); v1[e] = sigm_f(a1[e]); }
                    *(u32x4*)(rowp + bj * HALF) = pack8(v0, v1); } }
    }
};
template <int BR> struct EpiProj {
    const bf16_t* GATE; bf16_t* Y;
    __device__ __forceinline__ void operator()(AccRef acc, const Unit& u, int wr, int wc, int fr, int fq) const {
        int tid = threadIdx.x; asm volatile("" : "+v"(tid)); fr = tid & 15; fq = (tid >> 4) & 3;
        const int row0 = u.pm * BM + wr * 64 + fr, col0 = u.pn * BM + wc * 32 + 8 * fq;
#pragma unroll
        for (int ai = 0; ai < 2; ++ai)
#pragma unroll
            for (int mh = 0; mh < 2; ++mh) {
                u32x4 gq[2][2], yo[2][2];
#pragma unroll
                for (int mm = 0; mm < 2; ++mm)
#pragma unroll
                    for (int bj = 0; bj < 2; ++bj) { const size_t row = (size_t)(row0 + ai * HALF + (2 * mh + mm) * 16);
                        gq[mm][bj] = *(const u32x4*)(GATE + row * 3072 + BR * 1024 + col0 + bj * HALF);
                        if (BR > 0) yo[mm][bj] = *(const u32x4*)(Y + row * 1024 + col0 + bj * HALF); }
#pragma unroll
                for (int mm = 0; mm < 2; ++mm)
#pragma unroll
                    for (int bj = 0; bj < 2; ++bj) { const int m = 2 * mh + mm; const size_t row = (size_t)(row0 + ai * HALF + m * 16);
                        const f32x4 a0 = acc[ai][bj][m][0], a1 = acc[ai][bj][m][1]; const u32x4 g4 = gq[mm][bj];
                        f32x4 v0, v1;
                        v0[0] = bflo(g4.x) * a0[0]; v0[1] = bfhi(g4.x) * a0[1]; v0[2] = bflo(g4.y) * a0[2]; v0[3] = bfhi(g4.y) * a0[3];
                        v1[0] = bflo(g4.z) * a1[0]; v1[1] = bfhi(g4.z) * a1[1]; v1[2] = bflo(g4.w) * a1[2]; v1[3] = bfhi(g4.w) * a1[3];
                        if (BR > 0) { const u32x4 y4 = yo[mm][bj];
                            v0[0] += bflo(y4.x); v0[1] += bfhi(y4.x); v0[2] += bflo(y4.y); v0[3] += bfhi(y4.y); v1[0] += bflo(y4.z); v1[1] += bfhi(y4.z); v1[2] += bflo(y4.w); v1[3] += bfhi(y4.w); }
                        *(u32x4*)(Y + row * 1024 + col0 + bj * HALF) = pack8(v0, v1); }
                asm volatile("" ::: "memory"); __builtin_amdgcn_sched_barrier(0);
            }
    }
};
struct EpiOutNorm {
    float* O; const float* X; const float* PW; float* rowss; unsigned* cnt;
    __device__ __forceinline__ void operator()(AccRef acc, const Unit& u, int wr, int wc, int fr, int fq) const {
        int tid = threadIdx.x; asm volatile("" : "+v"(tid)); fr = tid & 15; fq = (tid >> 4) & 3;
        const int row0 = u.pm * BM + wr * 64 + fr, col0 = u.pn * BM + wc * 32 + 8 * fq;
#pragma unroll
        for (int ai = 0; ai < 2; ++ai)
#pragma unroll
            for (int m = 0; m < 4; ++m) { const int row = row0 + ai * HALF + m * 16; float ss = 0.f;
#pragma unroll
                for (int bj = 0; bj < 2; ++bj) { const f32x4 a0 = acc[ai][bj][m][0], a1 = acc[ai][bj][m][1];
                    ss += (a0[0] * a0[0] + a0[1] * a0[1]) + (a0[2] * a0[2] + a0[3] * a0[3]) + (a1[0] * a1[0] + a1[1] * a1[1]) + (a1[2] * a1[2] + a1[3] * a1[3]); }
                ss += __shfl_xor(ss, 16); ss += __shfl_xor(ss, 32);
                if (fq == 0) atomicAdd(rowss + row, ss); }
        asm volatile("s_waitcnt vmcnt(0)" ::: "memory");
        __syncthreads();
        if (threadIdx.x == 0) {
            __builtin_amdgcn_fence(__ATOMIC_RELEASE, "agent");
            asm volatile("s_waitcnt vmcnt(0)" ::: "memory");
            __hip_atomic_fetch_add(cnt + u.pm * 16, 1u, __ATOMIC_RELAXED, __HIP_MEMORY_SCOPE_AGENT);
            unsigned sp = 0;
            while (__hip_atomic_load(cnt + u.pm * 16, __ATOMIC_RELAXED, __HIP_MEMORY_SCOPE_AGENT) < 4u) { __builtin_amdgcn_s_sleep(1); if (++sp > (1u << 20)) break; }
            __builtin_amdgcn_fence(__ATOMIC_ACQUIRE, "agent");
            asm volatile("s_waitcnt vmcnt(0)" ::: "memory");
        }
        __syncthreads();
#pragma unroll
        for (int ai = 0; ai < 2; ++ai)
#pragma unroll
            for (int m = 0; m < 4; ++m) { const int row = row0 + ai * HALF + m * 16;
                const float rs = 1.0f / sqrtf(__hip_atomic_load(rowss + row, __ATOMIC_RELAXED, __HIP_MEMORY_SCOPE_AGENT) * (1.f / 1024.f) + EPS);
                f32x4 xv[2][2];
#pragma unroll
                for (int bj = 0; bj < 2; ++bj) { const size_t off = (size_t)row * 1024 + col0 + bj * HALF; xv[bj][0] = *(const f32x4*)(X + off); xv[bj][1] = *(const f32x4*)(X + off + 4); }
#pragma unroll
                for (int bj = 0; bj < 2; ++bj) { const size_t off = (size_t)row * 1024 + col0 + bj * HALF;
                    const f32x4 w0 = *(const f32x4*)(PW + col0 + bj * HALF), w1 = *(const f32x4*)(PW + col0 + bj * HALF + 4);
                    *(f32x4*)(O + off) = xv[bj][0] + acc[ai][bj][m][0] * rs * w0; *(f32x4*)(O + off + 4) = xv[bj][1] + acc[ai][bj][m][1] * rs * w1; }
                if (m & 1) { asm volatile("" ::: "memory"); __builtin_amdgcn_sched_barrier(0); } }
    }
};
}

#define XB_TMO      128
#define XB_XCNT(j)  (256  + 64 * (j))
#define XB_XSUB(j)  (1280 + 64 * (j))
#define XB_XGEN(j)  (2304 + 64 * (j))
#define XB_TOP      3328
#define XB_TOPGEN   3392
#define XCD_BAR_WORDS 3456
#define XB_SPIN_CAP (1u << 18)

__device__ __forceinline__ unsigned xb_ld(unsigned* p)              { return __hip_atomic_load(p, __ATOMIC_RELAXED, __HIP_MEMORY_SCOPE_AGENT); }
__device__ __forceinline__ unsigned xb_add(unsigned* p, unsigned v) { return __hip_atomic_fetch_add(p, v, __ATOMIC_RELAXED, __HIP_MEMORY_SCOPE_AGENT); }
__device__ __forceinline__ unsigned xb_xcc_id() { return (unsigned)__builtin_amdgcn_s_getreg((3 << 11) | 20) & 0xFu; }
#define XB_SPIN(cond, bar) do { unsigned _sp = 0; while (cond) { __builtin_amdgcn_s_sleep(1); \
    if ((++_sp & 255u) == 0u) { if (xb_ld(&(bar)[XB_TMO])) break; if (_sp > XB_SPIN_CAP) { atomicAdd(&(bar)[XB_TMO], 1u); break; } } } } while (0)

struct XcdBarrier {
    unsigned* bar; unsigned x;
    volatile LAS unsigned* st;
};

__device__ __forceinline__ XcdBarrier xcd_barrier_post(unsigned* bar, volatile LAS unsigned* st) {
    XcdBarrier b; b.bar = bar; b.x = xb_xcc_id(); b.st = st;
    if (threadIdx.x == 0) (void)xb_add(&bar[XB_XCNT(b.x)], 1u);
    return b;
}
__device__ __forceinline__ void xcd_barrier_complete(unsigned* bar, unsigned x, unsigned& nloc, unsigned& nx) {
    const unsigned G = gridDim.x * gridDim.y * gridDim.z;
    unsigned sum, cnt, mine, sp = 0u;
    for (;;) {
        sum = 0u; cnt = 0u; mine = 0u;
#pragma unroll
        for (unsigned j = 0; j < 16; ++j) { const unsigned c = xb_ld(&bar[XB_XCNT(j)]); sum += c; cnt += (c > 0u) ? 1u : 0u; mine = (j == x) ? c : mine; }
        if (sum == G) break;
        __builtin_amdgcn_s_sleep(1);
        if ((++sp & 255u) == 0u) { if (xb_ld(&bar[XB_TMO])) break; if (sp > XB_SPIN_CAP) { atomicAdd(&bar[XB_TMO], 1u); break; } }
    }
    nloc = mine > 0u ? mine : 1u; nx = cnt > 0u ? cnt : 1u;
}

__device__ __forceinline__ void xcd_barrier(const XcdBarrier& b) {
    asm volatile("s_waitcnt vmcnt(0)" ::: "memory");
    __syncthreads();
    if (threadIdx.x == 0) {
        unsigned* bar = b.bar;
        __builtin_amdgcn_s_waitcnt(0);
        unsigned nloc = b.st[0], nx = b.st[1];
        if (nloc == 0u) { xcd_barrier_complete(bar, b.x, nloc, nx); b.st[0] = nloc; b.st[1] = nx; }
        const unsigned old = xb_add(&bar[XB_XSUB(b.x)], 1u);
        const unsigned gen = old / nloc;
        if (old + 1u == (gen + 1u) * nloc) {
            __builtin_amdgcn_fence(__ATOMIC_RELEASE, "agent");
            asm volatile("s_waitcnt vmcnt(0)" ::: "memory");
            const unsigned og = xb_add(&bar[XB_TOP], 1u);
            const unsigned tg = og / nx;
            if (og + 1u == (tg + 1u) * nx) xb_add(&bar[XB_TOPGEN], 1u);
            else XB_SPIN(xb_ld(&bar[XB_TOPGEN]) == tg, bar);
            __builtin_amdgcn_fence(__ATOMIC_ACQUIRE, "agent");
            xb_add(&bar[XB_XGEN(b.x)], 1u);
            asm volatile("s_waitcnt vmcnt(0)" ::: "memory");
        } else {
            XB_SPIN(xb_ld(&bar[XB_XGEN(b.x)]) == gen, bar);
            __builtin_amdgcn_fence(__ATOMIC_ACQUIRE, "agent");
            asm volatile("s_waitcnt vmcnt(0)" ::: "memory");
        }
    }
    __syncthreads();
}


struct Args {
    const float *x, *mem, *pre_w, *mem_w, *w_in, *conv_w, *a_log, *dt_bias, *dn_w, *mix_w, *pool_scale, *w_kv, *w_pp, *w_pd, *w_pm, *w_out, *post_w;
    float* out; unsigned char* ws; int ph_lo, ph_hi;
};

__device__ __forceinline__ float wave_sum(float v) {
    v += __builtin_bit_cast(float, __builtin_amdgcn_update_dpp(0, __builtin_bit_cast(int, v), 0xB1, 0xF, 0xF, false));
    v += __builtin_bit_cast(float, __builtin_amdgcn_update_dpp(0, __builtin_bit_cast(int, v), 0x4E, 0xF, 0xF, false));
    v += __builtin_bit_cast(float, __builtin_amdgcn_update_dpp(0, __builtin_bit_cast(int, v), 0x124, 0xF, 0xF, false));
    v += __builtin_bit_cast(float, __builtin_amdgcn_update_dpp(0, __builtin_bit_cast(int, v), 0x128, 0xF, 0xF, false));
    const int vi = __builtin_bit_cast(int, v);
    const float s0 = __builtin_bit_cast(float, __builtin_amdgcn_readlane(vi, 0)), s1 = __builtin_bit_cast(float, __builtin_amdgcn_readlane(vi, 16));
    const float s2 = __builtin_bit_cast(float, __builtin_amdgcn_readlane(vi, 32)), s3 = __builtin_bit_cast(float, __builtin_amdgcn_readlane(vi, 48));
    return (s0 + s1) + (s2 + s3);
}

__device__ __forceinline__ void p0_transpose_item(const float* W, int ldw, int K, bf16_t* WT, LAS float* scr, int kb, int nb, int lane) {
    const int k0 = 64 * kb, n0 = 32 * nb;
    float tv[32];
#pragma unroll
    for (int i = 0; i < 32; ++i) tv[i] = W[(size_t)(k0 + 2 * i + (lane >> 5)) * ldw + n0 + (lane & 31)];
#pragma unroll
    for (int i = 0; i < 32; ++i) scr[(2 * i + (lane >> 5)) * 33 + (lane & 31)] = tv[i];
    LDS_WAIT();
    const int c = lane & 7;
#pragma unroll
    for (int j = 0; j < 4; ++j) { const int n = (lane >> 3) + 8 * j; const LAS float* s = scr + (8 * c) * 33 + n;
        u32x4 o; o.x = pk2(s[0 * 33], s[1 * 33]); o.y = pk2(s[2 * 33], s[3 * 33]); o.z = pk2(s[4 * 33], s[5 * 33]); o.w = pk2(s[6 * 33], s[7 * 33]);
        *(u32x4*)(WT + (size_t)(n0 + n) * K + k0 + 8 * c) = o; }
    LDS_WAIT();
}

__device__ __forceinline__ void p0_prologue(const Args& a, LAS unsigned char* lds) {
    int tid_ = threadIdx.x; asm volatile("" : "+v"(tid_));
    const int tid = tid_, lane = tid & 63, wave = tid >> 6, G = gridDim.x;
    unsigned char* ws = a.ws;
    LAS float* W16 = (LAS float*)lds;
    LAS float* scr = (LAS float*)(lds + 65536 + wave * 8448);
    for (int idx = tid; idx < 4096; idx += 512) { const int i = idx >> 2, q = idx & 3; const int p = ((i >> 8) * 4 + (i & 3)) * 64 + ((i >> 2) & 63);
        *(LAS f32x4*)(W16 + (q * 1024 + p) * 4) = *(const f32x4*)(a.w_in + (size_t)i * INW + 4096 + 4 * q); }
    for (int i = blockIdx.x * 512 + tid; i < M; i += G * 512) ((float*)(ws + WS_ROWSS))[i] = 0.f;
    for (int i = blockIdx.x * 512 + tid; i < M * 8; i += G * 512) ((float*)(ws + WS_SUMSQ))[i] = 0.f;
    __syncthreads();
    const int gw = blockIdx.x * 8 + wave, NGW = G * 8;
    bf16_t* WT = (bf16_t*)(ws + WS_WT);
#define SEG(src, ldw, Kk, Nseg, dst) { const int ni = ((Kk) / 64) * ((Nseg) / 32); if (r < ni) { const int nblk = (Nseg) / 32; p0_transpose_item((src), (ldw), (Kk), (dst), scr, r / nblk, r % nblk, lane); continue; } r -= ni; }
    constexpr int NITEMS = 16 * 288 + 512 + 256 + 512 + 256 + 512 + 32;
    for (int it = gw; it < NITEMS; it += NGW) {
        int r = it;
        SEG(a.w_in + 0, INW, 1024, 512, WT)
        SEG(a.w_in + 5136, INW, 1024, 512, WT + (size_t)512 * 1024)
        SEG(a.w_in + 1024, INW, 1024, 3072, WT + (size_t)1024 * 1024)
        SEG(a.w_in + 512, INW, 1024, 512, WT + (size_t)4096 * 1024)
        SEG(a.w_in + 4112, INW, 1024, 1024, WT + (size_t)4608 * 1024)
        SEG(a.w_in + 5648, INW, 1024, 512, WT + (size_t)5632 * 1024)
        SEG(a.w_in + 6160, INW, 1024, 3072, WT + (size_t)6144 * 1024)
        SEG(a.w_kv, 1024, 1024, 1024, (bf16_t*)(ws + WS_WKV))
        SEG(a.w_pp, 1024, 512, 1024, (bf16_t*)(ws + WS_WP))
        SEG(a.w_pd, 1024, 1024, 1024, (bf16_t*)(ws + WS_WD))
        SEG(a.w_pm, 1024, 512, 1024, (bf16_t*)(ws + WS_WM))
        SEG(a.w_out, 1024, 1024, 1024, (bf16_t*)(ws + WS_WOUT))
        SEG(a.mix_w + 0 * 16384, 128, 128, 128, (bf16_t*)(ws + WS_WMIX) + 0 * 16384)
        SEG(a.mix_w + 1 * 16384, 128, 128, 128, (bf16_t*)(ws + WS_WMIX) + 1 * 16384)
        SEG(a.mix_w + 2 * 16384, 128, 128, 128, (bf16_t*)(ws + WS_WMIX) + 2 * 16384)
        SEG(a.mix_w + 3 * 16384, 128, 128, 128, (bf16_t*)(ws + WS_WMIX) + 3 * 16384)
    }
#undef SEG
    f32x4 nwx[4], nwm[4];
#pragma unroll
    for (int j = 0; j < 4; ++j) { nwx[j] = ((const f32x4*)a.pre_w)[lane + 64 * j]; nwm[j] = ((const f32x4*)a.mem_w)[lane + 64 * j]; }
    f32x4 vnx[4];
    {   const int m = gw; const float* src = (m >= M) ? a.mem + (size_t)(m - M) * 1024 : a.x + (size_t)m * 1024;
#pragma unroll
        for (int j = 0; j < 4; ++j) vnx[j] = ((const f32x4*)src)[lane + 64 * j]; }
    for (int m = gw; m < M + NB * MEML; m += NGW) {
        const bool is_mem = m >= M;
        bf16_t* dst = is_mem ? (bf16_t*)(ws + WS_MEMN) + (size_t)(m - M) * 1024 : (bf16_t*)(ws + WS_H) + (size_t)m * 1024;
        f32x4 v[4]; float s = 0.f;
#pragma unroll
        for (int j = 0; j < 4; ++j) { v[j] = vnx[j]; s += (v[j].x * v[j].x + v[j].y * v[j].y) + (v[j].z * v[j].z + v[j].w * v[j].w); }
        {   const int m2 = (m + NGW < M + NB * MEML) ? m + NGW : m; const float* src = (m2 >= M) ? a.mem + (size_t)(m2 - M) * 1024 : a.x + (size_t)m2 * 1024;
#pragma unroll
            for (int j = 0; j < 4; ++j) vnx[j] = ((const f32x4*)src)[lane + 64 * j]; }
        const float rstd = 1.0f / sqrtf(wave_sum(s) * (1.f / 1024.f) + EPS);
#pragma unroll
        for (int j = 0; j < 4; ++j) { const f32x4 wv = is_mem ? nwm[j] : nwx[j]; v[j] = v[j] * rstd * wv;
            u32x2 o; o.x = pk2(v[j].x, v[j].y); o.y = pk2(v[j].z, v[j].w); ((u32x2*)dst)[lane + 64 * j] = o; }
        if (!is_mem) {
            f32x4 acc[4];
#pragma unroll
            for (int q = 0; q < 4; ++q) acc[q] = (f32x4){0.f, 0.f, 0.f, 0.f};
#pragma unroll
            for (int j = 0; j < 4; ++j)
#pragma unroll
                for (int e = 0; e < 4; ++e) { const float xv = v[j][e];
#pragma unroll
                    for (int q = 0; q < 4; ++q) { const f32x4 wv = *(const LAS f32x4*)(W16 + (q * 1024 + (j * 4 + e) * 64 + lane) * 4); acc[q] += xv * wv; } }
            float val = 0.f;
#pragma unroll
            for (int q = 0; q < 4; ++q)
#pragma unroll
                for (int e = 0; e < 4; ++e) { const float t = wave_sum(acc[q][e]); if (lane == q * 4 + e) val = t; }
            if (lane < 8) { const float z = val + a.dt_bias[lane]; const float sp = z > 20.f ? z : log1pf(expf(z));
                ((float*)(ws + WS_G))[(size_t)m * 8 + lane] = -expf(a.a_log[lane]) * sp; }
            else if (lane < 16) ((float*)(ws + WS_BETA))[(size_t)m * 8 + lane - 8] = 1.f / (1.f + expf(-val));
        }
    }
}

__device__ __forceinline__ void chunk_load_raw(const Args& a, int item, u32x4 (&raw)[11], int tid) {
    const int n = item & 31, h = (item >> 5) & 7, b = item >> 8; const int r0 = b * SEQ + 64 * n, gci = b * 32 + n;
    const int ten = tid >> 7, cgp = tid & 15, rg = (tid >> 4) & 7;
    if (tid < 384) {
        const bf16_t* src = (const bf16_t*)(a.ws + WS_QKV) + (size_t)ten * M * 1024 + h * 128 + cgp * 8;
#pragma unroll
        for (int i = 0; i < 11; ++i) { const int rr = 8 * rg - 3 + i;
            if (rr >= 0) raw[i] = *(const u32x4*)(src + (size_t)(r0 + rr) * 1024);
            else if (n > 0) raw[i] = *(const u32x4*)((const bf16_t*)(a.ws + WS_HALO) + ((size_t)(gci - 1) * 3 + (rr + 3)) * 3072 + ten * 1024 + h * 128 + cgp * 8);
            else raw[i] = (u32x4){0u, 0u, 0u, 0u}; }
    }
}
__device__ __forceinline__ void chunk_prep_item(const Args& a, LAS unsigned char* lds, int item, u32x4 (&raw)[11], int item_next, float& gpre, float& bpre) {
    int tid_ = threadIdx.x; asm volatile("" : "+v"(tid_));
    const int tid = tid_, lane = tid & 63, wid = tid >> 6, r16 = lane & 15, qp = lane >> 4;
    const int n = item & 31, h = (item >> 5) & 7, b = item >> 8;
    const int r0 = b * SEQ + 64 * n, gci = b * 32 + n;
    unsigned char* ws = a.ws;
    bf16_t* QKV = (bf16_t*)(ws + WS_QKV);
    LAS bf16_t* Kn = (LAS bf16_t*)(lds);
    LAS bf16_t* Qn = (LAS bf16_t*)(lds + 17408);
    LAS bf16_t* VbT = (LAS bf16_t*)(lds + 34816);
    LAS bf16_t* KbgT = (LAS bf16_t*)(lds + 53248);
    LAS bf16_t* Tb = (LAS bf16_t*)(lds + 71680);
    LAS float* Ap = (LAS float*)(lds + 80896);
    LAS float* gcs = (LAS float*)(lds + 98304);
    LAS float* bts = gcs + 64;
    __syncthreads();
    if (wid == 0) {
        float g = gpre;
        const float bt = bpre;
        if (item_next >= 0) { const int n2 = item_next & 31, h2 = (item_next >> 5) & 7, b2 = item_next >> 8; const int r2 = b2 * SEQ + 64 * n2;
            gpre = ((const float*)(ws + WS_G))[(size_t)(r2 + lane) * 8 + h2]; bpre = ((const float*)(ws + WS_BETA))[(size_t)(r2 + lane) * 8 + h2]; }
#pragma unroll
        for (int o = 1; o < 64; o <<= 1) { const float t = __shfl_up(g, o); if (lane >= o) g += t; }
        gcs[lane] = g; bts[lane] = bt;
        if (lane == 63) ((float*)(ws + WS_GL))[item] = __expf(g);
    }
    __syncthreads();
    u32x4 outA[8];
    const int ten = tid >> 7, cgp = tid & 15, rg = (tid >> 4) & 7;
    if (tid < 384) {
        f32x4 cw[4][2];
#pragma unroll
        for (int j = 0; j < 4; ++j) { const float* cp = a.conv_w + (size_t)j * 3072 + ten * 1024 + h * 128 + cgp * 8; cw[j][0] = *(const f32x4*)cp; cw[j][1] = *(const f32x4*)(cp + 4); }
        float y[8][8];
#pragma unroll
        for (int i = 0; i < 8; ++i) {
#pragma unroll
            for (int e = 0; e < 8; ++e) y[i][e] = 0.f;
#pragma unroll
            for (int j = 0; j < 4; ++j) { const u32x4 rv = raw[i + j];
                y[i][0] += cw[j][0][0] * bflo(rv.x); y[i][1] += cw[j][0][1] * bfhi(rv.x); y[i][2] += cw[j][0][2] * bflo(rv.y); y[i][3] += cw[j][0][3] * bfhi(rv.y);
                y[i][4] += cw[j][1][0] * bflo(rv.z); y[i][5] += cw[j][1][1] * bfhi(rv.z); y[i][6] += cw[j][1][2] * bflo(rv.w); y[i][7] += cw[j][1][3] * bfhi(rv.w); }
#pragma unroll
            for (int e = 0; e < 8; ++e) y[i][e] = silu_f(y[i][e]);
        }
        if (item_next >= 0) chunk_load_raw(a, item_next, raw, tid);
        const float gl = gcs[63];
        if (ten < 2) {
#pragma unroll
            for (int i = 0; i < 8; ++i) { float ss = 0.f;
#pragma unroll
                for (int e = 0; e < 8; ++e) ss += y[i][e] * y[i][e];
                ss += __shfl_xor(ss, 1); ss += __shfl_xor(ss, 2); ss += __shfl_xor(ss, 4); ss += __shfl_xor(ss, 8);
                const float sc = (1.0f / sqrtf(ss + EPS)) * (ten == 0 ? 0.08838834764831845f : 1.f);
#pragma unroll
                for (int e = 0; e < 8; ++e) y[i][e] *= sc; }
        }
        if (ten == 0) {
#pragma unroll
            for (int i = 0; i < 8; ++i) { const int row = 8 * rg + i; const float eg = __expf(gcs[row]);
                u32x4 w; w.x = pk2(y[i][0], y[i][1]); w.y = pk2(y[i][2], y[i][3]); w.z = pk2(y[i][4], y[i][5]); w.w = pk2(y[i][6], y[i][7]);
                *(LAS u32x4*)(Qn + row * 136 + cgp * 8) = w;
                outA[i].x = pk2(y[i][0] * eg, y[i][1] * eg); outA[i].y = pk2(y[i][2] * eg, y[i][3] * eg); outA[i].z = pk2(y[i][4] * eg, y[i][5] * eg); outA[i].w = pk2(y[i][6] * eg, y[i][7] * eg); }
        } else if (ten == 1) {
            float f1[8], f2[8];
#pragma unroll
            for (int i = 0; i < 8; ++i) { const int row = 8 * rg + i; const float gc = gcs[row]; f1[i] = bts[row] * __expf(gc); f2[i] = __expf(gl - gc);
                u32x4 w; w.x = pk2(y[i][0], y[i][1]); w.y = pk2(y[i][2], y[i][3]); w.z = pk2(y[i][4], y[i][5]); w.w = pk2(y[i][6], y[i][7]);
                *(LAS u32x4*)(Kn + row * 136 + cgp * 8) = w; }
#pragma unroll
            for (int e = 0; e < 8; ++e) { u32x4 w;
                w.x = pk2(y[0][e] * f1[0], y[1][e] * f1[1]); w.y = pk2(y[2][e] * f1[2], y[3][e] * f1[3]); w.z = pk2(y[4][e] * f1[4], y[5][e] * f1[5]); w.w = pk2(y[6][e] * f1[6], y[7][e] * f1[7]);
                *(LAS u32x4*)(KbgT + (cgp * 8 + e) * 72 + 8 * rg) = w;
                outA[e].x = pk2(y[0][e] * f2[0], y[1][e] * f2[1]); outA[e].y = pk2(y[2][e] * f2[2], y[3][e] * f2[3]); outA[e].z = pk2(y[4][e] * f2[4], y[5][e] * f2[5]); outA[e].w = pk2(y[6][e] * f2[6], y[7][e] * f2[7]); }
        } else {
            float f1[8];
#pragma unroll
            for (int i = 0; i < 8; ++i) f1[i] = bts[8 * rg + i];
#pragma unroll
            for (int e = 0; e < 8; ++e) { u32x4 w;
                w.x = pk2(y[0][e] * f1[0], y[1][e] * f1[1]); w.y = pk2(y[2][e] * f1[2], y[3][e] * f1[3]); w.z = pk2(y[4][e] * f1[4], y[5][e] * f1[5]); w.w = pk2(y[6][e] * f1[6], y[7][e] * f1[7]);
                *(LAS u32x4*)(VbT + (cgp * 8 + e) * 72 + 8 * rg) = w; }
        }
    }
    __syncthreads();
    if (tid < 128) {
#pragma unroll
        for (int i = 0; i < 8; ++i) *(u32x4*)(QKV + (size_t)(r0 + 8 * rg + i) * 1024 + h * 128 + cgp * 8) = outA[i];
    } else if (tid < 256) {
#pragma unroll
        for (int e = 0; e < 8; ++e) { const int k = cgp * 8 + e;
            *(u32x4*)((unsigned char*)(QKV + (size_t)2 * M * 1024 + (size_t)(r0 + (k >> 1)) * 1024 + h * 128) + (k & 1) * 128 + 16 * rg) = outA[e]; }
    }
    {
        const int mat = wid >> 2, ti = wid & 3;
        const LAS bf16_t* Bm = mat ? Qn : Kn;
        f32x4 c4[4];
#pragma unroll
        for (int tj = 0; tj < 4; ++tj) c4[tj] = (f32x4){0.f, 0.f, 0.f, 0.f};
#pragma unroll
        for (int ks = 0; ks < 4; ++ks) { const bf16x8 af = *(const LAS bf16x8*)(Kn + (ti * 16 + r16) * 136 + ks * 32 + 8 * qp);
#pragma unroll
            for (int tj = 0; tj < 4; ++tj) { const bf16x8 bf = *(const LAS bf16x8*)(Bm + (tj * 16 + r16) * 136 + ks * 32 + 8 * qp); c4[tj] = MFMA16(af, bf, c4[tj]); } }
        const int j0 = ti * 16 + 4 * qp;
        const f32x4 gj = *(const LAS f32x4*)(gcs + j0);
#pragma unroll
        for (int tj = 0; tj < 4; ++tj) { const int i = tj * 16 + r16; const float gi = gcs[i]; f32x4 v;
#pragma unroll
            for (int e = 0; e < 4; ++e) { const int j = j0 + e; const float d = __expf(fminf(gi - gj[e], 0.f)); const bool keep = mat ? (j <= i) : (j < i); v[e] = keep ? c4[tj][e] * d : 0.f; }
            if (mat == 0) { v = v * bts[i];
#pragma unroll
                for (int e = 0; e < 4; ++e) Ap[i * 68 + e * 16 + ti * 4 + qp] = v[e]; }
            else { u32x2 o; o.x = pk2(v[0], v[1]); o.y = pk2(v[2], v[3]); *(u32x2*)((bf16_t*)(ws + WS_AQK) + (size_t)item * 4096 + i * 64 + j0) = o; } }
    }
    __syncthreads();
    if (wid < 4) {
        const int ph = lane & 3, c = 16 * wid + (lane >> 2);
        float t[16];
#pragma unroll
        for (int m = 0; m < 16; ++m) t[m] = 0.f;
        f32x4 cf[3][4];
#define LOADROW(ii, slot) do { _Pragma("unroll") for (int m4 = 0; m4 < 4; ++m4) if (m4 * 16 < (ii) && (ii) < 64) cf[slot][m4] = *(const LAS f32x4*)(Ap + (ii) * 68 + ph * 16 + 4 * m4); } while (0)
        LOADROW(0, 0); LOADROW(1, 1); LOADROW(2, 2);
#pragma unroll
        for (int i = 0; i < 64; ++i) {
            float acc0 = 0.f, acc1 = 0.f;
#pragma unroll
            for (int m4 = 0; m4 * 16 < i; ++m4) { const f32x4 av = cf[i % 3][m4];
                acc0 += av[0] * t[4 * m4];
                if ((4 * m4 + 1) * 4 < i) acc1 += av[1] * t[4 * m4 + 1];
                if ((4 * m4 + 2) * 4 < i) acc0 += av[2] * t[4 * m4 + 2];
                if ((4 * m4 + 3) * 4 < i) acc1 += av[3] * t[4 * m4 + 3]; }
            __builtin_amdgcn_sched_barrier(0);
            LOADROW(i + 3, i % 3);
            __builtin_amdgcn_sched_barrier(0);
            float acc = acc0 + acc1;
            acc += __builtin_bit_cast(float, __builtin_amdgcn_update_dpp(0, __builtin_bit_cast(int, acc), 0xB1, 0xF, 0xF, false));
            acc += __builtin_bit_cast(float, __builtin_amdgcn_update_dpp(0, __builtin_bit_cast(int, acc), 0x4E, 0xF, 0xF, false));
            const float val = ((c == i) ? 1.f : 0.f) - acc;
            t[i >> 2] = (ph == (i & 3)) ? val : t[i >> 2];
        }
#undef LOADROW
#pragma unroll
        for (int m = 0; m < 16; ++m) Tb[(4 * m + ph) * 72 + c] = (bf16_t)f2bf(t[m]);
    }
    __syncthreads();
    {
        f32x4 cu[4], cwv[4];
#pragma unroll
        for (int ct = 0; ct < 4; ++ct) { cu[ct] = (f32x4){0.f, 0.f, 0.f, 0.f}; cwv[ct] = (f32x4){0.f, 0.f, 0.f, 0.f}; }
#pragma unroll
        for (int ks = 0; ks < 2; ++ks) {
            const bf16x8 vb = *(const LAS bf16x8*)(VbT + (16 * wid + r16) * 72 + ks * 32 + 8 * qp);
            const bf16x8 kb = *(const LAS bf16x8*)(KbgT + (16 * wid + r16) * 72 + ks * 32 + 8 * qp);
#pragma unroll
            for (int ct = 0; ct < 4; ++ct) { const bf16x8 tf = *(const LAS bf16x8*)(Tb + (16 * ct + r16) * 72 + ks * 32 + 8 * qp);
                cu[ct] = MFMA16(tf, vb, cu[ct]); cwv[ct] = MFMA16(kb, tf, cwv[ct]); }
        }
#pragma unroll
        for (int ct = 0; ct < 4; ++ct) {
            u32x2 o; o.x = pk2(cu[ct][0], cu[ct][1]); o.y = pk2(cu[ct][2], cu[ct][3]);
            ((u32x2*)(ws + WS_U))[(((size_t)item * 8 + wid) * 4 + ct) * 64 + lane] = o;
            u32x2 w2; w2.x = pk2(-cwv[ct][0], -cwv[ct][1]); w2.y = pk2(-cwv[ct][2], -cwv[ct][3]);
            *(u32x2*)(QKV + (size_t)M * 1024 + (size_t)(r0 + 16 * ct + r16) * 1024 + h * 128 + 16 * wid + 4 * qp) = w2;
        }
    }
}

__device__ __forceinline__ bf16x8 ldA_perm(const LAS bf16_t* p) {
    const u32x2 lo = *(const LAS u32x2*)p, hi = *(const LAS u32x2*)(p + 16);
    u32x4 v; v.x = lo.x; v.y = lo.y; v.z = hi.x; v.w = hi.y; return __builtin_bit_cast(bf16x8, v);
}
__device__ __forceinline__ bf16x8 packB(f32x4 t0, f32x4 t1) {
    u32x4 v; v.x = pk2(t0[0], t0[1]); v.y = pk2(t0[2], t0[3]); v.z = pk2(t1[0], t1[1]); v.w = pk2(t1[2], t1[3]); return __builtin_bit_cast(bf16x8, v);
}
constexpr int SC_W = 0, SC_QG = 18432, SC_AQK = 36864, SC_KDT = 47104, SC_BUF = 67584, SC_RED = 2 * SC_BUF, SC_RSTD = SC_RED + 2048;

__device__ __forceinline__ void scan_load(const Args& a, int bh, int n, u32x4 (&stg)[7]) {
    const int tid = threadIdx.x, b = bh >> 3, h = bh & 7; const int r0 = b * SEQ + 64 * n; const int item = bh * 32 + n;
    const bf16_t* QKV = (const bf16_t*)(a.ws + WS_QKV);
    const int c = tid >> 4, k8 = tid & 15;
#pragma unroll
    for (int i = 0; i < 2; ++i) {
        stg[i] = *(const u32x4*)(QKV + (size_t)M * 1024 + (size_t)(r0 + c + 32 * i) * 1024 + h * 128 + k8 * 8);
        stg[2 + i] = *(const u32x4*)(QKV + (size_t)(r0 + c + 32 * i) * 1024 + h * 128 + k8 * 8);
        stg[4 + i] = *(const u32x4*)(QKV + (size_t)2 * M * 1024 + (size_t)(r0 + c + 32 * i) * 1024 + h * 128 + k8 * 8);
    }
    stg[6] = *(const u32x4*)((const bf16_t*)(a.ws + WS_AQK) + (size_t)item * 4096 + tid * 8);
}
__device__ __forceinline__ void st_perm(LAS unsigned char* rowp  , int a4  , u32x4 v) {
    const int p0 = (a4 & 1) * 16 + (a4 >> 1) * 4;
    u32x2 lo; lo.x = v.x; lo.y = v.y; u32x2 hi; hi.x = v.z; hi.y = v.w;
    *(LAS u32x2*)(rowp + p0 * 2) = lo; *(LAS u32x2*)(rowp + (p0 + 8) * 2) = hi;
}
__device__ __forceinline__ void scan_store(LAS unsigned char* buf, const u32x4 (&stg)[7]) {
    const int tid = threadIdx.x; const int c = tid >> 4, k8 = tid & 15;
#pragma unroll
    for (int i = 0; i < 2; ++i) {
        st_perm(buf + SC_W + ((c + 32 * i) * 144 + (k8 >> 2) * 32) * 2, k8 & 3, stg[i]);
        st_perm(buf + SC_QG + ((c + 32 * i) * 144 + (k8 >> 2) * 32) * 2, k8 & 3, stg[2 + i]);
        const int line = c + 32 * i, k = line * 2 + (k8 >> 3), c8 = k8 & 7;
        st_perm(buf + SC_KDT + (k * 80 + (c8 >> 2) * 32) * 2, c8 & 3, stg[4 + i]);
    }
    { const int cc = tid >> 3, j8 = tid & 7; st_perm(buf + SC_AQK + (cc * 80 + (j8 >> 2) * 32) * 2, j8 & 3, stg[6]); }
}
__device__ __forceinline__ float dpp_add16(float v) {
    v += __builtin_bit_cast(float, __builtin_amdgcn_update_dpp(0, __builtin_bit_cast(int, v), 0xB1, 0xF, 0xF, false));
    v += __builtin_bit_cast(float, __builtin_amdgcn_update_dpp(0, __builtin_bit_cast(int, v), 0x4E, 0xF, 0xF, false));
    v += __builtin_bit_cast(float, __builtin_amdgcn_update_dpp(0, __builtin_bit_cast(int, v), 0x124, 0xF, 0xF, false));
    v += __builtin_bit_cast(float, __builtin_amdgcn_update_dpp(0, __builtin_bit_cast(int, v), 0x128, 0xF, 0xF, false));
    return v;
}
#define LDA128(p) (*(const LAS bf16x8*)(p))

struct ScanSet { u32x4 stg[7]; u32x2 u[4]; float gl; };
__device__ __forceinline__ void scan_load_set(const Args& a, int bh, int n, ScanSet& t, int lane, int wid) {
    scan_load(a, bh, n, t.stg);
#pragma unroll
    for (int ct = 0; ct < 4; ++ct) t.u[ct] = ((const u32x2*)(a.ws + WS_U))[(((size_t)(bh * 32 + n) * 8 + wid) * 4 + ct) * 64 + lane];
    t.gl = ((const float*)(a.ws + WS_GL))[bh * 32 + n];
}
__device__ __forceinline__ void scan_step(const Args& a, LAS unsigned char* lds, int bh, int n, f32x4 (&S)[8], ScanSet& T, float dnw, int lane, int wid, int r16, int qp) {
    const int tid = threadIdx.x, b = bh >> 3, h = bh & 7;
    bf16_t* Y = (bf16_t*)a.out;
    LAS unsigned char* buf = lds + (n & 1) * SC_BUF;
    const float gl = T.gl;
    f32x4 vn[4], o[4];
#pragma unroll
    for (int ct = 0; ct < 4; ++ct) { const u32x2 uu = T.u[ct];
        vn[ct] = (f32x4){bflo(uu.x), bfhi(uu.x), bflo(uu.y), bfhi(uu.y)}; o[ct] = (f32x4){0.f, 0.f, 0.f, 0.f}; }
    __builtin_amdgcn_sched_barrier(0);
    if (n + 1 < 32) scan_load_set(a, bh, n + 1, T, lane, wid);
    __builtin_amdgcn_sched_barrier(0);
    bf16x8 sb[4];
#pragma unroll
    for (int s = 0; s < 4; ++s) sb[s] = packB(S[2 * s], S[2 * s + 1]);
    const LAS bf16_t* Wb = (const LAS bf16_t*)(buf + SC_W); const LAS bf16_t* QGb = (const LAS bf16_t*)(buf + SC_QG);
    const LAS bf16_t* AQb = (const LAS bf16_t*)(buf + SC_AQK); const LAS bf16_t* KDb = (const LAS bf16_t*)(buf + SC_KDT);
    bf16x8 fa[8], fb[8];
#define SB() __builtin_amdgcn_sched_barrier(0)
#define LD_VO2(f, ca, cb, sh) do { _Pragma("unroll") for (int s_ = 0; s_ < 2; ++s_) { \
        f[4 * s_ + 0] = LDA128(Wb + (16 * (ca) + r16) * 144 + 32 * ((sh) + s_) + 8 * qp); f[4 * s_ + 1] = LDA128(Wb + (16 * (cb) + r16) * 144 + 32 * ((sh) + s_) + 8 * qp); \
        f[4 * s_ + 2] = LDA128(QGb + (16 * (ca) + r16) * 144 + 32 * ((sh) + s_) + 8 * qp); f[4 * s_ + 3] = LDA128(QGb + (16 * (cb) + r16) * 144 + 32 * ((sh) + s_) + 8 * qp); } } while (0)
#define MM_VO2(f, ca, cb, sh) do { _Pragma("unroll") for (int s_ = 0; s_ < 2; ++s_) { \
        vn[ca] = MFMA16(f[4 * s_ + 0], sb[(sh) + s_], vn[ca]); vn[cb] = MFMA16(f[4 * s_ + 1], sb[(sh) + s_], vn[cb]); \
        o[ca] = MFMA16(f[4 * s_ + 2], sb[(sh) + s_], o[ca]); o[cb] = MFMA16(f[4 * s_ + 3], sb[(sh) + s_], o[cb]); } } while (0)
#define LD_AQ(f) do { _Pragma("unroll") for (int c_ = 0; c_ < 4; ++c_) { f[c_] = LDA128(AQb + (16 * c_ + r16) * 80 + 8 * qp); f[4 + c_] = LDA128(AQb + (16 * c_ + r16) * 80 + 32 + 8 * qp); } } while (0)
#define MM_AQ(f) do { _Pragma("unroll") for (int c_ = 0; c_ < 4; ++c_) o[c_] = MFMA16(f[c_], vb[0], o[c_]); _Pragma("unroll") for (int c_ = 0; c_ < 4; ++c_) o[c_] = MFMA16(f[4 + c_], vb[1], o[c_]); } while (0)
#define LD_KD(f, k0) do { _Pragma("unroll") for (int c_ = 0; c_ < 4; ++c_) { f[c_] = LDA128(KDb + (16 * ((k0) + c_) + r16) * 80 + 8 * qp); f[4 + c_] = LDA128(KDb + (16 * ((k0) + c_) + r16) * 80 + 32 + 8 * qp); } } while (0)
#define MM_KD(f, k0) do { _Pragma("unroll") for (int c_ = 0; c_ < 4; ++c_) S[(k0) + c_] = MFMA16(f[c_], vb[0], S[(k0) + c_] * gl); _Pragma("unroll") for (int c_ = 0; c_ < 4; ++c_) S[(k0) + c_] = MFMA16(f[4 + c_], vb[1], S[(k0) + c_]); } while (0)
    LD_VO2(fa, 0, 1, 0); LD_VO2(fb, 0, 1, 2); SB();
    MM_VO2(fa, 0, 1, 0); SB(); LD_VO2(fa, 2, 3, 0); SB();
    MM_VO2(fb, 0, 1, 2); SB(); LD_VO2(fb, 2, 3, 2); SB();
    MM_VO2(fa, 2, 3, 0); SB(); LD_AQ(fa); SB();
    MM_VO2(fb, 2, 3, 2); SB(); LD_KD(fb, 0); SB();
    bf16x8 vb[2];
#pragma unroll
    for (int s = 0; s < 2; ++s) vb[s] = packB(vn[2 * s], vn[2 * s + 1]);
    MM_AQ(fa); SB(); LD_KD(fa, 4); SB();
    MM_KD(fb, 0); SB();
    MM_KD(fa, 4); SB();
#undef SB
#undef LD_VO2
#undef MM_VO2
#undef LD_AQ
#undef MM_AQ
#undef LD_KD
#undef MM_KD
    {
        float v16[16];
#pragma unroll
        for (int ct = 0; ct < 4; ++ct)
#pragma unroll
            for (int e = 0; e < 4; ++e) v16[4 * ct + e] = o[ct][e] * o[ct][e];
#define DPPF(x, ctrl) __builtin_bit_cast(float, __builtin_amdgcn_update_dpp(0, __builtin_bit_cast(int, (x)), (ctrl), 0xF, 0xF, false))
        float w8[8], w4[4], w2[2];
        const bool b3 = r16 & 8, b2 = r16 & 4, b1 = r16 & 2, b0 = r16 & 1;
#pragma unroll
        for (int j = 0; j < 8; ++j) { const float keep = b3 ? v16[j + 8] : v16[j], send = b3 ? v16[j] : v16[j + 8]; w8[j] = keep + DPPF(send, 0x128); }
#pragma unroll
        for (int j = 0; j < 4; ++j) { const float keep = b2 ? w8[j + 4] : w8[j], send = b2 ? w8[j] : w8[j + 4]; w4[j] = keep + DPPF(send, 0x141); }
#pragma unroll
        for (int j = 0; j < 2; ++j) { const float keep = b1 ? w4[j + 2] : w4[j], send = b1 ? w4[j] : w4[j + 2]; w2[j] = keep + DPPF(send, 0x1B); }
        const float keep = b0 ? w2[1] : w2[0], send = b0 ? w2[0] : w2[1];
        const float tot = keep + DPPF(send, 0xB1);
#undef DPPF
        atomicAdd((float*)(a.ws + WS_SUMSQ) + (size_t)(b * SEQ + 64 * n + 16 * (r16 >> 2) + 4 * qp + (r16 & 3)) * 8 + h, tot);
    }
    if (n + 1 < 32) scan_store(lds + ((n + 1) & 1) * SC_BUF, T.stg);
    const int rowb = b * SEQ + 64 * n;
#pragma unroll
    for (int ct = 0; ct < 4; ++ct)
#pragma unroll
        for (int e = 0; e < 4; ++e) Y[(size_t)(rowb + 16 * ct + 4 * qp + e) * 2048 + 512 + h * 128 + 16 * wid + r16] = (bf16_t)f2bf(o[ct][e] * dnw);
    __syncthreads();
}

__device__ __forceinline__ void scan_bh(const Args& a, LAS unsigned char* lds, int bh) {
    int tid_ = threadIdx.x; asm volatile("" : "+v"(tid_));
    const int tid = tid_, lane = tid & 63, wid = tid >> 6, r16 = lane & 15, qp = lane >> 4;
    const float dnw = a.dn_w[16 * wid + r16];
    f32x4 S[8];
#pragma unroll
    for (int kt = 0; kt < 8; ++kt) S[kt] = (f32x4){0.f, 0.f, 0.f, 0.f};
    ScanSet T;
    __syncthreads();
    scan_load_set(a, bh, 0, T, lane, wid);
    scan_store(lds, T.stg);
    __syncthreads();
#pragma unroll 1
    for (int n = 0; n < 32; ++n) scan_step(a, lds, bh, n, S, T, dnw, lane, wid, r16, qp);
}

__device__ __forceinline__ void attn_item(const Args& a, LAS unsigned char* lds, int item) {
    int tid_ = threadIdx.x; asm volatile("" : "+v"(tid_));
    const int tid = tid_, lane = tid & 63, wid = tid >> 6, r16 = lane & 15, qp = lane >> 4;
    const int qt = item & 15, head = (item >> 4) & 3, b = item >> 6;
    LAS bf16_t* Ks = (LAS bf16_t*)lds;
    LAS bf16_t* Vt = (LAS bf16_t*)(lds + 69632);
    const bf16_t* KM = (const bf16_t*)(a.ws + WS_KMEM); const bf16_t* VM = (const bf16_t*)(a.ws + WS_VMEMT); const bf16_t* QM = (const bf16_t*)(a.ws + WS_QM);
    __syncthreads();
#pragma unroll
    for (int i = 0; i < 8; ++i) { const int p = tid + 512 * i;
        { const int key = p >> 4, d8 = p & 15; *(LAS u32x4*)(Ks + key * 136 + d8 * 8) = *(const u32x4*)(KM + (size_t)(b * 256 + key) * 512 + head * 128 + d8 * 8); }
        { const int d = p >> 5, k8 = p & 31; *(LAS u32x4*)(Vt + d * 264 + k8 * 8) = *(const u32x4*)(VM + (size_t)(head * 128 + d) * 2048 + b * 256 + k8 * 8); } }
    const int qrow = b * SEQ + qt * 128 + 16 * wid + r16;
    bf16x8 qf[4];
#pragma unroll
    for (int s = 0; s < 4; ++s) qf[s] = *(const bf16x8*)(QM + (size_t)qrow * 512 + head * 128 + 32 * s + 8 * qp);
    __syncthreads();
    f32x4 sc[16];
#pragma unroll
    for (int kt = 0; kt < 16; ++kt) { sc[kt] = (f32x4){0.f, 0.f, 0.f, 0.f};
#pragma unroll
        for (int s = 0; s < 4; ++s) sc[kt] = MFMA16(*(const LAS bf16x8*)(Ks + (16 * kt + r16) * 136 + 32 * s + 8 * qp), qf[s], sc[kt]); }
    float mx = -3.0e38f;
#pragma unroll
    for (int kt = 0; kt < 16; ++kt) mx = fmaxf(fmaxf(fmaxf(sc[kt][0], sc[kt][1]), fmaxf(sc[kt][2], sc[kt][3])), mx);
    mx = fmaxf(mx, __shfl_xor(mx, 16)); mx = fmaxf(mx, __shfl_xor(mx, 32));
    const float scl = 0.08838834764831845f; float sum = 0.f;
#pragma unroll
    for (int kt = 0; kt < 16; ++kt)
#pragma unroll
        for (int e = 0; e < 4; ++e) { const float p = __expf((sc[kt][e] - mx) * scl); sc[kt][e] = p; sum += p; }
    sum += __shfl_xor(sum, 16); sum += __shfl_xor(sum, 32);
    f32x4 o[8];
#pragma unroll
    for (int dt = 0; dt < 8; ++dt) o[dt] = (f32x4){0.f, 0.f, 0.f, 0.f};
#pragma unroll
    for (int s = 0; s < 8; ++s) { const bf16x8 pb = packB(sc[2 * s], sc[2 * s + 1]);
#pragma unroll
        for (int dt = 0; dt < 8; ++dt) o[dt] = MFMA16(ldA_perm(Vt + (16 * dt + r16) * 264 + 32 * s + 4 * qp), pb, o[dt]); }
    const float inv = 1.f / sum;
    bf16_t* Y = (bf16_t*)a.out;
#pragma unroll
    for (int dt = 0; dt < 8; ++dt) { u32x2 w; w.x = pk2(o[dt][0] * inv, o[dt][1] * inv); w.y = pk2(o[dt][2] * inv, o[dt][3] * inv);
        *(u32x2*)(Y + (size_t)qrow * 2048 + 1536 + head * 128 + 16 * dt + 4 * qp) = w; }
}

__device__ __forceinline__ void pool_item(const Args& a, LAS unsigned char* lds, int item) {
    int tid_ = threadIdx.x; asm volatile("" : "+v"(tid_));
    const int tid = tid_, lane = tid & 63, wid = tid >> 6, r16 = lane & 15, qp = lane >> 4;
    const int g = item & 3, tt = (item >> 2) & 31, b = item >> 7;
    LAS bf16_t* Xs = (LAS bf16_t*)lds;
    LAS bf16_t* Ps = (LAS bf16_t*)(lds + 20480);
    const bf16_t* XA = (const bf16_t*)(a.ws + WS_XA);
    const int t0 = tt * 64;
    __syncthreads();
    for (int p = tid; p < 1280; p += 512) { const int row = p >> 4, c8 = p & 15; const int t = t0 - 16 + row; u32x4 v = (u32x4){0u, 0u, 0u, 0u};
        if (t >= 0) v = *(const u32x4*)(XA + (size_t)(b * SEQ + t) * 512 + g * 128 + c8 * 8);
        *(LAS u32x4*)(Xs + row * 128 + c8 * 8) = v; }
    __syncthreads();
    {
        const int c = tid & 127, rgp = tid >> 7, w = 2 << g; float sum = 0.f;
        for (int j = 1; j < w; ++j) sum += bflo((unsigned)Xs[(16 + 16 * rgp - j) * 128 + c]);
        const float invw = 1.f / (float)w;
#pragma unroll 4
        for (int i = 0; i < 16; ++i) { const int row = 16 * rgp + i; const float xv = bflo((unsigned)Xs[(16 + row) * 128 + c]); sum += xv;
            const int t = t0 + row; const float mean = (t + 1 >= w) ? sum * invw : sum / (float)(t + 1);
            Ps[row * 136 + c] = (bf16_t)f2bf(mean - xv);
            sum -= bflo((unsigned)Xs[(16 + row - (w - 1)) * 128 + c]); }
    }
    __syncthreads();
    const bf16_t* WX = (const bf16_t*)(a.ws + WS_WMIX) + g * 16384;
    f32x4 acc[4];
#pragma unroll
    for (int t4 = 0; t4 < 4; ++t4) acc[t4] = (f32x4){0.f, 0.f, 0.f, 0.f};
#pragma unroll
    for (int s = 0; s < 4; ++s) { const bf16x8 af = *(const bf16x8*)(WX + (16 * wid + r16) * 128 + 32 * s + 8 * qp);
#pragma unroll
        for (int t4 = 0; t4 < 4; ++t4) acc[t4] = MFMA16(af, *(const LAS bf16x8*)(Ps + (16 * t4 + r16) * 136 + 32 * s + 8 * qp), acc[t4]); }
    const f32x4 psc = *(const f32x4*)(a.pool_scale + g * 128 + 16 * wid + 4 * qp);
    bf16_t* Y = (bf16_t*)a.out;
#pragma unroll
    for (int t4 = 0; t4 < 4; ++t4) { u32x2 w2; w2.x = pk2(acc[t4][0] * psc[0], acc[t4][1] * psc[1]); w2.y = pk2(acc[t4][2] * psc[2], acc[t4][3] * psc[3]);
        *(u32x2*)(Y + (size_t)(b * SEQ + t0 + 16 * t4 + r16) * 2048 + g * 128 + 16 * wid + 4 * qp) = w2; }
}

#ifndef REP_P0
#define REP_P0 1
#endif
#ifndef REP_P1
#define REP_P1 1
#endif
#ifndef REP_P3
#define REP_P3 1
#endif
#ifndef REP_P5
#define REP_P5 1
#endif
#define P0_BODY if (IN(0)) p0_prologue(a, lds);
#define P1_BODY \
    if (IN(1)) { \
        {   pg8::Gemm g{(const bf16_t*)(ws + WS_H), (const bf16_t*)(ws + WS_WT), 1024, 1024, 1024}; pg8::StaticOrder S; S.init(M, 4096, G, bx); \
            pg8::EpiStage1 E{(bf16_t*)(ws + WS_XA), (bf16_t*)(ws + WS_QM), (bf16_t*)(ws + WS_QKV), (bf16_t*)(ws + WS_HALO)}; \
            pg8::gemm_phase(lds, g, S, E); } \
    }
#ifndef REP_SCAN
#define REP_SCAN 1
#endif
#ifndef REP_ATTN
#define REP_ATTN 1
#endif
#ifndef REP_POOL
#define REP_POOL 1
#endif
#define P3_BODY \
    if (IN(3)) { \
        unsigned* kvcnt = (unsigned*)(ws + WS_CTL) + 8192; \
        if (G >= 128) { \
            if (bx < 64) { for (int rep = 0; rep < REP_SCAN; ++rep) scan_bh(a, lds, bx); } \
            else { const int c = bx - 64, GG = G - 64; \
                if (c < 32) { \
                    pg8::OneUnit S1; \
                    if (c < 16) { S1.u.pm = c >> 1; S1.u.pn = c & 1; pg8::Gemm g{(const bf16_t*)(ws + WS_MEMN), (const bf16_t*)(ws + WS_WKV), 1024, 1024, 1024}; pg8::EpiPlain E{(bf16_t*)(ws + WS_KMEM), 512}; pg8::gemm_phase(lds, g, S1, E); } \
                    else { S1.u.pm = (c - 16) >> 3; S1.u.pn = (c - 16) & 7; pg8::Gemm g{(const bf16_t*)(ws + WS_WKV) + (size_t)512 * 1024, (const bf16_t*)(ws + WS_MEMN), 1024, 1024, 1024}; pg8::EpiPlain E{(bf16_t*)(ws + WS_VMEMT), 2048}; pg8::gemm_phase(lds, g, S1, E); } \
                    asm volatile("s_waitcnt vmcnt(0)" ::: "memory"); __syncthreads(); \
                    if (tid == 0) { __builtin_amdgcn_fence(__ATOMIC_RELEASE, "agent"); asm volatile("s_waitcnt vmcnt(0)" ::: "memory"); __hip_atomic_fetch_add(kvcnt, 1u, __ATOMIC_RELAXED, __HIP_MEMORY_SCOPE_AGENT); } \
                } \
                bool kv_ok = false; \
                for (int it = c; it < 1024 * REP_POOL + 512 * REP_ATTN; it += GG) { \
                    if (it < 1024 * REP_POOL) pool_item(a, lds, it & 1023); \
                    else { \
                        if (!kv_ok) { if (tid == 0) { unsigned sp = 0; while (__hip_atomic_load(kvcnt, __ATOMIC_RELAXED, __HIP_MEMORY_SCOPE_AGENT) < 32u) { __builtin_amdgcn_s_sleep(2); if (++sp > (1u << 20)) break; } \
                                __builtin_amdgcn_fence(__ATOMIC_ACQUIRE, "agent"); asm volatile("s_waitcnt vmcnt(0)" ::: "memory"); } __syncthreads(); kv_ok = true; } \
                        attn_item(a, lds, (it - 1024 * REP_POOL) & 511); } } } \
        } else { \
            for (int it = bx; it < 32; it += G) { pg8::OneUnit S1; \
                    if (it < 16) { S1.u.pm = it >> 1; S1.u.pn = it & 1; pg8::Gemm g{(const bf16_t*)(ws + WS_MEMN), (const bf16_t*)(ws + WS_WKV), 1024, 1024, 1024}; pg8::EpiPlain E{(bf16_t*)(ws + WS_KMEM), 512}; pg8::gemm_phase(lds, g, S1, E); } \
                    else { S1.u.pm = (it - 16) >> 3; S1.u.pn = (it - 16) & 7; pg8::Gemm g{(const bf16_t*)(ws + WS_WKV) + (size_t)512 * 1024, (const bf16_t*)(ws + WS_MEMN), 1024, 1024, 1024}; pg8::EpiPlain E{(bf16_t*)(ws + WS_VMEMT), 2048}; pg8::gemm_phase(lds, g, S1, E); } } \
            xcd_barrier(xbar); \
            for (int it = bx; it < 64 + 512 + 1024; it += G) { if (it < 64) scan_bh(a, lds, it); else if (it < 576) attn_item(a, lds, it - 64); else pool_item(a, lds, it - 576); } \
        } \
    }
#define P5_BODY \
    if (IN(5)) { \
        pg8::StaticOrder SO; SO.init(M, 1024, G, bx); \
        pg8::OneUnit S1; \
        if (SO.next(0, S1.u)) { \
            bf16_t* Y = (bf16_t*)(ws + WS_Y); const bf16_t* YC = (const bf16_t*)a.out; const bf16_t* GT = (const bf16_t*)(ws + WS_GATE); \
            {   pg8::Gemm g{YC, (const bf16_t*)(ws + WS_WP), 2048, 512, 512}; pg8::EpiProj<0> E{GT, Y}; pg8::gemm_phase(lds, g, S1, E); } \
            {   pg8::Gemm g{YC + 512, (const bf16_t*)(ws + WS_WD), 2048, 1024, 1024}; pg8::EpiProj<1> E{GT, Y}; pg8::gemm_phase(lds, g, S1, E); } \
            {   pg8::Gemm g{YC + 1536, (const bf16_t*)(ws + WS_WM), 2048, 512, 512}; pg8::EpiProj<2> E{GT, Y}; pg8::gemm_phase(lds, g, S1, E); } \
        } \
    }
__global__ void __launch_bounds__(512, 2) hybrid_fwd(Args a) {
    extern __shared__ __attribute__((aligned(16))) unsigned char lds_raw[];
    LAS unsigned char* lds = (LAS unsigned char*)lds_raw;
    const int G = gridDim.x, bx = blockIdx.x, tid = threadIdx.x;
    unsigned char* ws = a.ws;
    const int lo = a.ph_lo, hi = a.ph_hi;
    volatile LAS unsigned* xst = (volatile LAS unsigned*)(lds + LDS_BYTES - 16);
    if (tid < 4) xst[tid] = 0u;
    __syncthreads();
    XcdBarrier xbar; xbar.bar = (unsigned*)(ws + WS_CTL); xbar.x = 0; xbar.st = xst;
    if (hi - lo > 1) xbar = xcd_barrier_post((unsigned*)(ws + WS_CTL), xst);
    if (lo == 0x7fffffff) cg::this_grid().sync();
#define IN(k) (lo <= (k) && (k) < hi)
#define SEAM(k) do { if (IN(k) && IN((k) + 1)) xcd_barrier(xbar); } while (0)
    P0_BODY
#if REP_P0 > 1
    xcd_barrier(xbar);
    P0_BODY
#endif
    SEAM(0);
    P1_BODY
#if REP_P1 > 1
    xcd_barrier(xbar);
    P1_BODY
#endif
    SEAM(1);
#ifndef NO_P2
    if (IN(2)) { u32x4 raw[11]; float gpre = 0.f, bpre = 0.f; if (bx < 2048) { chunk_load_raw(a, bx, raw, tid); if (tid < 64) { const int n2 = bx & 31, h2 = (bx >> 5) & 7, b2 = bx >> 8; const int r2 = b2 * SEQ + 64 * n2; gpre = ((const float*)(ws + WS_G))[(size_t)(r2 + tid) * 8 + h2]; bpre = ((const float*)(ws + WS_BETA))[(size_t)(r2 + tid) * 8 + h2]; } }
        for (int it = bx; it < 2048; it += G) chunk_prep_item(a, lds, it, raw, (it + G < 2048) ? it + G : -1, gpre, bpre); }
#endif
    SEAM(2);
    P3_BODY
#if REP_P3 > 1
    xcd_barrier(xbar);
    P3_BODY
#endif
    SEAM(3);
    if (IN(4)) {
        {   pg8::Gemm g{(const bf16_t*)(ws + WS_H), (const bf16_t*)(ws + WS_WT) + (size_t)4096 * 1024, 1024, 1024, 1024}; pg8::StaticOrder S; S.init(M, 2048, G, bx);
            pg8::EpiZ E{(bf16_t*)a.out, (const float*)(ws + WS_SUMSQ)}; pg8::gemm_phase(lds, g, S, E); }
        {   pg8::Gemm g{(const bf16_t*)(ws + WS_H), (const bf16_t*)(ws + WS_WT) + (size_t)6144 * 1024, 1024, 1024, 1024}; pg8::StaticOrder S; S.init(M, 3072, G, bx);
            pg8::EpiGate E{(bf16_t*)(ws + WS_GATE)}; pg8::gemm_phase(lds, g, S, E); }
    }
    SEAM(4);
    P5_BODY
#if REP_P5 > 1
    xcd_barrier(xbar);
    P5_BODY
#endif
    SEAM(5);
    if (IN(6)) {
        pg8::Gemm g{(const bf16_t*)(ws + WS_Y), (const bf16_t*)(ws + WS_WOUT), 1024, 1024, 1024}; pg8::StaticOrder S; S.init(M, 1024, G, bx);
        pg8::EpiOutNorm E{a.out, a.x, a.post_w, (float*)(ws + WS_ROWSS), (unsigned*)(ws + WS_CTL) + 4096};
        pg8::gemm_phase(lds, g, S, E);
    }
#undef IN
#undef SEAM
}

extern "C" void kernel_launch(void* const* d_in, const int* in_sizes, int n_in, void* d_out, int out_size, void* d_ws, size_t ws_size, hipStream_t stream) {
    static int grid = 0;
    if (grid == 0) {
        if (n_in != 17 || out_size != M * DM || ws_size < WS_END) { fprintf(stderr, "kernel_launch: unexpected shapes (n_in %d out %d ws %zu)\n", n_in, out_size, ws_size); grid = -1; return; }
        int dev = 0, cus = 0, per_cu = 0;
        hipGetDevice(&dev); hipDeviceGetAttribute(&cus, hipDeviceAttributeMultiprocessorCount, dev);
        if (hipFuncSetAttribute((const void*)hybrid_fwd, hipFuncAttributeMaxDynamicSharedMemorySize, LDS_BYTES) != hipSuccess) { fprintf(stderr, "kernel_launch: hipFuncSetAttribute failed\n"); grid = -1; return; }
        if (hipOccupancyMaxActiveBlocksPerMultiprocessor(&per_cu, (const void*)hybrid_fwd, 512, LDS_BYTES) != hipSuccess || per_cu < 1) { fprintf(stderr, "kernel_launch: occupancy query gives %d\n", per_cu); per_cu = 1; }
        (void)hipGetLastError();
        grid = cus * 1;
        if (grid > 256) grid = 256;
    }
    if (grid < 0) return;
    Args a{};
    a.x = (const float*)d_in[0]; a.mem = (const float*)d_in[1]; a.pre_w = (const float*)d_in[2]; a.mem_w = (const float*)d_in[3]; a.w_in = (const float*)d_in[4];
    a.conv_w = (const float*)d_in[5]; a.a_log = (const float*)d_in[6]; a.dt_bias = (const float*)d_in[7]; a.dn_w = (const float*)d_in[8]; a.mix_w = (const float*)d_in[9];
    a.pool_scale = (const float*)d_in[10]; a.w_kv = (const float*)d_in[11]; a.w_pp = (const float*)d_in[12]; a.w_pd = (const float*)d_in[13]; a.w_pm = (const float*)d_in[14];
    a.w_out = (const float*)d_in[15]; a.post_w = (const float*)d_in[16];
    a.out = (float*)d_out; a.ws = (unsigned char*)d_ws;
#if MK_PER_PHASE
    for (int p = 0; p < 7; ++p) { a.ph_lo = p; a.ph_hi = p + 1; hipLaunchKernelGGL(hybrid_fwd, dim3(grid), dim3(512), LDS_BYTES, stream, a); }
#else
    a.ph_lo = 0; a.ph_hi = 7;
    if (hipMemsetAsync((char*)d_ws + WS_CTL, 0, 65536, stream) != hipSuccess) { fprintf(stderr, "kernel_launch: memset of the barrier words failed\n"); return; }
    void* args[] = {&a};
    hipError_t e = hipLaunchCooperativeKernel((const void*)hybrid_fwd, dim3(grid), dim3(512), args, LDS_BYTES, stream);
    if (e != hipSuccess) fprintf(stderr, "kernel_launch: cooperative launch failed: %s (grid %d)\n", hipGetErrorString(e), grid);
#endif
}
```

```cpp
#include <hip/hip_runtime.h>
#include <hip/hip_cooperative_groups.h>
#include <cstdio>
#include <cstdint>
namespace cg = cooperative_groups;

#ifndef MK_PER_PHASE
#define MK_PER_PHASE 0
#endif

#define LAS __attribute__((address_space(3)))
typedef unsigned short bf16_t;
typedef short bf16x8 __attribute__((ext_vector_type(8)));
typedef float f32x4 __attribute__((ext_vector_type(4)));
typedef unsigned u32x4 __attribute__((ext_vector_type(4)));
typedef unsigned u32x2 __attribute__((ext_vector_type(2)));

constexpr int DM = 1024, NB = 8, SEQ = 2048, M = NB * SEQ, INW = 9232, MEML = 256;
constexpr float EPS = 1e-6f;
constexpr size_t MiB = 1u << 20;
constexpr size_t WS_WT = 0;
constexpr size_t WS_WKV = 18 * MiB;
constexpr size_t WS_WP = 20 * MiB;
constexpr size_t WS_WD = 21 * MiB;
constexpr size_t WS_WM = 23 * MiB;
constexpr size_t WS_WOUT = 24 * MiB;
constexpr size_t WS_WMIX = 26 * MiB;
constexpr size_t WS_G = 26 * MiB + 256 * 1024;
constexpr size_t WS_BETA = WS_G + 512 * 1024;
constexpr size_t WS_ROWSS = WS_BETA + 512 * 1024;
constexpr size_t WS_GL = WS_ROWSS + 64 * 1024;
constexpr size_t WS_SUMSQ = 27 * MiB + 384 * 1024;
constexpr size_t WS_H = 28 * MiB;
constexpr size_t WS_MEMN = 60 * MiB;
constexpr size_t WS_KMEM = 64 * MiB;
constexpr size_t WS_VMEMT = 66 * MiB;
constexpr size_t WS_XA = 68 * MiB;
constexpr size_t WS_QM = 84 * MiB;
constexpr size_t WS_QKV = 100 * MiB;
constexpr size_t WS_HALO = 196 * MiB;
constexpr size_t WS_U = 201 * MiB;
constexpr size_t WS_AQK = 233 * MiB;
constexpr size_t WS_CTL = 250 * MiB;
constexpr size_t WS_END = 251 * MiB;
constexpr size_t WS_Y = WS_XA;
constexpr size_t WS_GATE = WS_QKV;
constexpr int LDS_BYTES = 147456;

__device__ __forceinline__ unsigned f2bf(float f) { unsigned u = __float_as_uint(f); return (u + 0x7fffu + ((u >> 16) & 1u)) >> 16; }
typedef __bf16 bf16x2_t __attribute__((ext_vector_type(2)));
typedef float f32x2_t __attribute__((ext_vector_type(2)));
__device__ __forceinline__ unsigned pk2(float lo, float hi) { f32x2_t v = {lo, hi}; bf16x2_t b = __builtin_convertvector(v, bf16x2_t); return __builtin_bit_cast(unsigned, b); }
__device__ __forceinline__ float bflo(unsigned u) { return __uint_as_float(u << 16); }
__device__ __forceinline__ float bfhi(unsigned u) { return __uint_as_float(u & 0xffff0000u); }
__device__ __forceinline__ unsigned cvt_pk_bf16(float lo, float hi) { unsigned r; asm volatile("v_cvt_pk_bf16_f32 %0, %1, %2" : "=v"(r) : "v"(lo), "v"(hi)); return r; }
__device__ __forceinline__ float silu_f(float z) { return z * __builtin_amdgcn_rcpf(1.f + __expf(-z)); }
__device__ __forceinline__ float sigm_f(float z) { return __builtin_amdgcn_rcpf(1.f + __expf(-z)); }
#define LDS_WAIT() asm volatile("s_waitcnt lgkmcnt(0)" ::: "memory")
#define MFMA16(a, b, c) __builtin_amdgcn_mfma_f32_16x16x32_bf16((a), (b), (c), 0, 0, 0)

namespace pg8 {
constexpr int BM = 256, BK = 64, HALF = 128, HTB = HALF * BK * 2, STAGE_BYTES = 8 * HTB, NXCD = 8, WGM = 8;
__host__ __device__ __forceinline__ int lds_byte(int r, int c) { const int st = (r >> 4) * 2 + (c >> 5), rr = r & 15, cc = c & 31, ob = rr * 64 + cc * 2; return st * 1024 + (ob ^ (((ob >> 9) & 1) << 5)); }
__host__ __device__ __forceinline__ void stage_rc(int b, int& R, int& C) { const int st = b / 1024, sb = b % 1024, swz = sb ^ (((sb >> 9) & 1) << 5); R = (st >> 1) * 16 + swz / 64; C = (st & 1) * 32 + (swz % 64) / 2; }
__host__ __device__ __forceinline__ int perm32(int rho) { const int n = rho >> 4, i = rho & 15; return 8 * (i >> 2) + 4 * n + (i & 3); }
struct Unit { int pm, pn; };
struct Gemm { const bf16_t* A; const bf16_t* Bt; int lda, ldb, K; };
struct StaticOrder {
    int nM, nN, nwg, G, c;
    __device__ void init(int Mr, int Nc, int G_, int c_) { nM = Mr / BM; nN = Nc / BM; nwg = nM * nN; G = G_; c = c_; }
    __device__ bool next(int i, Unit& u) const {
        const long L = (long)i * G + c; if (L >= nwg) return false;
        int wgid = (int)L; { const int q = nwg / NXCD, r = nwg % NXCD, xcd = wgid % NXCD, off = wgid / NXCD; wgid = (xcd < r ? xcd * (q + 1) : r * (q + 1) + (xcd - r) * q) + off; }
        const int nig = WGM * nN, gid = wgid / nig, fm = gid * WGM, gsz = (nM - fm) < WGM ? (nM - fm) : WGM;
        u.pm = fm + ((wgid % nig) % gsz); u.pn = (wgid % nig) / gsz; return true;
    }
};
struct OneUnit {
    Unit u;
    __device__ bool next(int i, Unit& o) const { if (i) return false; o = u; return true; }
};

template <class Epi, class Sched>
__device__ __forceinline__ void gemm_phase(LAS unsigned char* lds, const Gemm g, const Sched& S, const Epi& E) {
    int tid_ = threadIdx.x; asm volatile("" : "+v"(tid_));
    const int tid = tid_, wid = __builtin_amdgcn_readfirstlane(tid >> 6), lane = tid & 63, wr = wid >> 2, wc = wid & 3, fr = lane & 15, fq = lane >> 4;
    const int K = g.K, nt = K / BK;
    unsigned voffA[2], voffB[2];
#pragma unroll
    for (int i = 0; i < 2; ++i) { int R, C; stage_rc(tid * 16 + i * 8192, R, C); const int Rb = (R & ~31) + perm32(R & 31);
        voffA[i] = (unsigned)(R * g.lda + C) * 2u; voffB[i] = (unsigned)(Rb * g.ldb + C) * 2u; }
    const size_t kstep = (size_t)(BK * 2);
    const size_t hstepA = (size_t)HALF * g.lda * 2, hstepB = (size_t)HALF * g.ldb * 2;
    const size_t tstepA = 2 * hstepA, tstepB = 2 * hstepB;
    const unsigned ldsw = (unsigned)wid * 1024u;
    const int aoff = lds_byte(wr * 64 + fr, fq * 8), boff = lds_byte(wc * 32 + fr, fq * 8);
#define PG8_SA(b, h) (((b) * 2 + (h)) * HTB)
#define PG8_SB(b, h) ((4 + (b) * 2 + (h)) * HTB)
#define PG8_STAGE(bufoff, gbase, voff) do { _Pragma("unroll") for (int _i = 0; _i < 2; ++_i) \
        __builtin_amdgcn_global_load_lds((const unsigned*)((const char*)(gbase) + (voff)[_i]), (LAS unsigned*)(lds + (bufoff) + ldsw + _i * 8192), 16, 0, 0); } while (0)
#define PG8_LDA(dst, b, h) do { _Pragma("unroll") for (int m = 0; m < 4; ++m) _Pragma("unroll") for (int k = 0; k < 2; ++k) dst[m][k] = *(const LAS bf16x8*)(lds + PG8_SA(b, h) + aoff + m * 2048 + k * 1024); } while (0)
#define PG8_LDB(dst, b, h) do { _Pragma("unroll") for (int n = 0; n < 2; ++n) _Pragma("unroll") for (int k = 0; k < 2; ++k) dst[n][k] = *(const LAS bf16x8*)(lds + PG8_SB(b, h) + boff + n * 2048 + k * 1024); } while (0)
#define PG8_MMA(ai, bj, At, Bt) do { __builtin_amdgcn_s_setprio(1); _Pragma("unroll") for (int m = 0; m < 4; ++m) _Pragma("unroll") for (int n = 0; n < 2; ++n) _Pragma("unroll") for (int k = 0; k < 2; ++k) \
        acc[ai][bj][m][n] = __builtin_amdgcn_mfma_f32_16x16x32_bf16(Bt[n][k], At[m][k], acc[ai][bj][m][n], 0, 0, 0); __builtin_amdgcn_s_setprio(0); } while (0)
#define PG8_WAIT_V(n) asm volatile("s_waitcnt vmcnt(" #n ")" ::: "memory")
#define PG8_WAIT_L(n) asm volatile("s_waitcnt lgkmcnt(" #n ")" ::: "memory")
#define PG8_BAR __builtin_amdgcn_s_barrier()
#define PG8_SCHED __builtin_amdgcn_sched_barrier(0)
    Unit cur, nxt; int ui = 0;
    if (!S.next(0, cur)) return;
    f32x4 acc[2][2][4][2];
#pragma unroll
    for (int a = 0; a < 2; ++a)
#pragma unroll
        for (int b = 0; b < 2; ++b)
#pragma unroll
            for (int m = 0; m < 4; ++m)
#pragma unroll
                for (int n = 0; n < 2; ++n) acc[a][b][m][n] = (f32x4){0.f, 0.f, 0.f, 0.f};
    bf16x8 At[4][2], B0[2][2], B1[2][2];
    const char* cA = (const char*)g.A + (size_t)cur.pm * tstepA; const char* cB = (const char*)g.Bt + (size_t)cur.pn * tstepB;
    {
        PG8_STAGE(PG8_SB(0, 0), cB, voffB); PG8_STAGE(PG8_SB(0, 1), cB + hstepB, voffB); PG8_STAGE(PG8_SA(0, 0), cA, voffA); PG8_STAGE(PG8_SA(0, 1), cA + hstepA, voffA);
        if (wr == 1) PG8_BAR;
        PG8_WAIT_V(2); PG8_BAR;
        PG8_STAGE(PG8_SB(1, 0), cB + kstep, voffB); PG8_STAGE(PG8_SA(1, 0), cA + kstep, voffA); PG8_STAGE(PG8_SB(1, 1), cB + hstepB + kstep, voffB);
        PG8_WAIT_V(6); PG8_BAR;
    }
    for (;;) {
        const bool has_next = S.next(ui + 1, nxt);
        const char* nA = has_next ? (const char*)g.A + (size_t)nxt.pm * tstepA : cA; const char* nB = has_next ? (const char*)g.Bt + (size_t)nxt.pn * tstepB : cB;
        for (int t = 0; t < nt; t += 2) {
            const bool last = (t == nt - 2);
            const char* a1 = cA + (size_t)(t + 1) * kstep;
            const char* a2 = last ? nA : cA + (size_t)(t + 2) * kstep; const char* b2 = last ? nB : cB + (size_t)(t + 2) * kstep;
            const char* a3 = a2 + kstep; const char* b3 = b2 + kstep;
            PG8_LDB(B0, 0, 0); PG8_LDB(B1, 0, 1); PG8_SCHED; PG8_LDA(At, 0, 0); PG8_STAGE(PG8_SA(1, 1), a1 + hstepA, voffA);
            PG8_WAIT_V(8); PG8_WAIT_L(0); PG8_BAR; PG8_MMA(0, 0, At, B0); PG8_MMA(0, 1, At, B1); PG8_BAR; PG8_SCHED;
            PG8_LDA(At, 0, 1); PG8_STAGE(PG8_SB(0, 0), b2, voffB); PG8_STAGE(PG8_SB(0, 1), b2 + hstepB, voffB); PG8_STAGE(PG8_SA(0, 0), a2, voffA);
            PG8_WAIT_V(8); PG8_WAIT_L(0); PG8_BAR; PG8_MMA(1, 0, At, B0); PG8_MMA(1, 1, At, B1); PG8_BAR; PG8_SCHED;
            PG8_LDB(B0, 1, 0); PG8_LDB(B1, 1, 1); PG8_SCHED; PG8_LDA(At, 1, 0); PG8_STAGE(PG8_SA(0, 1), a2 + hstepA, voffA);
            PG8_WAIT_V(8); PG8_WAIT_L(0); PG8_BAR; PG8_MMA(0, 0, At, B0); PG8_MMA(0, 1, At, B1); PG8_BAR; PG8_SCHED;
            PG8_LDA(At, 1, 1); PG8_STAGE(PG8_SB(1, 0), b3, voffB); PG8_STAGE(PG8_SB(1, 1), b3 + hstepB, voffB); PG8_STAGE(PG8_SA(1, 0), a3, voffA);
            PG8_WAIT_V(8); PG8_WAIT_L(0); PG8_BAR; PG8_MMA(1, 0, At, B0); PG8_MMA(1, 1, At, B1); PG8_BAR; PG8_SCHED;
        }
        if (wr == 0) PG8_BAR;
        E(acc, cur, wr, wc, fr, fq);
        if (!has_next) break;
#pragma unroll
        for (int a = 0; a < 2; ++a)
#pragma unroll
            for (int b = 0; b < 2; ++b)
#pragma unroll
                for (int m = 0; m < 4; ++m)
#pragma unroll
                    for (int n = 0; n < 2; ++n) acc[a][b][m][n] = (f32x4){0.f, 0.f, 0.f, 0.f};
        cur = nxt; cA = nA; cB = nB; ++ui;
        if (wr == 1) PG8_BAR;
    }
    PG8_WAIT_V(0);
    PG8_BAR;
#undef PG8_SA
#undef PG8_SB
#undef PG8_STAGE
#undef PG8_LDA
#undef PG8_LDB
#undef PG8_MMA
#undef PG8_WAIT_V
#undef PG8_WAIT_L
#undef PG8_BAR
#undef PG8_SCHED
}

typedef const f32x4 (&AccRef)[2][2][4][2];
__device__ __forceinline__ u32x4 pack8(f32x4 v0, f32x4 v1) { u32x4 w; w.x = pk2(v0[0], v0[1]); w.y = pk2(v0[2], v0[3]); w.z = pk2(v1[0], v1[1]); w.w = pk2(v1[2], v1[3]); return w; }

struct EpiPlain {
    bf16_t* O; int ldc;
    __device__ __forceinline__ void operator()(AccRef acc, const Unit& u, int wr, int wc, int fr, int fq) const {
        const int row0 = u.pm * BM + wr * 64 + fr, col0 = u.pn * BM + wc * 32 + 8 * fq;
#pragma unroll
        for (int ai = 0; ai < 2; ++ai)
#pragma unroll
            for (int m = 0; m < 4; ++m) { bf16_t* rowp = O + (size_t)(row0 + ai * HALF + m * 16) * ldc + col0;
#pragma unroll
                for (int bj = 0; bj < 2; ++bj) *(u32x4*)(rowp + bj * HALF) = pack8(acc[ai][bj][m][0], acc[ai][bj][m][1]); }
    }
};
struct EpiStage1 {
    bf16_t *xa, *qm, *qkv, *halo;
    __device__ __forceinline__ void operator()(AccRef acc, const Unit& u, int wr, int wc, int fr, int fq) const {
        const int pn = u.pn; bf16_t* base; int ldc, colt;
        if (pn < 2) { base = xa; ldc = 512; colt = pn * 256; }
        else if (pn < 4) { base = qm; ldc = 512; colt = (pn - 2) * 256; }
        else { const int t = (pn - 4) >> 2; base = qkv + (size_t)t * M * 1024; ldc = 1024; colt = ((pn - 4) & 3) * 256; }
        const int row0 = u.pm * BM + wr * 64 + fr, col0 = colt + wc * 32 + 8 * fq;
#pragma unroll
        for (int ai = 0; ai < 2; ++ai)
#pragma unroll
            for (int m = 0; m < 4; ++m) { const int row = row0 + ai * HALF + m * 16; bf16_t* rowp = base + (size_t)row * ldc + col0;
#pragma unroll
                for (int bj = 0; bj < 2; ++bj) { const u32x4 w = pack8(acc[ai][bj][m][0], acc[ai][bj][m][1]);
                    *(u32x4*)(rowp + bj * HALF) = w;
                    if (m == 3 && pn >= 4 && fr >= 13) *(u32x4*)(halo + ((size_t)(row >> 6) * 3 + (fr - 13)) * 3072 + (pn - 4) * 256 + bj * HALF + wc * 32 + 8 * fq) = w; } }
    }
};
struct EpiZ {
    bf16_t* Y; const float* SUMSQ;
    __device__ __forceinline__ void operator()(AccRef acc, const Unit& u, int wr, int wc, int fr, int fq) const {
        int tid = threadIdx.x; asm volatile("" : "+v"(tid)); fr = tid & 15; fq = (tid >> 4) & 3;
        const int row0 = u.pm * BM + wr * 64 + fr, col0 = u.pn * BM + wc * 32 + 8 * fq;
        const bool isdn = (col0 >= 512) && (col0 < 1536); const int hd = isdn ? ((col0 - 512) >> 7) : 0;
#pragma unroll
        for (int ai = 0; ai < 2; ++ai)
#pragma unroll
            for (int mh = 0; mh < 2; ++mh) {
                u32x4 o[2][2]; float sq[2][2];
#pragma unroll
                for (int mm = 0; mm < 2; ++mm)
#pragma unroll
                    for (int bj = 0; bj < 2; ++bj) { const size_t row = (size_t)(row0 + ai * HALF + (2 * mh + mm) * 16);
                        o[mm][bj] = *(const u32x4*)(Y + row * 2048 + col0 + bj * HALF); sq[mm][bj] = SUMSQ[row * 8 + (isdn ? hd + bj : 0)]; }
#pragma unroll
                for (int mm = 0; mm < 2; ++mm)
#pragma unroll
                    for (int bj = 0; bj < 2; ++bj) { const int m = 2 * mh + mm; const size_t row = (size_t)(row0 + ai * HALF + m * 16);
                        const f32x4 a0 = acc[ai][bj][m][0], a1 = acc[ai][bj][m][1]; const u32x4 ov = o[mm][bj];
                        const float fac = isdn ? (1.0f / sqrtf(sq[mm][bj] * (1.f / 128.f) + EPS)) : 1.f;
                        f32x4 v0, v1;
                        v0[0] = bflo(ov.x) * silu_f(a0[0]); v0[1] = bfhi(ov.x) * silu_f(a0[1]); v0[2] = bflo(ov.y) * silu_f(a0[2]); v0[3] = bfhi(ov.y) * silu_f(a0[3]);
                        v1[0] = bflo(ov.z) * silu_f(a1[0]); v1[1] = bfhi(ov.z) * silu_f(a1[1]); v1[2] = bflo(ov.w) * silu_f(a1[2]); v1[3] = bfhi(ov.w) * silu_f(a1[3]);
                        *(u32x4*)(Y + row * 2048 + col0 + bj * HALF) = pack8(v0 * fac, v1 * fac); }
                asm volatile("" ::: "memory"); __builtin_amdgcn_sched_barrier(0);
            }
    }
};
struct EpiGate {
    bf16_t* GATE;
    __device__ __forceinline__ void operator()(AccRef acc, const Unit& u, int wr, int wc, int fr, int fq) const {
        int tid = threadIdx.x; asm volatile("" : "+v"(tid)); fr = tid & 15; fq = (tid >> 4) & 3;
        const int row0 = u.pm * BM + wr * 64 + fr, col0 = u.pn * BM + wc * 32 + 8 * fq;
#pragma unroll
        for (int ai = 0; ai < 2; ++ai)
#pragma unroll
            for (int m = 0; m < 4; ++m) { bf16_t* rowp = GATE + (size_t)(row0 + ai * HALF + m * 16) * 3072 + col0;
#pragma unroll
                for (int bj = 0; bj < 2; ++bj) { const f32x4 a0 = acc[ai][bj][m][0], a1 = acc[ai][bj][m][1]; f32x4 v0, v1;
#pragma unroll
                    for (int e = 0; e < 4; ++e) { v0[e] = sigm_f(a0[e]); v1[e] = sigm_f(a1[e]); }
                    *(u32x4*)(rowp + bj * HALF) = pack8(v0, v1); } }
    }
};
template <int BR> struct EpiProj {
    const bf16_t* GATE; bf16_t* Y;
    __device__ __forceinline__ void operator()(AccRef acc, const Unit& u, int wr, int wc, int fr, int fq) const {
        int tid = threadIdx.x; asm volatile("" : "+v"(tid)); fr = tid & 15; fq = (tid >> 4) & 3;
        const int row0 = u.pm * BM + wr * 64 + fr, col0 = u.pn * BM + wc * 32 + 8 * fq;
#pragma unroll
        for (int ai = 0; ai < 2; ++ai)
#pragma unroll
            for (int mh = 0; mh < 2; ++mh) {
                u32x4 gq[2][2], yo[2][2];
#pragma unroll
                for (int mm = 0; mm < 2; ++mm)
#pragma unroll
                    for (int bj = 0; bj < 2; ++bj) { const size_t row = (size_t)(row0 + ai * HALF + (2 * mh + mm) * 16);
                        gq[mm][bj] = *(const u32x4*)(GATE + row * 3072 + BR * 1024 + col0 + bj * HALF);
                        if (BR > 0) yo[mm][bj] = *(const u32x4*)(Y + row * 1024 + col0 + bj * HALF); }
#pragma unroll
                for (int mm = 0; mm < 2; ++mm)
#pragma unroll
                    for (int bj = 0; bj < 2; ++bj) { const int m = 2 * mh + mm; const size_t row = (size_t)(row0 + ai * HALF + m * 16);
                        const f32x4 a0 = acc[ai][bj][m][0], a1 = acc[ai][bj][m][1]; const u32x4 g4 = gq[mm][bj];
                        f32x4 v0, v1;
                        v0[0] = bflo(g4.x) * a0[0]; v0[1] = bfhi(g4.x) * a0[1]; v0[2] = bflo(g4.y) * a0[2]; v0[3] = bfhi(g4.y) * a0[3];
                        v1[0] = bflo(g4.z) * a1[0]; v1[1] = bfhi(g4.z) * a1[1]; v1[2] = bflo(g4.w) * a1[2]; v1[3] = bfhi(g4.w) * a1[3];
                        if (BR > 0) { const u32x4 y4 = yo[mm][bj];
                            v0[0] += bflo(y4.x); v0[1] += bfhi(y4.x); v0[2] += bflo(y4.y); v0[3] += bfhi(y4.y); v1[0] += bflo(y4.z); v1[1] += bfhi(y4.z); v1[2] += bflo(y4.w); v1[3] += bfhi(y4.w); }
                        *(u32x4*)(Y + row * 1024 + col0 + bj * HALF) = pack8(v0, v1); }
                asm volatile("" ::: "memory"); __builtin_amdgcn_sched_barrier(0);
            }
    }
};
struct EpiOutNorm {
    float* O; const float* X; const float* PW; float* rowss; unsigned* cnt;
    __device__ __forceinline__ void operator()(AccRef acc, const Unit& u, int wr, int wc, int fr, int fq) const {
        int tid = threadIdx.x; asm volatile("" : "+v"(tid)); fr = tid & 15; fq = (tid >> 4) & 3;
        const int row0 = u.pm * BM + wr * 64 + fr, col0 = u.pn * BM + wc * 32 + 8 * fq;
#pragma unroll
        for (int ai = 0; ai < 2; ++ai)
#pragma unroll
            for (int m = 0; m < 4; ++m) { const int row = row0 + ai * HALF + m * 16; float ss = 0.f;
#pragma unroll
                for (int bj = 0; bj < 2; ++bj) { const f32x4 a0 = acc[ai][bj][m][0], a1 = acc[ai][bj][m][1];
                    ss += (a0[0] * a0[0] + a0[1] * a0[1]) + (a0[2] * a0[2] + a0[3] * a0[3]) + (a1[0] * a1[0] + a1[1] * a1[1]) + (a1[2] * a1[2] + a1[3] * a1[3]); }
                ss += __shfl_xor(ss, 16); ss += __shfl_xor(ss, 32);
                if (fq == 0) atomicAdd(rowss + row, ss); }
        asm volatile("s_waitcnt vmcnt(0)" ::: "memory");
        __syncthreads();
        if (threadIdx.x == 0) {
            __builtin_amdgcn_fence(__ATOMIC_RELEASE, "agent");
            asm volatile("s_waitcnt vmcnt(0)" ::: "memory");
            __hip_atomic_fetch_add(cnt + u.pm * 16, 1u, __ATOMIC_RELAXED, __HIP_MEMORY_SCOPE_AGENT);
            unsigned sp = 0;
            while (__hip_atomic_load(cnt + u.pm * 16, __ATOMIC_RELAXED, __HIP_MEMORY_SCOPE_AGENT) < 4u) { __builtin_amdgcn_s_sleep(1); if (++sp > (1u << 20)) break; }
            __builtin_amdgcn_fence(__ATOMIC_ACQUIRE, "agent");
            asm volatile("s_waitcnt vmcnt(0)" ::: "memory");
        }
        __syncthreads();
#pragma unroll
        for (int ai = 0; ai < 2; ++ai)
#pragma unroll
            for (int m = 0; m < 4; ++m) { const int row = row0 + ai * HALF + m * 16;
                const float rs = 1.0f / sqrtf(__hip_atomic_load(rowss + row, __ATOMIC_RELAXED, __HIP_MEMORY_SCOPE_AGENT) * (1.f / 1024.f) + EPS);
                f32x4 xv[2][2];
#pragma unroll
                for (int bj = 0; bj < 2; ++bj) { const size_t off = (size_t)row * 1024 + col0 + bj * HALF; xv[bj][0] = *(const f32x4*)(X + off); xv[bj][1] = *(const f32x4*)(X + off + 4); }
#pragma unroll
                for (int bj = 0; bj < 2; ++bj) { const size_t off = (size_t)row * 1024 + col0 + bj * HALF;
                    const f32x4 w0 = *(const f32x4*)(PW + col0 + bj * HALF), w1 = *(const f32x4*)(PW + col0 + bj * HALF + 4);
                    *(f32x4*)(O + off) = xv[bj][0] + acc[ai][bj][m][0] * rs * w0; *(f32x4*)(O + off + 4) = xv[bj][1] + acc[ai][bj][m][1] * rs * w1; }
                if (m & 1) { asm volatile("" ::: "memory"); __builtin_amdgcn_sched_barrier(0); } }
    }
};
}

#define XB_TMO      128
#define XB_XCNT(j)  (256  + 64 * (j))
#define XB_XSUB(j)  (1280 + 64 * (j))
#define XB_XGEN(j)  (2304 + 64 * (j))
#define XB_TOP      3328
#define XB_TOPGEN   3392
#define XCD_BAR_WORDS 3456
#define XB_SPIN_CAP (1u << 18)

__device__ __forceinline__ unsigned xb_ld(unsigned* p)              { return __hip_atomic_load(p, __ATOMIC_RELAXED, __HIP_MEMORY_SCOPE_AGENT); }
__device__ __forceinline__ unsigned xb_add(unsigned* p, unsigned v) { return __hip_atomic_fetch_add(p, v, __ATOMIC_RELAXED, __HIP_MEMORY_SCOPE_AGENT); }
__device__ __forceinline__ unsigned xb_xcc_id() { return (unsigned)__builtin_amdgcn_s_getreg((3 << 11) | 20) & 0xFu; }
#define XB_SPIN(cond, bar) do { unsigned _sp = 0; while (cond) { __builtin_amdgcn_s_sleep(1); \
    if ((++_sp & 255u) == 0u) { if (xb_ld(&(bar)[XB_TMO])) break; if (_sp > XB_SPIN_CAP) { atomicAdd(&(bar)[XB_TMO], 1u); break; } } } } while (0)

struct XcdBarrier {
    unsigned* bar; unsigned x;
    volatile LAS unsigned* st;
};

__device__ __forceinline__ XcdBarrier xcd_barrier_post(unsigned* bar, volatile LAS unsigned* st) {
    XcdBarrier b; b.bar = bar; b.x = xb_xcc_id(); b.st = st;
    if (threadIdx.x == 0) (void)xb_add(&bar[XB_XCNT(b.x)], 1u);
    return b;
}
__device__ __forceinline__ void xcd_barrier_complete(unsigned* bar, unsigned x, unsigned& nloc, unsigned& nx) {
    const unsigned G = gridDim.x * gridDim.y * gridDim.z;
    unsigned sum, cnt, mine, sp = 0u;
    for (;;) {
        sum = 0u; cnt = 0u; mine = 0u;
#pragma unroll
        for (unsigned j = 0; j < 16; ++j) { const unsigned c = xb_ld(&bar[XB_XCNT(j)]); sum += c; cnt += (c > 0u) ? 1u : 0u; mine = (j == x) ? c : mine; }
        if (sum == G) break;
        __builtin_amdgcn_s_sleep(1);
        if ((++sp & 255u) == 0u) { if (xb_ld(&bar[XB_TMO])) break; if (sp > XB_SPIN_CAP) { atomicAdd(&bar[XB_TMO], 1u); break; } }
    }
    nloc = mine > 0u ? mine : 1u; nx = cnt > 0u ? cnt : 1u;
}

__device__ __forceinline__ void xcd_barrier(const XcdBarrier& b) {
    asm volatile("s_waitcnt vmcnt(0)" ::: "memory");
    __syncthreads();
    if (threadIdx.x == 0) {
        unsigned* bar = b.bar;
        __builtin_amdgcn_s_waitcnt(0);
        unsigned nloc = b.st[0], nx = b.st[1];
        if (nloc == 0u) { xcd_barrier_complete(bar, b.x, nloc, nx); b.st[0] = nloc; b.st[1] = nx; }
        const unsigned old = xb_add(&bar[XB_XSUB(b.x)], 1u);
        const unsigned gen = old / nloc;
        if (old + 1u == (gen + 1u) * nloc) {
            __builtin_amdgcn_fence(__ATOMIC_RELEASE, "agent");
            asm volatile("s_waitcnt vmcnt(0)" ::: "memory");
            const unsigned og = xb_add(&bar[XB_TOP], 1u);
            const unsigned tg = og / nx;
            if (og + 1u == (tg + 1u) * nx) xb_add(&bar[XB_TOPGEN], 1u);
            else XB_SPIN(xb_ld(&bar[XB_TOPGEN]) == tg, bar);
            __builtin_amdgcn_fence(__ATOMIC_ACQUIRE, "agent");
            xb_add(&bar[XB_XGEN(b.x)], 1u);
            asm volatile("s_waitcnt vmcnt(0)" ::: "memory");
        } else {
            XB_SPIN(xb_ld(&bar[XB_XGEN(b.x)]) == gen, bar);
            __builtin_amdgcn_fence(__ATOMIC_ACQUIRE, "agent");
            asm volatile("s_waitcnt vmcnt(0)" ::: "memory");
        }
    }
    __syncthreads();
}


struct Args {
    const float *x, *mem, *pre_w, *mem_w, *w_in, *conv_w, *a_log, *dt_bias, *dn_w, *mix_w, *pool_scale, *w_kv, *w_pp, *w_pd, *w_pm, *w_out, *post_w;
    float* out; unsigned char* ws; int ph_lo, ph_hi;
};

__device__ __forceinline__ float wave_sum(float v) {
    v += __builtin_bit_cast(float, __builtin_amdgcn_update_dpp(0, __builtin_bit_cast(int, v), 0xB1, 0xF, 0xF, false));
    v += __builtin_bit_cast(float, __builtin_amdgcn_update_dpp(0, __builtin_bit_cast(int, v), 0x4E, 0xF, 0xF, false));
    v += __builtin_bit_cast(float, __builtin_amdgcn_update_dpp(0, __builtin_bit_cast(int, v), 0x124, 0xF, 0xF, false));
    v += __builtin_bit_cast(float, __builtin_amdgcn_update_dpp(0, __builtin_bit_cast(int, v), 0x128, 0xF, 0xF, false));
    const int vi = __builtin_bit_cast(int, v);
    const float s0 = __builtin_bit_cast(float, __builtin_amdgcn_readlane(vi, 0)), s1 = __builtin_bit_cast(float, __builtin_amdgcn_readlane(vi, 16));
    const float s2 = __builtin_bit_cast(float, __builtin_amdgcn_readlane(vi, 32)), s3 = __builtin_bit_cast(float, __builtin_amdgcn_readlane(vi, 48));
    return (s0 + s1) + (s2 + s3);
}

__device__ __forceinline__ void p0_transpose_item(const float* W, int ldw, int K, bf16_t* WT, LAS float* scr, int kb, int nb, int lane) {
    const int k0 = 64 * kb, n0 = 32 * nb;
    float tv[32];
#pragma unroll
    for (int i = 0; i < 32; ++i) tv[i] = W[(size_t)(k0 + 2 * i + (lane >> 5)) * ldw + n0 + (lane & 31)];
#pragma unroll
    for (int i = 0; i < 32; ++i) scr[(2 * i + (lane >> 5)) * 33 + (lane & 31)] = tv[i];
    LDS_WAIT();
    const int c = lane & 7;
#pragma unroll
    for (int j = 0; j < 4; ++j) { const int n = (lane >> 3) + 8 * j; const LAS float* s = scr + (8 * c) * 33 + n;
        u32x4 o; o.x = pk2(s[0 * 33], s[1 * 33]); o.y = pk2(s[2 * 33], s[3 * 33]); o.z = pk2(s[4 * 33], s[5 * 33]); o.w = pk2(s[6 * 33], s[7 * 33]);
        *(u32x4*)(WT + (size_t)(n0 + n) * K + k0 + 8 * c) = o; }
    LDS_WAIT();
}

__device__ __forceinline__ void p0_prologue(const Args& a, LAS unsigned char* lds) {
    int tid_ = threadIdx.x; asm volatile("" : "+v"(tid_));
    const int tid = tid_, lane = tid & 63, wave = tid >> 6, G = gridDim.x;
    unsigned char* ws = a.ws;
    LAS float* W16 = (LAS float*)lds;
    LAS float* scr = (LAS float*)(lds + 65536 + wave * 8448);
    for (int idx = tid; idx < 4096; idx += 512) { const int i = idx >> 2, q = idx & 3; const int p = ((i >> 8) * 4 + (i & 3)) * 64 + ((i >> 2) & 63);
        *(LAS f32x4*)(W16 + (q * 1024 + p) * 4) = *(const f32x4*)(a.w_in + (size_t)i * INW + 4096 + 4 * q); }
    for (int i = blockIdx.x * 512 + tid; i < M; i += G * 512) ((float*)(ws + WS_ROWSS))[i] = 0.f;
    for (int i = blockIdx.x * 512 + tid; i < M * 8; i += G * 512) ((float*)(ws + WS_SUMSQ))[i] = 0.f;
    __syncthreads();
    const int gw = blockIdx.x * 8 + wave, NGW = G * 8;
    bf16_t* WT = (bf16_t*)(ws + WS_WT);
#define SEG(src, ldw, Kk, Nseg, dst) { const int ni = ((Kk) / 64) * ((Nseg) / 32); if (r < ni) { const int nblk = (Nseg) / 32; p0_transpose_item((src), (ldw), (Kk), (dst), scr, r / nblk, r % nblk, lane); continue; } r -= ni; }
    constexpr int NITEMS = 16 * 128 + 512 + 32;
    for (int it = gw; it < NITEMS; it += NGW) {
        int r = it;
        SEG(a.w_in + 0, INW, 1024, 512, WT)
        SEG(a.w_in + 5136, INW, 1024, 512, WT + (size_t)512 * 1024)
        SEG(a.w_in + 1024, INW, 1024, 3072, WT + (size_t)1024 * 1024)
        SEG(a.w_kv, 1024, 1024, 1024, (bf16_t*)(ws + WS_WKV))
        SEG(a.mix_w + 0 * 16384, 128, 128, 128, (bf16_t*)(ws + WS_WMIX) + 0 * 16384)
        SEG(a.mix_w + 1 * 16384, 128, 128, 128, (bf16_t*)(ws + WS_WMIX) + 1 * 16384)
        SEG(a.mix_w + 2 * 16384, 128, 128, 128, (bf16_t*)(ws + WS_WMIX) + 2 * 16384)
        SEG(a.mix_w + 3 * 16384, 128, 128, 128, (bf16_t*)(ws + WS_WMIX) + 3 * 16384)
    }
    f32x4 nwx[4], nwm[4];
#pragma unroll
    for (int j = 0; j < 4; ++j) { nwx[j] = ((const f32x4*)a.pre_w)[lane + 64 * j]; nwm[j] = ((const f32x4*)a.mem_w)[lane + 64 * j]; }
    f32x4 vnx[4];
    {   const int m = gw; const float* src = (m >= M) ? a.mem + (size_t)(m - M) * 1024 : a.x + (size_t)m * 1024;
#pragma unroll
        for (int j = 0; j < 4; ++j) vnx[j] = ((const f32x4*)src)[lane + 64 * j]; }
    for (int m = gw; m < M + NB * MEML; m += NGW) {
        const bool is_mem = m >= M;
        bf16_t* dst = is_mem ? (bf16_t*)(ws + WS_MEMN) + (size_t)(m - M) * 1024 : (bf16_t*)(ws + WS_H) + (size_t)m * 1024;
        f32x4 v[4]; float s = 0.f;
#pragma unroll
        for (int j = 0; j < 4; ++j) { v[j] = vnx[j]; s += (v[j].x * v[j].x + v[j].y * v[j].y) + (v[j].z * v[j].z + v[j].w * v[j].w); }
        {   const int m2 = (m + NGW < M + NB * MEML) ? m + NGW : m; const float* src = (m2 >= M) ? a.mem + (size_t)(m2 - M) * 1024 : a.x + (size_t)m2 * 1024;
#pragma unroll
            for (int j = 0; j < 4; ++j) vnx[j] = ((const f32x4*)src)[lane + 64 * j]; }
        const float rstd = 1.0f / sqrtf(wave_sum(s) * (1.f / 1024.f) + EPS);
#pragma unroll
        for (int j = 0; j < 4; ++j) { const f32x4 wv = is_mem ? nwm[j] : nwx[j]; v[j] = v[j] * rstd * wv;
            u32x2 o; o.x = pk2(v[j].x, v[j].y); o.y = pk2(v[j].z, v[j].w); ((u32x2*)dst)[lane + 64 * j] = o; }
        if (!is_mem) {
            f32x4 acc[4];
#pragma unroll
            for (int q = 0; q < 4; ++q) acc[q] = (f32x4){0.f, 0.f, 0.f, 0.f};
#pragma unroll
            for (int j = 0; j < 4; ++j)
#pragma unroll
                for (int e = 0; e < 4; ++e) { const float xv = v[j][e];
#pragma unroll
                    for (int q = 0; q < 4; ++q) { const f32x4 wv = *(const LAS f32x4*)(W16 + (q * 1024 + (j * 4 + e) * 64 + lane) * 4); acc[q] += xv * wv; } }
            float val = 0.f;
#pragma unroll
            for (int q = 0; q < 4; ++q)
#pragma unroll
                for (int e = 0; e < 4; ++e) { const float t = wave_sum(acc[q][e]); if (lane == q * 4 + e) val = t; }
            if (lane < 8) { const float z = val + a.dt_bias[lane]; const float sp = z > 20.f ? z : log1pf(expf(z));
                ((float*)(ws + WS_G))[(size_t)m * 8 + lane] = -expf(a.a_log[lane]) * sp; }
            else if (lane < 16) ((float*)(ws + WS_BETA))[(size_t)m * 8 + lane - 8] = 1.f / (1.f + expf(-val));
        }
    }
}

__device__ __forceinline__ void late_transposes(const Args& a, LAS unsigned char* lds, int c, int GG) {
    int tid_ = threadIdx.x; asm volatile("" : "+v"(tid_));
    const int tid = tid_, lane = tid & 63, wave = tid >> 6;
    unsigned char* ws = a.ws; bf16_t* WT = (bf16_t*)(ws + WS_WT);
    LAS float* scr = (LAS float*)(lds + wave * 8448);
    __syncthreads();
    const int gw = c * 8 + wave, NGW = GG * 8;
    constexpr int NITEMS = 16 * 160 + 256 + 512 + 256 + 512;
    for (int it = gw; it < NITEMS; it += NGW) {
        int r = it;
        SEG(a.w_in + 512, INW, 1024, 512, WT + (size_t)4096 * 1024)
        SEG(a.w_in + 4112, INW, 1024, 1024, WT + (size_t)4608 * 1024)
        SEG(a.w_in + 5648, INW, 1024, 512, WT + (size_t)5632 * 1024)
        SEG(a.w_in + 6160, INW, 1024, 3072, WT + (size_t)6144 * 1024)
        SEG(a.w_pp, 1024, 512, 1024, (bf16_t*)(ws + WS_WP))
        SEG(a.w_pd, 1024, 1024, 1024, (bf16_t*)(ws + WS_WD))
        SEG(a.w_pm, 1024, 512, 1024, (bf16_t*)(ws + WS_WM))
        SEG(a.w_out, 1024, 1024, 1024, (bf16_t*)(ws + WS_WOUT))
    }
    __syncthreads();
}
#undef SEG

__device__ __forceinline__ void chunk_load_raw(const Args& a, int item, u32x4 (&raw)[11], int tid) {
    const int n = item & 31, h = (item >> 5) & 7, b = item >> 8; const int r0 = b * SEQ + 64 * n, gci = b * 32 + n;
    const int ten = tid >> 7, cgp = tid & 15, rg = (tid >> 4) & 7;
    if (tid < 384) {
        const bf16_t* src = (const bf16_t*)(a.ws + WS_QKV) + (size_t)ten * M * 1024 + h * 128 + cgp * 8;
#pragma unroll
        for (int i = 0; i < 11; ++i) { const int rr = 8 * rg - 3 + i;
            if (rr >= 0) raw[i] = *(const u32x4*)(src + (size_t)(r0 + rr) * 1024);
            else if (n > 0) raw[i] = *(const u32x4*)((const bf16_t*)(a.ws + WS_HALO) + ((size_t)(gci - 1) * 3 + (rr + 3)) * 3072 + ten * 1024 + h * 128 + cgp * 8);
            else raw[i] = (u32x4){0u, 0u, 0u, 0u}; }
    }
}
__device__ __forceinline__ void chunk_prep_item(const Args& a, LAS unsigned char* lds, int item, u32x4 (&raw)[11], int item_next, float& gpre, float& bpre) {
    int tid_ = threadIdx.x; asm volatile("" : "+v"(tid_));
    const int tid = tid_, lane = tid & 63, wid = tid >> 6, r16 = lane & 15, qp = lane >> 4;
    const int n = item & 31, h = (item >> 5) & 7, b = item >> 8;
    const int r0 = b * SEQ + 64 * n, gci = b * 32 + n;
    unsigned char* ws = a.ws;
    bf16_t* QKV = (bf16_t*)(ws + WS_QKV);
    LAS bf16_t* Kn = (LAS bf16_t*)(lds);
    LAS bf16_t* Qn = (LAS bf16_t*)(lds + 17408);
    LAS bf16_t* VbT = (LAS bf16_t*)(lds + 34816);
    LAS bf16_t* KbgT = (LAS bf16_t*)(lds + 53248);
    LAS bf16_t* Tb = (LAS bf16_t*)(lds + 71680);
    LAS float* Ap = (LAS float*)(lds + 80896);
    LAS float* gcs = (LAS float*)(lds + 98304);
    LAS float* bts = gcs + 64;
    __syncthreads();
    if (wid == 0) {
        float g = gpre;
        const float bt = bpre;
        if (item_next >= 0) { const int n2 = item_next & 31, h2 = (item_next >> 5) & 7, b2 = item_next >> 8; const int r2 = b2 * SEQ + 64 * n2;
            gpre = ((const float*)(ws + WS_G))[(size_t)(r2 + lane) * 8 + h2]; bpre = ((const float*)(ws + WS_BETA))[(size_t)(r2 + lane) * 8 + h2]; }
#pragma unroll
        for (int o = 1; o < 64; o <<= 1) { const float t = __shfl_up(g, o); if (lane >= o) g += t; }
        gcs[lane] = g; bts[lane] = bt;
        if (lane == 63) ((float*)(ws + WS_GL))[item] = __expf(g);
    }
    __syncthreads();
    u32x4 outA[8];
    const int ten = tid >> 7, cgp = tid & 15, rg = (tid >> 4) & 7;
    if (tid < 384) {
        f32x4 cw[4][2];
#pragma unroll
        for (int j = 0; j < 4; ++j) { const float* cp = a.conv_w + (size_t)j * 3072 + ten * 1024 + h * 128 + cgp * 8; cw[j][0] = *(const f32x4*)cp; cw[j][1] = *(const f32x4*)(cp + 4); }
        float y[8][8];
#pragma unroll
        for (int i = 0; i < 8; ++i) {
#pragma unroll
            for (int e = 0; e < 8; ++e) y[i][e] = 0.f;
#pragma unroll
            for (int j = 0; j < 4; ++j) { const u32x4 rv = raw[i + j];
                y[i][0] += cw[j][0][0] * bflo(rv.x); y[i][1] += cw[j][0][1] * bfhi(rv.x); y[i][2] += cw[j][0][2] * bflo(rv.y); y[i][3] += cw[j][0][3] * bfhi(rv.y);
                y[i][4] += cw[j][1][0] * bflo(rv.z); y[i][5] += cw[j][1][1] * bfhi(rv.z); y[i][6] += cw[j][1][2] * bflo(rv.w); y[i][7] += cw[j][1][3] * bfhi(rv.w); }
#pragma unroll
            for (int e = 0; e < 8; ++e) y[i][e] = silu_f(y[i][e]);
        }
        if (item_next >= 0) chunk_load_raw(a, item_next, raw, tid);
        const float gl = gcs[63];
        if (ten < 2) {
#pragma unroll
            for (int i = 0; i < 8; ++i) { float ss = 0.f;
#pragma unroll
                for (int e = 0; e < 8; ++e) ss += y[i][e] * y[i][e];
                ss += __shfl_xor(ss, 1); ss += __shfl_xor(ss, 2); ss += __shfl_xor(ss, 4); ss += __shfl_xor(ss, 8);
                const float sc = (1.0f / sqrtf(ss + EPS)) * (ten == 0 ? 0.08838834764831845f : 1.f);
#pragma unroll
                for (int e = 0; e < 8; ++e) y[i][e] *= sc; }
        }
        if (ten == 0) {
#pragma unroll
            for (int i = 0; i < 8; ++i) { const int row = 8 * rg + i; const float eg = __expf(gcs[row]);
                u32x4 w; w.x = pk2(y[i][0], y[i][1]); w.y = pk2(y[i][2], y[i][3]); w.z = pk2(y[i][4], y[i][5]); w.w = pk2(y[i][6], y[i][7]);
                *(LAS u32x4*)(Qn + row * 136 + cgp * 8) = w;
                outA[i].x = pk2(y[i][0] * eg, y[i][1] * eg); outA[i].y = pk2(y[i][2] * eg, y[i][3] * eg); outA[i].z = pk2(y[i][4] * eg, y[i][5] * eg); outA[i].w = pk2(y[i][6] * eg, y[i][7] * eg); }
        } else if (ten == 1) {
            float f1[8], f2[8];
#pragma unroll
            for (int i = 0; i < 8; ++i) { const int row = 8 * rg + i; const float gc = gcs[row]; f1[i] = bts[row] * __expf(gc); f2[i] = __expf(gl - gc);
                u32x4 w; w.x = pk2(y[i][0], y[i][1]); w.y = pk2(y[i][2], y[i][3]); w.z = pk2(y[i][4], y[i][5]); w.w = pk2(y[i][6], y[i][7]);
                *(LAS u32x4*)(Kn + row * 136 + cgp * 8) = w; }
#pragma unroll
            for (int e = 0; e < 8; ++e) { u32x4 w;
                w.x = pk2(y[0][e] * f1[0], y[1][e] * f1[1]); w.y = pk2(y[2][e] * f1[2], y[3][e] * f1[3]); w.z = pk2(y[4][e] * f1[4], y[5][e] * f1[5]); w.w = pk2(y[6][e] * f1[6], y[7][e] * f1[7]);
                *(LAS u32x4*)(KbgT + (cgp * 8 + e) * 72 + 8 * rg) = w;
                outA[e].x = pk2(y[0][e] * f2[0], y[1][e] * f2[1]); outA[e].y = pk2(y[2][e] * f2[2], y[3][e] * f2[3]); outA[e].z = pk2(y[4][e] * f2[4], y[5][e] * f2[5]); outA[e].w = pk2(y[6][e] * f2[6], y[7][e] * f2[7]); }
        } else {
            float f1[8];
#pragma unroll
            for (int i = 0; i < 8; ++i) f1[i] = bts[8 * rg + i];
#pragma unroll
            for (int e = 0; e < 8; ++e) { u32x4 w;
                w.x = pk2(y[0][e] * f1[0], y[1][e] * f1[1]); w.y = pk2(y[2][e] * f1[2], y[3][e] * f1[3]); w.z = pk2(y[4][e] * f1[4], y[5][e] * f1[5]); w.w = pk2(y[6][e] * f1[6], y[7][e] * f1[7]);
                *(LAS u32x4*)(VbT + (cgp * 8 + e) * 72 + 8 * rg) = w; }
        }
    }
    __syncthreads();
    if (tid < 128) {
#pragma unroll
        for (int i = 0; i < 8; ++i) *(u32x4*)(QKV + (size_t)(r0 + 8 * rg + i) * 1024 + h * 128 + cgp * 8) = outA[i];
    } else if (tid < 256) {
#pragma unroll
        for (int e = 0; e < 8; ++e) { const int k = cgp * 8 + e;
            *(u32x4*)((unsigned char*)(QKV + (size_t)2 * M * 1024 + (size_t)(r0 + (k >> 1)) * 1024 + h * 128) + (k & 1) * 128 + 16 * rg) = outA[e]; }
    }
    {
        const int mat = wid >> 2, ti = wid & 3;
        const LAS bf16_t* Bm = mat ? Qn : Kn;
        f32x4 c4[4];
#pragma unroll
        for (int tj = 0; tj < 4; ++tj) c4[tj] = (f32x4){0.f, 0.f, 0.f, 0.f};
#pragma unroll
        for (int ks = 0; ks < 4; ++ks) { const bf16x8 af = *(const LAS bf16x8*)(Kn + (ti * 16 + r16) * 136 + ks * 32 + 8 * qp);
#pragma unroll
            for (int tj = 0; tj < 4; ++tj) { const bf16x8 bf = *(const LAS bf16x8*)(Bm + (tj * 16 + r16) * 136 + ks * 32 + 8 * qp); c4[tj] = MFMA16(af, bf, c4[tj]); } }
        const int j0 = ti * 16 + 4 * qp;
        const f32x4 gj = *(const LAS f32x4*)(gcs + j0);
#pragma unroll
        for (int tj = 0; tj < 4; ++tj) { const int i = tj * 16 + r16; const float gi = gcs[i]; f32x4 v;
#pragma unroll
            for (int e = 0; e < 4; ++e) { const int j = j0 + e; const float d = __expf(fminf(gi - gj[e], 0.f)); const bool keep = mat ? (j <= i) : (j < i); v[e] = keep ? c4[tj][e] * d : 0.f; }
            if (mat == 0) { v = v * bts[i];
#pragma unroll
                for (int e = 0; e < 4; ++e) Ap[i * 68 + e * 16 + ti * 4 + qp] = v[e]; }
            else { u32x2 o; o.x = pk2(v[0], v[1]); o.y = pk2(v[2], v[3]); *(u32x2*)((bf16_t*)(ws + WS_AQK) + (size_t)item * 4096 + i * 64 + j0) = o; } }
    }
    __syncthreads();
    if (wid < 4) {
        const int ph = lane & 3, c = 16 * wid + (lane >> 2);
        float t[16];
#pragma unroll
        for (int m = 0; m < 16; ++m) t[m] = 0.f;
        f32x4 cf[3][4];
#define LOADROW(ii, slot) do { _Pragma("unroll") for (int m4 = 0; m4 < 4; ++m4) if (m4 * 16 < (ii) && (ii) < 64) cf[slot][m4] = *(const LAS f32x4*)(Ap + (ii) * 68 + ph * 16 + 4 * m4); } while (0)
        LOADROW(0, 0); LOADROW(1, 1); LOADROW(2, 2);
#pragma unroll
        for (int i = 0; i < 64; ++i) {
            float acc0 = 0.f, acc1 = 0.f;
#pragma unroll
            for (int m4 = 0; m4 * 16 < i; ++m4) { const f32x4 av = cf[i % 3][m4];
                acc0 += av[0] * t[4 * m4];
                if ((4 * m4 + 1) * 4 < i) acc1 += av[1] * t[4 * m4 + 1];
                if ((4 * m4 + 2) * 4 < i) acc0 += av[2] * t[4 * m4 + 2];
                if ((4 * m4 + 3) * 4 < i) acc1 += av[3] * t[4 * m4 + 3]; }
            __builtin_amdgcn_sched_barrier(0);
            LOADROW(i + 3, i % 3);
            __builtin_amdgcn_sched_barrier(0);
            float acc = acc0 + acc1;
            acc += __builtin_bit_cast(float, __builtin_amdgcn_update_dpp(0, __builtin_bit_cast(int, acc), 0xB1, 0xF, 0xF, false));
            acc += __builtin_bit_cast(float, __builtin_amdgcn_update_dpp(0, __builtin_bit_cast(int, acc), 0x4E, 0xF, 0xF, false));
            const float val = ((c == i) ? 1.f : 0.f) - acc;
            t[i >> 2] = (ph == (i & 3)) ? val : t[i >> 2];
        }
#undef LOADROW
#pragma unroll
        for (int m = 0; m < 16; ++m) Tb[(4 * m + ph) * 72 + c] = (bf16_t)f2bf(t[m]);
    }
    __syncthreads();
    {
        f32x4 cu[4], cwv[4];
#pragma unroll
        for (int ct = 0; ct < 4; ++ct) { cu[ct] = (f32x4){0.f, 0.f, 0.f, 0.f}; cwv[ct] = (f32x4){0.f, 0.f, 0.f, 0.f}; }
#pragma unroll
        for (int ks = 0; ks < 2; ++ks) {
            const bf16x8 vb = *(const LAS bf16x8*)(VbT + (16 * wid + r16) * 72 + ks * 32 + 8 * qp);
            const bf16x8 kb = *(const LAS bf16x8*)(KbgT + (16 * wid + r16) * 72 + ks * 32 + 8 * qp);
#pragma unroll
            for (int ct = 0; ct < 4; ++ct) { const bf16x8 tf = *(const LAS bf16x8*)(Tb + (16 * ct + r16) * 72 + ks * 32 + 8 * qp);
                cu[ct] = MFMA16(tf, vb, cu[ct]); cwv[ct] = MFMA16(kb, tf, cwv[ct]); }
        }
#pragma unroll
        for (int ct = 0; ct < 4; ++ct) {
            u32x2 o; o.x = pk2(cu[ct][0], cu[ct][1]); o.y = pk2(cu[ct][2], cu[ct][3]);
            ((u32x2*)(ws + WS_U))[(((size_t)item * 8 + wid) * 4 + ct) * 64 + lane] = o;
            u32x2 w2; w2.x = pk2(-cwv[ct][0], -cwv[ct][1]); w2.y = pk2(-cwv[ct][2], -cwv[ct][3]);
            *(u32x2*)(QKV + (size_t)M * 1024 + (size_t)(r0 + 16 * ct + r16) * 1024 + h * 128 + 16 * wid + 4 * qp) = w2;
        }
    }
}

__device__ __forceinline__ bf16x8 ldA_perm(const LAS bf16_t* p) {
    const u32x2 lo = *(const LAS u32x2*)p, hi = *(const LAS u32x2*)(p + 16);
    u32x4 v; v.x = lo.x; v.y = lo.y; v.z = hi.x; v.w = hi.y; return __builtin_bit_cast(bf16x8, v);
}
__device__ __forceinline__ bf16x8 packB(f32x4 t0, f32x4 t1) {
    u32x4 v; v.x = pk2(t0[0], t0[1]); v.y = pk2(t0[2], t0[3]); v.z = pk2(t1[0], t1[1]); v.w = pk2(t1[2], t1[3]); return __builtin_bit_cast(bf16x8, v);
}
constexpr int SC_W = 0, SC_QG = 18432, SC_AQK = 36864, SC_KDT = 47104, SC_BUF = 67584, SC_RED = 2 * SC_BUF, SC_RSTD = SC_RED + 2048;

__device__ __forceinline__ void scan_load(const Args& a, int bh, int n, u32x4 (&stg)[7]) {
    const int tid = threadIdx.x, b = bh >> 3, h = bh & 7; const int r0 = b * SEQ + 64 * n; const int item = bh * 32 + n;
    const bf16_t* QKV = (const bf16_t*)(a.ws + WS_QKV);
    const int c = tid >> 4, k8 = tid & 15;
#pragma unroll
    for (int i = 0; i < 2; ++i) {
        stg[i] = *(const u32x4*)(QKV + (size_t)M * 1024 + (size_t)(r0 + c + 32 * i) * 1024 + h * 128 + k8 * 8);
        stg[2 + i] = *(const u32x4*)(QKV + (size_t)(r0 + c + 32 * i) * 1024 + h * 128 + k8 * 8);
        stg[4 + i] = *(const u32x4*)(QKV + (size_t)2 * M * 1024 + (size_t)(r0 + c + 32 * i) * 1024 + h * 128 + k8 * 8);
    }
    stg[6] = *(const u32x4*)((const bf16_t*)(a.ws + WS_AQK) + (size_t)item * 4096 + tid * 8);
}
__device__ __forceinline__ void st_perm(LAS unsigned char* rowp  , int a4  , u32x4 v) {
    const int p0 = (a4 & 1) * 16 + (a4 >> 1) * 4;
    u32x2 lo; lo.x = v.x; lo.y = v.y; u32x2 hi; hi.x = v.z; hi.y = v.w;
    *(LAS u32x2*)(rowp + p0 * 2) = lo; *(LAS u32x2*)(rowp + (p0 + 8) * 2) = hi;
}
__device__ __forceinline__ void scan_store(LAS unsigned char* buf, const u32x4 (&stg)[7]) {
    const int tid = threadIdx.x; const int c = tid >> 4, k8 = tid & 15;
#pragma unroll
    for (int i = 0; i < 2; ++i) {
        st_perm(buf + SC_W + ((c + 32 * i) * 144 + (k8 >> 2) * 32) * 2, k8 & 3, stg[i]);
        st_perm(buf + SC_QG + ((c + 32 * i) * 144 + (k8 >> 2) * 32) * 2, k8 & 3, stg[2 + i]);
        const int line = c + 32 * i, k = line * 2 + (k8 >> 3), c8 = k8 & 7;
        st_perm(buf + SC_KDT + (k * 80 + (c8 >> 2) * 32) * 2, c8 & 3, stg[4 + i]);
    }
    { const int cc = tid >> 3, j8 = tid & 7; st_perm(buf + SC_AQK + (cc * 80 + (j8 >> 2) * 32) * 2, j8 & 3, stg[6]); }
}
__device__ __forceinline__ float dpp_add16(float v) {
    v += __builtin_bit_cast(float, __builtin_amdgcn_update_dpp(0, __builtin_bit_cast(int, v), 0xB1, 0xF, 0xF, false));
    v += __builtin_bit_cast(float, __builtin_amdgcn_update_dpp(0, __builtin_bit_cast(int, v), 0x4E, 0xF, 0xF, false));
    v += __builtin_bit_cast(float, __builtin_amdgcn_update_dpp(0, __builtin_bit_cast(int, v), 0x124, 0xF, 0xF, false));
    v += __builtin_bit_cast(float, __builtin_amdgcn_update_dpp(0, __builtin_bit_cast(int, v), 0x128, 0xF, 0xF, false));
    return v;
}
#define LDA128(p) (*(const LAS bf16x8*)(p))

struct ScanSet { u32x4 stg[7]; u32x2 u[4]; float gl; };
__device__ __forceinline__ void scan_load_set(const Args& a, int bh, int n, ScanSet& t, int lane, int wid) {
    scan_load(a, bh, n, t.stg);
#pragma unroll
    for (int ct = 0; ct < 4; ++ct) t.u[ct] = ((const u32x2*)(a.ws + WS_U))[(((size_t)(bh * 32 + n) * 8 + wid) * 4 + ct) * 64 + lane];
    t.gl = ((const float*)(a.ws + WS_GL))[bh * 32 + n];
}
__device__ __forceinline__ void scan_step(const Args& a, LAS unsigned char* lds, int bh, int n, f32x4 (&S)[8], ScanSet& T, float dnw, int lane, int wid, int r16, int qp, bool accum) {
    const int tid = threadIdx.x, b = bh >> 3, h = bh & 7;
    bf16_t* Y = (bf16_t*)a.out;
    LAS unsigned char* buf = lds + (n & 1) * SC_BUF;
    const float gl = T.gl;
    f32x4 vn[4], o[4];
#pragma unroll
    for (int ct = 0; ct < 4; ++ct) { const u32x2 uu = T.u[ct];
        vn[ct] = (f32x4){bflo(uu.x), bfhi(uu.x), bflo(uu.y), bfhi(uu.y)}; o[ct] = (f32x4){0.f, 0.f, 0.f, 0.f}; }
    __builtin_amdgcn_sched_barrier(0);
    if (n + 1 < 32) scan_load_set(a, bh, n + 1, T, lane, wid);
    __builtin_amdgcn_sched_barrier(0);
    bf16x8 sb[4];
#pragma unroll
    for (int s = 0; s < 4; ++s) sb[s] = packB(S[2 * s], S[2 * s + 1]);
    const LAS bf16_t* Wb = (const LAS bf16_t*)(buf + SC_W); const LAS bf16_t* QGb = (const LAS bf16_t*)(buf + SC_QG);
    const LAS bf16_t* AQb = (const LAS bf16_t*)(buf + SC_AQK); const LAS bf16_t* KDb = (const LAS bf16_t*)(buf + SC_KDT);
    bf16x8 fa[8], fb[8];
#define SB() __builtin_amdgcn_sched_barrier(0)
#define LD_VO2(f, ca, cb, sh) do { _Pragma("unroll") for (int s_ = 0; s_ < 2; ++s_) { \
        f[4 * s_ + 0] = LDA128(Wb + (16 * (ca) + r16) * 144 + 32 * ((sh) + s_) + 8 * qp); f[4 * s_ + 1] = LDA128(Wb + (16 * (cb) + r16) * 144 + 32 * ((sh) + s_) + 8 * qp); \
        f[4 * s_ + 2] = LDA128(QGb + (16 * (ca) + r16) * 144 + 32 * ((sh) + s_) + 8 * qp); f[4 * s_ + 3] = LDA128(QGb + (16 * (cb) + r16) * 144 + 32 * ((sh) + s_) + 8 * qp); } } while (0)
#define MM_VO2(f, ca, cb, sh) do { _Pragma("unroll") for (int s_ = 0; s_ < 2; ++s_) { \
        vn[ca] = MFMA16(f[4 * s_ + 0], sb[(sh) + s_], vn[ca]); vn[cb] = MFMA16(f[4 * s_ + 1], sb[(sh) + s_], vn[cb]); \
        o[ca] = MFMA16(f[4 * s_ + 2], sb[(sh) + s_], o[ca]); o[cb] = MFMA16(f[4 * s_ + 3], sb[(sh) + s_], o[cb]); } } while (0)
#define LD_AQ(f) do { _Pragma("unroll") for (int c_ = 0; c_ < 4; ++c_) { f[c_] = LDA128(AQb + (16 * c_ + r16) * 80 + 8 * qp); f[4 + c_] = LDA128(AQb + (16 * c_ + r16) * 80 + 32 + 8 * qp); } } while (0)
#define MM_AQ(f) do { _Pragma("unroll") for (int c_ = 0; c_ < 4; ++c_) o[c_] = MFMA16(f[c_], vb[0], o[c_]); _Pragma("unroll") for (int c_ = 0; c_ < 4; ++c_) o[c_] = MFMA16(f[4 + c_], vb[1], o[c_]); } while (0)
#define LD_KD(f, k0) do { _Pragma("unroll") for (int c_ = 0; c_ < 4; ++c_) { f[c_] = LDA128(KDb + (16 * ((k0) + c_) + r16) * 80 + 8 * qp); f[4 + c_] = LDA128(KDb + (16 * ((k0) + c_) + r16) * 80 + 32 + 8 * qp); } } while (0)
#define MM_KD(f, k0) do { _Pragma("unroll") for (int c_ = 0; c_ < 4; ++c_) S[(k0) + c_] = MFMA16(f[c_], vb[0], S[(k0) + c_] * gl); _Pragma("unroll") for (int c_ = 0; c_ < 4; ++c_) S[(k0) + c_] = MFMA16(f[4 + c_], vb[1], S[(k0) + c_]); } while (0)
    LD_VO2(fa, 0, 1, 0); LD_VO2(fb, 0, 1, 2); SB();
    MM_VO2(fa, 0, 1, 0); SB(); LD_VO2(fa, 2, 3, 0); SB();
    MM_VO2(fb, 0, 1, 2); SB(); LD_VO2(fb, 2, 3, 2); SB();
    MM_VO2(fa, 2, 3, 0); SB(); LD_AQ(fa); SB();
    MM_VO2(fb, 2, 3, 2); SB(); LD_KD(fb, 0); SB();
    bf16x8 vb[2];
#pragma unroll
    for (int s = 0; s < 2; ++s) vb[s] = packB(vn[2 * s], vn[2 * s + 1]);
    MM_AQ(fa); SB(); LD_KD(fa, 4); SB();
    MM_KD(fb, 0); SB();
    MM_KD(fa, 4); SB();
#undef SB
#undef LD_VO2
#undef MM_VO2
#undef LD_AQ
#undef MM_AQ
#undef LD_KD
#undef MM_KD
    {
        float v16[16];
#pragma unroll
        for (int ct = 0; ct < 4; ++ct)
#pragma unroll
            for (int e = 0; e < 4; ++e) v16[4 * ct + e] = o[ct][e] * o[ct][e];
#define DPPF(x, ctrl) __builtin_bit_cast(float, __builtin_amdgcn_update_dpp(0, __builtin_bit_cast(int, (x)), (ctrl), 0xF, 0xF, false))
        float w8[8], w4[4], w2[2];
        const bool b3 = r16 & 8, b2 = r16 & 4, b1 = r16 & 2, b0 = r16 & 1;
#pragma unroll
        for (int j = 0; j < 8; ++j) { const float keep = b3 ? v16[j + 8] : v16[j], send = b3 ? v16[j] : v16[j + 8]; w8[j] = keep + DPPF(send, 0x128); }
#pragma unroll
        for (int j = 0; j < 4; ++j) { const float keep = b2 ? w8[j + 4] : w8[j], send = b2 ? w8[j] : w8[j + 4]; w4[j] = keep + DPPF(send, 0x141); }
#pragma unroll
        for (int j = 0; j < 2; ++j) { const float keep = b1 ? w4[j + 2] : w4[j], send = b1 ? w4[j] : w4[j + 2]; w2[j] = keep + DPPF(send, 0x1B); }
        const float keep = b0 ? w2[1] : w2[0], send = b0 ? w2[0] : w2[1];
        const float tot = keep + DPPF(send, 0xB1);
#undef DPPF
        if (accum) atomicAdd((float*)(a.ws + WS_SUMSQ) + (size_t)(b * SEQ + 64 * n + 16 * (r16 >> 2) + 4 * qp + (r16 & 3)) * 8 + h, tot);
    }
    if (n + 1 < 32) scan_store(lds + ((n + 1) & 1) * SC_BUF, T.stg);
    const int rowb = b * SEQ + 64 * n;
#pragma unroll
    for (int ct = 0; ct < 4; ++ct)
#pragma unroll
        for (int e = 0; e < 4; ++e) Y[(size_t)(rowb + 16 * ct + 4 * qp + e) * 2048 + 512 + h * 128 + 16 * wid + r16] = (bf16_t)f2bf(o[ct][e] * dnw);
    __syncthreads();
}

__device__ __forceinline__ void scan_bh(const Args& a, LAS unsigned char* lds, int bh, bool accum = true) {
    int tid_ = threadIdx.x; asm volatile("" : "+v"(tid_));
    const int tid = tid_, lane = tid & 63, wid = tid >> 6, r16 = lane & 15, qp = lane >> 4;
    const float dnw = a.dn_w[16 * wid + r16];
    f32x4 S[8];
#pragma unroll
    for (int kt = 0; kt < 8; ++kt) S[kt] = (f32x4){0.f, 0.f, 0.f, 0.f};
    ScanSet T;
    __syncthreads();
    scan_load_set(a, bh, 0, T, lane, wid);
    scan_store(lds, T.stg);
    __syncthreads();
#pragma unroll 1
    for (int n = 0; n < 32; ++n) scan_step(a, lds, bh, n, S, T, dnw, lane, wid, r16, qp, accum);
}

__device__ __forceinline__ void attn_item(const Args& a, LAS unsigned char* lds, int item) {
    int tid_ = threadIdx.x; asm volatile("" : "+v"(tid_));
    const int tid = tid_, lane = tid & 63, wid = tid >> 6, r16 = lane & 15, qp = lane >> 4;
    const int qt = item & 15, head = (item >> 4) & 3, b = item >> 6;
    LAS bf16_t* Ks = (LAS bf16_t*)lds;
    LAS bf16_t* Vt = (LAS bf16_t*)(lds + 69632);
    const bf16_t* KM = (const bf16_t*)(a.ws + WS_KMEM); const bf16_t* VM = (const bf16_t*)(a.ws + WS_VMEMT); const bf16_t* QM = (const bf16_t*)(a.ws + WS_QM);
    __syncthreads();
#pragma unroll
    for (int i = 0; i < 8; ++i) { const int p = tid + 512 * i;
        { const int key = p >> 4, d8 = p & 15; *(LAS u32x4*)(Ks + key * 136 + d8 * 8) = *(const u32x4*)(KM + (size_t)(b * 256 + key) * 512 + head * 128 + d8 * 8); }
        { const int d = p >> 5, k8 = p & 31; *(LAS u32x4*)(Vt + d * 264 + k8 * 8) = *(const u32x4*)(VM + (size_t)(head * 128 + d) * 2048 + b * 256 + k8 * 8); } }
    const int qrow = b * SEQ + qt * 128 + 16 * wid + r16;
    bf16x8 qf[4];
#pragma unroll
    for (int s = 0; s < 4; ++s) qf[s] = *(const bf16x8*)(QM + (size_t)qrow * 512 + head * 128 + 32 * s + 8 * qp);
    __syncthreads();
    f32x4 sc[16];
#pragma unroll
    for (int kt = 0; kt < 16; ++kt) { sc[kt] = (f32x4){0.f, 0.f, 0.f, 0.f};
#pragma unroll
        for (int s = 0; s < 4; ++s) sc[kt] = MFMA16(*(const LAS bf16x8*)(Ks + (16 * kt + r16) * 136 + 32 * s + 8 * qp), qf[s], sc[kt]); }
    float mx = -3.0e38f;
#pragma unroll
    for (int kt = 0; kt < 16; ++kt) mx = fmaxf(fmaxf(fmaxf(sc[kt][0], sc[kt][1]), fmaxf(sc[kt][2], sc[kt][3])), mx);
    mx = fmaxf(mx, __shfl_xor(mx, 16)); mx = fmaxf(mx, __shfl_xor(mx, 32));
    const float scl = 0.08838834764831845f; float sum = 0.f;
#pragma unroll
    for (int kt = 0; kt < 16; ++kt)
#pragma unroll
        for (int e = 0; e < 4; ++e) { const float p = __expf((sc[kt][e] - mx) * scl); sc[kt][e] = p; sum += p; }
    sum += __shfl_xor(sum, 16); sum += __shfl_xor(sum, 32);
    f32x4 o[8];
#pragma unroll
    for (int dt = 0; dt < 8; ++dt) o[dt] = (f32x4){0.f, 0.f, 0.f, 0.f};
#pragma unroll
    for (int s = 0; s < 8; ++s) { const bf16x8 pb = packB(sc[2 * s], sc[2 * s + 1]);
#pragma unroll
        for (int dt = 0; dt < 8; ++dt) o[dt] = MFMA16(ldA_perm(Vt + (16 * dt + r16) * 264 + 32 * s + 4 * qp), pb, o[dt]); }
    const float inv = 1.f / sum;
    bf16_t* Y = (bf16_t*)a.out;
#pragma unroll
    for (int dt = 0; dt < 8; ++dt) { u32x2 w; w.x = pk2(o[dt][0] * inv, o[dt][1] * inv); w.y = pk2(o[dt][2] * inv, o[dt][3] * inv);
        *(u32x2*)(Y + (size_t)qrow * 2048 + 1536 + head * 128 + 16 * dt + 4 * qp) = w; }
}

__device__ __forceinline__ void pool_item(const Args& a, LAS unsigned char* lds, int item) {
    int tid_ = threadIdx.x; asm volatile("" : "+v"(tid_));
    const int tid = tid_, lane = tid & 63, wid = tid >> 6, r16 = lane & 15, qp = lane >> 4;
    const int g = item & 3, tt = (item >> 2) & 31, b = item >> 7;
    LAS bf16_t* Xs = (LAS bf16_t*)lds;
    LAS bf16_t* Ps = (LAS bf16_t*)(lds + 20480);
    const bf16_t* XA = (const bf16_t*)(a.ws + WS_XA);
    const int t0 = tt * 64;
    __syncthreads();
    for (int p = tid; p < 1280; p += 512) { const int row = p >> 4, c8 = p & 15; const int t = t0 - 16 + row; u32x4 v = (u32x4){0u, 0u, 0u, 0u};
        if (t >= 0) v = *(const u32x4*)(XA + (size_t)(b * SEQ + t) * 512 + g * 128 + c8 * 8);
        *(LAS u32x4*)(Xs + row * 128 + c8 * 8) = v; }
    __syncthreads();
    {
        const int c = tid & 127, rgp = tid >> 7, w = 2 << g; float sum = 0.f;
        for (int j = 1; j < w; ++j) sum += bflo((unsigned)Xs[(16 + 16 * rgp - j) * 128 + c]);
        const float invw = 1.f / (float)w;
#pragma unroll 4
        for (int i = 0; i < 16; ++i) { const int row = 16 * rgp + i; const float xv = bflo((unsigned)Xs[(16 + row) * 128 + c]); sum += xv;
            const int t = t0 + row; const float mean = (t + 1 >= w) ? sum * invw : sum / (float)(t + 1);
            Ps[row * 136 + c] = (bf16_t)f2bf(mean - xv);
            sum -= bflo((unsigned)Xs[(16 + row - (w - 1)) * 128 + c]); }
    }
    __syncthreads();
    const bf16_t* WX = (const bf16_t*)(a.ws + WS_WMIX) + g * 16384;
    f32x4 acc[4];
#pragma unroll
    for (int t4 = 0; t4 < 4; ++t4) acc[t4] = (f32x4){0.f, 0.f, 0.f, 0.f};
#pragma unroll
    for (int s = 0; s < 4; ++s) { const bf16x8 af = *(const bf16x8*)(WX + (16 * wid + r16) * 128 + 32 * s + 8 * qp);
#pragma unroll
        for (int t4 = 0; t4 < 4; ++t4) acc[t4] = MFMA16(af, *(const LAS bf16x8*)(Ps + (16 * t4 + r16) * 136 + 32 * s + 8 * qp), acc[t4]); }
    const f32x4 psc = *(const f32x4*)(a.pool_scale + g * 128 + 16 * wid + 4 * qp);
    bf16_t* Y = (bf16_t*)a.out;
#pragma unroll
    for (int t4 = 0; t4 < 4; ++t4) { u32x2 w2; w2.x = pk2(acc[t4][0] * psc[0], acc[t4][1] * psc[1]); w2.y = pk2(acc[t4][2] * psc[2], acc[t4][3] * psc[3]);
        *(u32x2*)(Y + (size_t)(b * SEQ + t0 + 16 * t4 + r16) * 2048 + g * 128 + 16 * wid + 4 * qp) = w2; }
}

#ifndef REP_P0
#define REP_P0 1
#endif
#ifndef REP_P1
#define REP_P1 1
#endif
#ifndef REP_P3
#define REP_P3 1
#endif
#ifndef REP_P5
#define REP_P5 1
#endif
#define P0_BODY if (IN(0)) p0_prologue(a, lds);
#define P1_BODY \
    if (IN(1)) { \
        {   pg8::Gemm g{(const bf16_t*)(ws + WS_H), (const bf16_t*)(ws + WS_WT), 1024, 1024, 1024}; pg8::StaticOrder S; S.init(M, 4096, G, bx); \
            pg8::EpiStage1 E{(bf16_t*)(ws + WS_XA), (bf16_t*)(ws + WS_QM), (bf16_t*)(ws + WS_QKV), (bf16_t*)(ws + WS_HALO)}; \
            pg8::gemm_phase(lds, g, S, E); } \
    }
#ifndef REP_SCAN
#define REP_SCAN 1
#endif
#ifndef REP_ATTN
#define REP_ATTN 1
#endif
#ifndef REP_POOL
#define REP_POOL 1
#endif
#define P3_BODY \
    if (IN(3)) { \
        unsigned* kvcnt = (unsigned*)(ws + WS_CTL) + 8192; \
        if (G >= 128) { \
            if (bx < 64) { for (int rep = 0; rep < REP_SCAN; ++rep) scan_bh(a, lds, bx, rep == 0); } \
            else { const int c = bx - 64, GG = G - 64; \
                if (c < 32) { \
                    pg8::OneUnit S1; \
                    if (c < 16) { S1.u.pm = c >> 1; S1.u.pn = c & 1; pg8::Gemm g{(const bf16_t*)(ws + WS_MEMN), (const bf16_t*)(ws + WS_WKV), 1024, 1024, 1024}; pg8::EpiPlain E{(bf16_t*)(ws + WS_KMEM), 512}; pg8::gemm_phase(lds, g, S1, E); } \
                    else { S1.u.pm = (c - 16) >> 3; S1.u.pn = (c - 16) & 7; pg8::Gemm g{(const bf16_t*)(ws + WS_WKV) + (size_t)512 * 1024, (const bf16_t*)(ws + WS_MEMN), 1024, 1024, 1024}; pg8::EpiPlain E{(bf16_t*)(ws + WS_VMEMT), 2048}; pg8::gemm_phase(lds, g, S1, E); } \
                    asm volatile("s_waitcnt vmcnt(0)" ::: "memory"); __syncthreads(); \
                    if (tid == 0) { __builtin_amdgcn_fence(__ATOMIC_RELEASE, "agent"); asm volatile("s_waitcnt vmcnt(0)" ::: "memory"); __hip_atomic_fetch_add(kvcnt, 1u, __ATOMIC_RELAXED, __HIP_MEMORY_SCOPE_AGENT); } \
                } \
                bool kv_ok = false; \
                for (int it = c; it < 1024 * REP_POOL + 512 * REP_ATTN; it += GG) { \
                    if (it < 1024 * REP_POOL) pool_item(a, lds, it & 1023); \
                    else { \
                        if (!kv_ok) { if (tid == 0) { unsigned sp = 0; while (__hip_atomic_load(kvcnt, __ATOMIC_RELAXED, __HIP_MEMORY_SCOPE_AGENT) < 32u) { __builtin_amdgcn_s_sleep(2); if (++sp > (1u << 20)) break; } \
                                __builtin_amdgcn_fence(__ATOMIC_ACQUIRE, "agent"); asm volatile("s_waitcnt vmcnt(0)" ::: "memory"); } __syncthreads(); kv_ok = true; } \
                        attn_item(a, lds, (it - 1024 * REP_POOL) & 511); } } \
                late_transposes(a, lds, c, GG); } \
        } else { \
            for (int it = bx; it < 32; it += G) { pg8::OneUnit S1; \
                    if (it < 16) { S1.u.pm = it >> 1; S1.u.pn = it & 1; pg8::Gemm g{(const bf16_t*)(ws + WS_MEMN), (const bf16_t*)(ws + WS_WKV), 1024, 1024, 1024}; pg8::EpiPlain E{(bf16_t*)(ws + WS_KMEM), 512}; pg8::gemm_phase(lds, g, S1, E); } \
                    else { S1.u.pm = (it - 16) >> 3; S1.u.pn = (it - 16) & 7; pg8::Gemm g{(const bf16_t*)(ws + WS_WKV) + (size_t)512 * 1024, (const bf16_t*)(ws + WS_MEMN), 1024, 1024, 1024}; pg8::EpiPlain E{(bf16_t*)(ws + WS_VMEMT), 2048}; pg8::gemm_phase(lds, g, S1, E); } } \
            xcd_barrier(xbar); \
            for (int it = bx; it < 64 + 512 + 1024; it += G) { if (it < 64) scan_bh(a, lds, it); else if (it < 576) attn_item(a, lds, it - 64); else pool_item(a, lds, it - 576); } \
            late_transposes(a, lds, bx, G); \
        } \
    }
#define P5_BODY \
    if (IN(5)) { \
        pg8::StaticOrder SO; SO.init(M, 1024, G, bx); \
        pg8::OneUnit S1; \
        if (SO.next(0, S1.u)) { \
            bf16_t* Y = (bf16_t*)(ws + WS_Y); const bf16_t* YC = (const bf16_t*)a.out; const bf16_t* GT = (const bf16_t*)(ws + WS_GATE); \
            {   pg8::Gemm g{YC, (const bf16_t*)(ws + WS_WP), 2048, 512, 512}; pg8::EpiProj<0> E{GT, Y}; pg8::gemm_phase(lds, g, S1, E); } \
            {   pg8::Gemm g{YC + 512, (const bf16_t*)(ws + WS_WD), 2048, 1024, 1024}; pg8::EpiProj<1> E{GT, Y}; pg8::gemm_phase(lds, g, S1, E); } \
            {   pg8::Gemm g{YC + 1536, (const bf16_t*)(ws + WS_WM), 2048, 512, 512}; pg8::EpiProj<2> E{GT, Y}; pg8::gemm_phase(lds, g, S1, E); } \
        } \
    }
__global__ void __launch_bounds__(512, 2) hybrid_fwd(Args a) {
    extern __shared__ __attribute__((aligned(16))) unsigned char lds_raw[];
    LAS unsigned char* lds = (LAS unsigned char*)lds_raw;
    const int G = gridDim.x, bx = blockIdx.x, tid = threadIdx.x;
    unsigned char* ws = a.ws;
    const int lo = a.ph_lo, hi = a.ph_hi;
    volatile LAS unsigned* xst = (volatile LAS unsigned*)(lds + LDS_BYTES - 16);
    if (tid < 4) xst[tid] = 0u;
    __syncthreads();
    XcdBarrier xbar; xbar.bar = (unsigned*)(ws + WS_CTL); xbar.x = 0; xbar.st = xst;
    if (hi - lo > 1) xbar = xcd_barrier_post((unsigned*)(ws + WS_CTL), xst);
    if (lo == 0x7fffffff) cg::this_grid().sync();
#define IN(k) (lo <= (k) && (k) < hi)
#define SEAM(k) do { if (IN(k) && IN((k) + 1)) xcd_barrier(xbar); } while (0)
    P0_BODY
#if REP_P0 > 1
    xcd_barrier(xbar);
    P0_BODY
#endif
    SEAM(0);
#ifndef REP_P12
#define REP_P12 1
#endif
    for (int rep12 = 0; rep12 < REP_P12; ++rep12) {
    if (rep12) xcd_barrier(xbar);
    P1_BODY
#if REP_P1 > 1
    xcd_barrier(xbar);
    P1_BODY
#endif
    SEAM(1);
#ifndef NO_P2
    if (IN(2)) { u32x4 raw[11]; float gpre = 0.f, bpre = 0.f; if (bx < 2048) { chunk_load_raw(a, bx, raw, tid); if (tid < 64) { const int n2 = bx & 31, h2 = (bx >> 5) & 7, b2 = bx >> 8; const int r2 = b2 * SEQ + 64 * n2; gpre = ((const float*)(ws + WS_G))[(size_t)(r2 + tid) * 8 + h2]; bpre = ((const float*)(ws + WS_BETA))[(size_t)(r2 + tid) * 8 + h2]; } }
        for (int it = bx; it < 2048; it += G) chunk_prep_item(a, lds, it, raw, (it + G < 2048) ? it + G : -1, gpre, bpre); }
#endif
    }
    SEAM(2);
    P3_BODY
#if REP_P3 > 1
    xcd_barrier(xbar);
    P3_BODY
#endif
    SEAM(3);
    if (IN(4)) {
        {   pg8::Gemm g{(const bf16_t*)(ws + WS_H), (const bf16_t*)(ws + WS_WT) + (size_t)4096 * 1024, 1024, 1024, 1024}; pg8::StaticOrder S; S.init(M, 2048, G, bx);
            pg8::EpiZ E{(bf16_t*)a.out, (const float*)(ws + WS_SUMSQ)}; pg8::gemm_phase(lds, g, S, E); }
        {   pg8::Gemm g{(const bf16_t*)(ws + WS_H), (const bf16_t*)(ws + WS_WT) + (size_t)6144 * 1024, 1024, 1024, 1024}; pg8::StaticOrder S; S.init(M, 3072, G, bx);
            pg8::EpiGate E{(bf16_t*)(ws + WS_GATE)}; pg8::gemm_phase(lds, g, S, E); }
    }
    SEAM(4);
    P5_BODY
#if REP_P5 > 1
    xcd_barrier(xbar);
    P5_BODY
#endif
    SEAM(5);
    if (IN(6)) {
        pg8::Gemm g{(const bf16_t*)(ws + WS_Y), (const bf16_t*)(ws + WS_WOUT), 1024, 1024, 1024}; pg8::StaticOrder S; S.init(M, 1024, G, bx);
        pg8::EpiOutNorm E{a.out, a.x, a.post_w, (float*)(ws + WS_ROWSS), (unsigned*)(ws + WS_CTL) + 4096};
        pg8::gemm_phase(lds, g, S, E);
    }
#undef IN
#undef SEAM
}

extern "C" void kernel_launch(void* const* d_in, const int* in_sizes, int n_in, void* d_out, int out_size, void* d_ws, size_t ws_size, hipStream_t stream) {
    static int grid = 0;
    if (grid == 0) {
        if (n_in != 17 || out_size != M * DM || ws_size < WS_END) { fprintf(stderr, "kernel_launch: unexpected shapes (n_in %d out %d ws %zu)\n", n_in, out_size, ws_size); grid = -1; return; }
        int dev = 0, cus = 0, per_cu = 0;
        hipGetDevice(&dev); hipDeviceGetAttribute(&cus, hipDeviceAttributeMultiprocessorCount, dev);
        if (hipFuncSetAttribute((const void*)hybrid_fwd, hipFuncAttributeMaxDynamicSharedMemorySize, LDS_BYTES) != hipSuccess) { fprintf(stderr, "kernel_launch: hipFuncSetAttribute failed\n"); grid = -1; return; }
        if (hipOccupancyMaxActiveBlocksPerMultiprocessor(&per_cu, (const void*)hybrid_fwd, 512, LDS_BYTES) != hipSuccess || per_cu < 1) { fprintf(stderr, "kernel_launch: occupancy query gives %d\n", per_cu); per_cu = 1; }
        (void)hipGetLastError();
        grid = cus * 1;
        if (grid > 256) grid = 256;
    }
    if (grid < 0) return;
    Args a{};
    a.x = (const float*)d_in[0]; a.mem = (const float*)d_in[1]; a.pre_w = (const float*)d_in[2]; a.mem_w = (const float*)d_in[3]; a.w_in = (const float*)d_in[4];
    a.conv_w = (const float*)d_in[5]; a.a_log = (const float*)d_in[6]; a.dt_bias = (const float*)d_in[7]; a.dn_w = (const float*)d_in[8]; a.mix_w = (const float*)d_in[9];
    a.pool_scale = (const float*)d_in[10]; a.w_kv = (const float*)d_in[11]; a.w_pp = (const float*)d_in[12]; a.w_pd = (const float*)d_in[13]; a.w_pm = (const float*)d_in[14];
    a.w_out = (const float*)d_in[15]; a.post_w = (const float*)d_in[16];
    a.out = (float*)d_out; a.ws = (unsigned char*)d_ws;
#if MK_PER_PHASE
    for (int p = 0; p < 7; ++p) { a.ph_lo = p; a.ph_hi = p + 1; hipLaunchKernelGGL(hybrid_fwd, dim3(grid), dim3(512), LDS_BYTES, stream, a); }
#else
    a.ph_lo = 0; a.ph_hi = 7;
    if (hipMemsetAsync((char*)d_ws + WS_CTL, 0, 65536, stream) != hipSuccess) { fprintf(stderr, "kernel_launch: memset of the barrier words failed\n"); return; }
    void* args[] = {&a};
    hipError_t e = hipLaunchCooperativeKernel((const void*)hybrid_fwd, dim3(grid), dim3(512), args, LDS_BYTES, stream);
    if (e != hipSuccess) fprintf(stderr, "kernel_launch: cooperative launch failed: %s (grid %d)\n", hipGetErrorString(e), grid);
#endif
}
```

```cpp
#include <hip/hip_runtime.h>
#include <hip/hip_cooperative_groups.h>
#include <cstdio>
#include <cstdint>
namespace cg = cooperative_groups;

#ifndef MK_PER_PHASE
#define MK_PER_PHASE 0
#endif

#define LAS __attribute__((address_space(3)))
typedef unsigned short bf16_t;
typedef short bf16x8 __attribute__((ext_vector_type(8)));
typedef float f32x4 __attribute__((ext_vector_type(4)));
typedef unsigned u32x4 __attribute__((ext_vector_type(4)));
typedef unsigned u32x2 __attribute__((ext_vector_type(2)));

constexpr int DM = 1024, NB = 8, SEQ = 2048, M = NB * SEQ, INW = 9232, MEML = 256;
constexpr float EPS = 1e-6f;
constexpr size_t MiB = 1u << 20;
constexpr size_t WS_WT = 0;
constexpr size_t WS_WKV = 18 * MiB;
constexpr size_t WS_WP = 20 * MiB;
constexpr size_t WS_WD = 21 * MiB;
constexpr size_t WS_WM = 23 * MiB;
constexpr size_t WS_WOUT = 24 * MiB;
constexpr size_t WS_WMIX = 26 * MiB;
constexpr size_t WS_G = 26 * MiB + 256 * 1024;
constexpr size_t WS_BETA = WS_G + 512 * 1024;
constexpr size_t WS_ROWSS = WS_BETA + 512 * 1024;
constexpr size_t WS_GL = WS_ROWSS + 64 * 1024;
constexpr size_t WS_SUMSQ = 27 * MiB + 384 * 1024;
constexpr size_t WS_H = 28 * MiB;
constexpr size_t WS_MEMN = 60 * MiB;
constexpr size_t WS_KMEM = 64 * MiB;
constexpr size_t WS_VMEMT = 66 * MiB;
constexpr size_t WS_XA = 68 * MiB;
constexpr size_t WS_QM = 84 * MiB;
constexpr size_t WS_QKV = 100 * MiB;
constexpr size_t WS_HALO = 196 * MiB;
constexpr size_t WS_U = 201 * MiB;
constexpr size_t WS_AQK = 233 * MiB;
constexpr size_t WS_CTL = 250 * MiB;
constexpr size_t WS_END = 251 * MiB;
constexpr size_t WS_Y = WS_XA;
constexpr size_t WS_GATE = WS_QKV;
constexpr int LDS_BYTES = 147456;

__device__ __forceinline__ unsigned f2bf(float f) { unsigned u = __float_as_uint(f); return (u + 0x7fffu + ((u >> 16) & 1u)) >> 16; }
typedef __bf16 bf16x2_t __attribute__((ext_vector_type(2)));
typedef float f32x2_t __attribute__((ext_vector_type(2)));
__device__ __forceinline__ unsigned pk2(float lo, float hi) { f32x2_t v = {lo, hi}; bf16x2_t b = __builtin_convertvector(v, bf16x2_t); return __builtin_bit_cast(unsigned, b); }
__device__ __forceinline__ float bflo(unsigned u) { return __uint_as_float(u << 16); }
__device__ __forceinline__ float bfhi(unsigned u) { return __uint_as_float(u & 0xffff0000u); }
__device__ __forceinline__ unsigned cvt_pk_bf16(float lo, float hi) { unsigned r; asm volatile("v_cvt_pk_bf16_f32 %0, %1, %2" : "=v"(r) : "v"(lo), "v"(hi)); return r; }
__device__ __forceinline__ float silu_f(float z) { return z * __builtin_amdgcn_rcpf(1.f + __expf(-z)); }
__device__ __forceinline__ float sigm_f(float z) { return __builtin_amdgcn_rcpf(1.f + __expf(-z)); }
#define LDS_WAIT() asm volatile("s_waitcnt lgkmcnt(0)" ::: "memory")
#define MFMA16(a, b, c) __builtin_amdgcn_mfma_f32_16x16x32_bf16((a), (b), (c), 0, 0, 0)

namespace pg8 {
constexpr int BM = 256, BK = 64, HALF = 128, HTB = HALF * BK * 2, STAGE_BYTES = 8 * HTB, NXCD = 8, WGM = 8;
__host__ __device__ __forceinline__ int lds_byte(int r, int c) { const int st = (r >> 4) * 2 + (c >> 5), rr = r & 15, cc = c & 31, ob = rr * 64 + cc * 2; return st * 1024 + (ob ^ (((ob >> 9) & 1) << 5)); }
__host__ __device__ __forceinline__ void stage_rc(int b, int& R, int& C) { const int st = b / 1024, sb = b % 1024, swz = sb ^ (((sb >> 9) & 1) << 5); R = (st >> 1) * 16 + swz / 64; C = (st & 1) * 32 + (swz % 64) / 2; }
__host__ __device__ __forceinline__ int perm32(int rho) { const int n = rho >> 4, i = rho & 15; return 8 * (i >> 2) + 4 * n + (i & 3); }
struct Unit { int pm, pn; };
struct Gemm { const bf16_t* A; const bf16_t* Bt; int lda, ldb, K; };
struct StaticOrder {
    int nM, nN, nwg, G, c;
    __device__ void init(int Mr, int Nc, int G_, int c_) { nM = Mr / BM; nN = Nc / BM; nwg = nM * nN; G = G_; c = c_; }
    __device__ bool next(int i, Unit& u) const {
        const long L = (long)i * G + c; if (L >= nwg) return false;
        int wgid = (int)L; { const int q = nwg / NXCD, r = nwg % NXCD, xcd = wgid % NXCD, off = wgid / NXCD; wgid = (xcd < r ? xcd * (q + 1) : r * (q + 1) + (xcd - r) * q) + off; }
        const int nig = WGM * nN, gid = wgid / nig, fm = gid * WGM, gsz = (nM - fm) < WGM ? (nM - fm) : WGM;
        u.pm = fm + ((wgid % nig) % gsz); u.pn = (wgid % nig) / gsz; return true;
    }
};
struct OneUnit {
    Unit u;
    __device__ bool next(int i, Unit& o) const { if (i) return false; o = u; return true; }
};

template <class Epi, class Sched>
__device__ __forceinline__ void gemm_phase(LAS unsigned char* lds, const Gemm g, const Sched& S, const Epi& E) {
    int tid_ = threadIdx.x; asm volatile("" : "+v"(tid_));
    const int tid = tid_, wid = __builtin_amdgcn_readfirstlane(tid >> 6), lane = tid & 63, wr = wid >> 2, wc = wid & 3, fr = lane & 15, fq = lane >> 4;
    const int K = g.K, nt = K / BK;
    unsigned voffA[2], voffB[2];
#pragma unroll
    for (int i = 0; i < 2; ++i) { int R, C; stage_rc(tid * 16 + i * 8192, R, C); const int Rb = (R & ~31) + perm32(R & 31);
        voffA[i] = (unsigned)(R * g.lda + C) * 2u; voffB[i] = (unsigned)(Rb * g.ldb + C) * 2u; }
    const size_t kstep = (size_t)(BK * 2);
    const size_t hstepA = (size_t)HALF * g.lda * 2, hstepB = (size_t)HALF * g.ldb * 2;
    const size_t tstepA = 2 * hstepA, tstepB = 2 * hstepB;
    const unsigned ldsw = (unsigned)wid * 1024u;
    const int aoff = lds_byte(wr * 64 + fr, fq * 8), boff = lds_byte(wc * 32 + fr, fq * 8);
#define PG8_SA(b, h) (((b) * 2 + (h)) * HTB)
#define PG8_SB(b, h) ((4 + (b) * 2 + (h)) * HTB)
#define PG8_STAGE(bufoff, gbase, voff) do { _Pragma("unroll") for (int _i = 0; _i < 2; ++_i) \
        __builtin_amdgcn_global_load_lds((const unsigned*)((const char*)(gbase) + (voff)[_i]), (LAS unsigned*)(lds + (bufoff) + ldsw + _i * 8192), 16, 0, 0); } while (0)
#define PG8_LDA(dst, b, h) do { _Pragma("unroll") for (int m = 0; m < 4; ++m) _Pragma("unroll") for (int k = 0; k < 2; ++k) dst[m][k] = *(const LAS bf16x8*)(lds + PG8_SA(b, h) + aoff + m * 2048 + k * 1024); } while (0)
#define PG8_LDB(dst, b, h) do { _Pragma("unroll") for (int n = 0; n < 2; ++n) _Pragma("unroll") for (int k = 0; k < 2; ++k) dst[n][k] = *(const LAS bf16x8*)(lds + PG8_SB(b, h) + boff + n * 2048 + k * 1024); } while (0)
#define PG8_MMA(ai, bj, At, Bt) do { __builtin_amdgcn_s_setprio(1); _Pragma("unroll") for (int m = 0; m < 4; ++m) _Pragma("unroll") for (int n = 0; n < 2; ++n) _Pragma("unroll") for (int k = 0; k < 2; ++k) \
        acc[ai][bj][m][n] = __builtin_amdgcn_mfma_f32_16x16x32_bf16(Bt[n][k], At[m][k], acc[ai][bj][m][n], 0, 0, 0); __builtin_amdgcn_s_setprio(0); } while (0)
#define PG8_WAIT_V(n) asm volatile("s_waitcnt vmcnt(" #n ")" ::: "memory")
#define PG8_WAIT_L(n) asm volatile("s_waitcnt lgkmcnt(" #n ")" ::: "memory")
#define PG8_BAR __builtin_amdgcn_s_barrier()
#define PG8_SCHED __builtin_amdgcn_sched_barrier(0)
    Unit cur, nxt; int ui = 0;
    if (!S.next(0, cur)) return;
    f32x4 acc[2][2][4][2];
#pragma unroll
    for (int a = 0; a < 2; ++a)
#pragma unroll
        for (int b = 0; b < 2; ++b)
#pragma unroll
            for (int m = 0; m < 4; ++m)
#pragma unroll
                for (int n = 0; n < 2; ++n) acc[a][b][m][n] = (f32x4){0.f, 0.f, 0.f, 0.f};
    bf16x8 At[4][2], B0[2][2], B1[2][2];
    const char* cA = (const char*)g.A + (size_t)cur.pm * tstepA; const char* cB = (const char*)g.Bt + (size_t)cur.pn * tstepB;
    {
        PG8_STAGE(PG8_SB(0, 0), cB, voffB); PG8_STAGE(PG8_SB(0, 1), cB + hstepB, voffB); PG8_STAGE(PG8_SA(0, 0), cA, voffA); PG8_STAGE(PG8_SA(0, 1), cA + hstepA, voffA);
        if (wr == 1) PG8_BAR;
        PG8_WAIT_V(2); PG8_BAR;
        PG8_STAGE(PG8_SB(1, 0), cB + kstep, voffB); PG8_STAGE(PG8_SA(1, 0), cA + kstep, voffA); PG8_STAGE(PG8_SB(1, 1), cB + hstepB + kstep, voffB);
        PG8_WAIT_V(6); PG8_BAR;
    }
    for (;;) {
        const bool has_next = S.next(ui + 1, nxt);
        const char* nA = has_next ? (const char*)g.A + (size_t)nxt.pm * tstepA : cA; const char* nB = has_next ? (const char*)g.Bt + (size_t)nxt.pn * tstepB : cB;
        for (int t = 0; t < nt; t += 2) {
            const bool last = (t == nt - 2);
            const char* a1 = cA + (size_t)(t + 1) * kstep;
            const char* a2 = last ? nA : cA + (size_t)(t + 2) * kstep; const char* b2 = last ? nB : cB + (size_t)(t + 2) * kstep;
            const char* a3 = a2 + kstep; const char* b3 = b2 + kstep;
            PG8_LDB(B0, 0, 0); PG8_LDB(B1, 0, 1); PG8_SCHED; PG8_LDA(At, 0, 0); PG8_STAGE(PG8_SA(1, 1), a1 + hstepA, voffA);
            PG8_WAIT_V(8); PG8_WAIT_L(0); PG8_BAR; PG8_MMA(0, 0, At, B0); PG8_MMA(0, 1, At, B1); PG8_BAR; PG8_SCHED;
            PG8_LDA(At, 0, 1); PG8_STAGE(PG8_SB(0, 0), b2, voffB); PG8_STAGE(PG8_SB(0, 1), b2 + hstepB, voffB); PG8_STAGE(PG8_SA(0, 0), a2, voffA);
            PG8_WAIT_V(8); PG8_WAIT_L(0); PG8_BAR; PG8_MMA(1, 0, At, B0); PG8_MMA(1, 1, At, B1); PG8_BAR; PG8_SCHED;
            PG8_LDB(B0, 1, 0); PG8_LDB(B1, 1, 1); PG8_SCHED; PG8_LDA(At, 1, 0); PG8_STAGE(PG8_SA(0, 1), a2 + hstepA, voffA);
            PG8_WAIT_V(8); PG8_WAIT_L(0); PG8_BAR; PG8_MMA(0, 0, At, B0); PG8_MMA(0, 1, At, B1); PG8_BAR; PG8_SCHED;
            PG8_LDA(At, 1, 1); PG8_STAGE(PG8_SB(1, 0), b3, voffB); PG8_STAGE(PG8_SB(1, 1), b3 + hstepB, voffB); PG8_STAGE(PG8_SA(1, 0), a3, voffA);
            PG8_WAIT_V(8); PG8_WAIT_L(0); PG8_BAR; PG8_MMA(1, 0, At, B0); PG8_MMA(1, 1, At, B1); PG8_BAR; PG8_SCHED;
        }
        if (wr == 0) PG8_BAR;
        E(acc, cur, wr, wc, fr, fq);
        if (!has_next) break;
#pragma unroll
        for (int a = 0; a < 2; ++a)
#pragma unroll
            for (int b = 0; b < 2; ++b)
#pragma unroll
                for (int m = 0; m < 4; ++m)
#pragma unroll
                    for (int n = 0; n < 2; ++n) acc[a][b][m][n] = (f32x4){0.f, 0.f, 0.f, 0.f};
        cur = nxt; cA = nA; cB = nB; ++ui;
        if (wr == 1) PG8_BAR;
    }
    PG8_WAIT_V(0);
    PG8_BAR;
#undef PG8_SA
#undef PG8_SB
#undef PG8_STAGE
#undef PG8_LDA
#undef PG8_LDB
#undef PG8_MMA
#undef PG8_WAIT_V
#undef PG8_WAIT_L
#undef PG8_BAR
#undef PG8_SCHED
}

typedef const f32x4 (&AccRef)[2][2][4][2];
__device__ __forceinline__ u32x4 pack8(f32x4 v0, f32x4 v1) { u32x4 w; w.x = pk2(v0[0], v0[1]); w.y = pk2(v0[2], v0[3]); w.z = pk2(v1[0], v1[1]); w.w = pk2(v1[2], v1[3]); return w; }

struct EpiPlain {
    bf16_t* O; int ldc;
    __device__ __forceinline__ void operator()(AccRef acc, const Unit& u, int wr, int wc, int fr, int fq) const {
        const int row0 = u.pm * BM + wr * 64 + fr, col0 = u.pn * BM + wc * 32 + 8 * fq;
#pragma unroll
        for (int ai = 0; ai < 2; ++ai)
#pragma unroll
            for (int m = 0; m < 4; ++m) { bf16_t* rowp = O + (size_t)(row0 + ai * HALF + m * 16) * ldc + col0;
#pragma unroll
                for (int bj = 0; bj < 2; ++bj) *(u32x4*)(rowp + bj * HALF) = pack8(acc[ai][bj][m][0], acc[ai][bj][m][1]); }
    }
};
struct EpiStage1 {
    bf16_t *xa, *qm, *qkv, *halo;
    __device__ __forceinline__ void operator()(AccRef acc, const Unit& u, int wr, int wc, int fr, int fq) const {
        const int pn = u.pn; bf16_t* base; int ldc, colt;
        if (pn < 2) { base = xa; ldc = 512; colt = pn * 256; }
        else if (pn < 4) { base = qm; ldc = 512; colt = (pn - 2) * 256; }
        else { const int t = (pn - 4) >> 2; base = qkv + (size_t)t * M * 1024; ldc = 1024; colt = ((pn - 4) & 3) * 256; }
        const int row0 = u.pm * BM + wr * 64 + fr, col0 = colt + wc * 32 + 8 * fq;
#pragma unroll
        for (int ai = 0; ai < 2; ++ai)
#pragma unroll
            for (int m = 0; m < 4; ++m) { const int row = row0 + ai * HALF + m * 16; bf16_t* rowp = base + (size_t)row * ldc + col0;
#pragma unroll
                for (int bj = 0; bj < 2; ++bj) { const u32x4 w = pack8(acc[ai][bj][m][0], acc[ai][bj][m][1]);
                    *(u32x4*)(rowp + bj * HALF) = w;
                    if (m == 3 && pn >= 4 && fr >= 13) *(u32x4*)(halo + ((size_t)(row >> 6) * 3 + (fr - 13)) * 3072 + (pn - 4) * 256 + bj * HALF + wc * 32 + 8 * fq) = w; } }
    }
};
struct EpiZ {
    bf16_t* Y; const float* SUMSQ;
    __device__ __forceinline__ void operator()(AccRef acc, const Unit& u, int wr, int wc, int fr, int fq) const {
        int tid = threadIdx.x; asm volatile("" : "+v"(tid)); fr = tid & 15; fq = (tid >> 4) & 3;
        const int row0 = u.pm * BM + wr * 64 + fr, col0 = u.pn * BM + wc * 32 + 8 * fq;
        const bool isdn = (col0 >= 512) && (col0 < 1536); const int hd = isdn ? ((col0 - 512) >> 7) : 0;
#pragma unroll
        for (int ai = 0; ai < 2; ++ai)
#pragma unroll
            for (int mh = 0; mh < 2; ++mh) {
                u32x4 o[2][2]; float sq[2][2];
#pragma unroll
                for (int mm = 0; mm < 2; ++mm)
#pragma unroll
                    for (int bj = 0; bj < 2; ++bj) { const size_t row = (size_t)(row0 + ai * HALF + (2 * mh + mm) * 16);
                        o[mm][bj] = *(const u32x4*)(Y + row * 2048 + col0 + bj * HALF); sq[mm][bj] = SUMSQ[row * 8 + (isdn ? hd + bj : 0)]; }
#pragma unroll
                for (int mm = 0; mm < 2; ++mm)
#pragma unroll
                    for (int bj = 0; bj < 2; ++bj) { const int m = 2 * mh + mm; const size_t row = (size_t)(row0 + ai * HALF + m * 16);
                        const f32x4 a0 = acc[ai][bj][m][0], a1 = acc[ai][bj][m][1]; const u32x4 ov = o[mm][bj];
                        const float fac = isdn ? (1.0f / sqrtf(sq[mm][bj] * (1.f / 128.f) + EPS)) : 1.f;
                        f32x4 v0, v1;
                        v0[0] = bflo(ov.x) * silu_f(a0[0]); v0[1] = bfhi(ov.x) * silu_f(a0[1]); v0[2] = bflo(ov.y) * silu_f(a0[2]); v0[3] = bfhi(ov.y) * silu_f(a0[3]);
                        v1[0] = bflo(ov.z) * silu_f(a1[0]); v1[1] = bfhi(ov.z) * silu_f(a1[1]); v1[2] = bflo(ov.w) * silu_f(a1[2]); v1[3] = bfhi(ov.w) * silu_f(a1[3]);
                        *(u32x4*)(Y + row * 2048 + col0 + bj * HALF) = pack8(v0 * fac, v1 * fac); }
                asm volatile("" ::: "memory"); __builtin_amdgcn_sched_barrier(0);
            }
    }
};
struct EpiGate {
    bf16_t* GATE;
    __device__ __forceinline__ void operator()(AccRef acc, const Unit& u, int wr, int wc, int fr, int fq) const {
        int tid = threadIdx.x; asm volatile("" : "+v"(tid)); fr = tid & 15; fq = (tid >> 4) & 3;
        const int row0 = u.pm * BM + wr * 64 + fr, col0 = u.pn * BM + wc * 32 + 8 * fq;
#pragma unroll
        for (int ai = 0; ai < 2; ++ai)
#pragma unroll
            for (int m = 0; m < 4; ++m) { bf16_t* rowp = GATE + (size_t)(row0 + ai * HALF + m * 16) * 3072 + col0;
#pragma unroll
                for (int bj = 0; bj < 2; ++bj) { const f32x4 a0 = acc[ai][bj][m][0], a1 = acc[ai][bj][m][1]; f32x4 v0, v1;
#pragma unroll
                    for (int e = 0; e < 4; ++e) { v0[e] = sigm_f(a0[e]); v1[e] = sigm_f(a1[e]); }
                    *(u32x4*)(rowp + bj * HALF) = pack8(v0, v1); } }
    }
};
template <int BR> struct EpiProj {
    const bf16_t* GATE; bf16_t* Y;
    __device__ __forceinline__ void operator()(AccRef acc, const Unit& u, int wr, int wc, int fr, int fq) const {
        int tid = threadIdx.x; asm volatile("" : "+v"(tid)); fr = tid & 15; fq = (tid >> 4) & 3;
        const int row0 = u.pm * BM + wr * 64 + fr, col0 = u.pn * BM + wc * 32 + 8 * fq;
#pragma unroll
        for (int ai = 0; ai < 2; ++ai)
#pragma unroll
            for (int mh = 0; mh < 2; ++mh) {
                u32x4 gq[2][2], yo[2][2];
#pragma unroll
                for (int mm = 0; mm < 2; ++mm)
#pragma unroll
                    for (int bj = 0; bj < 2; ++bj) { const size_t row = (size_t)(row0 + ai * HALF + (2 * mh + mm) * 16);
                        gq[mm][bj] = *(const u32x4*)(GATE + row * 3072 + BR * 1024 + col0 + bj * HALF);
                        if (BR > 0) yo[mm][bj] = *(const u32x4*)(Y + row * 1024 + col0 + bj * HALF); }
#pragma unroll
                for (int mm = 0; mm < 2; ++mm)
#pragma unroll
                    for (int bj = 0; bj < 2; ++bj) { const int m = 2 * mh + mm; const size_t row = (size_t)(row0 + ai * HALF + m * 16);
                        const f32x4 a0 = acc[ai][bj][m][0], a1 = acc[ai][bj][m][1]; const u32x4 g4 = gq[mm][bj];
                        f32x4 v0, v1;
                        v0[0] = bflo(g4.x) * a0[0]; v0[1] = bfhi(g4.x) * a0[1]; v0[2] = bflo(g4.y) * a0[2]; v0[3] = bfhi(g4.y) * a0[3];
                        v1[0] = bflo(g4.z) * a1[0]; v1[1] = bfhi(g4.z) * a1[1]; v1[2] = bflo(g4.w) * a1[2]; v1[3] = bfhi(g4.w) * a1[3];
                        if (BR > 0) { const u32x4 y4 = yo[mm][bj];
                            v0[0] += bflo(y4.x); v0[1] += bfhi(y4.x); v0[2] += bflo(y4.y); v0[3] += bfhi(y4.y); v1[0] += bflo(y4.z); v1[1] += bfhi(y4.z); v1[2] += bflo(y4.w); v1[3] += bfhi(y4.w); }
                        *(u32x4*)(Y + row * 1024 + col0 + bj * HALF) = pack8(v0, v1); }
                asm volatile("" ::: "memory"); __builtin_amdgcn_sched_barrier(0);
            }
    }
};
struct EpiOutNorm {
    float* O; const float* X; const float* PW; float* rowss; unsigned* cnt;
    __device__ __forceinline__ void operator()(AccRef acc, const Unit& u, int wr, int wc, int fr, int fq) const {
        int tid = threadIdx.x; asm volatile("" : "+v"(tid)); fr = tid & 15; fq = (tid >> 4) & 3;
        const int row0 = u.pm * BM + wr * 64 + fr, col0 = u.pn * BM + wc * 32 + 8 * fq;
#pragma unroll
        for (int ai = 0; ai < 2; ++ai)
#pragma unroll
            for (int m = 0; m < 4; ++m) { const int row = row0 + ai * HALF + m * 16; float ss = 0.f;
#pragma unroll
                for (int bj = 0; bj < 2; ++bj) { const f32x4 a0 = acc[ai][bj][m][0], a1 = acc[ai][bj][m][1];
                    ss += (a0[0] * a0[0] + a0[1] * a0[1]) + (a0[2] * a0[2] + a0[3] * a0[3]) + (a1[0] * a1[0] + a1[1] * a1[1]) + (a1[2] * a1[2] + a1[3] * a1[3]); }
                ss += __shfl_xor(ss, 16); ss += __shfl_xor(ss, 32);
                if (fq == 0) atomicAdd(rowss + row, ss); }
        asm volatile("s_waitcnt vmcnt(0)" ::: "memory");
        __syncthreads();
        if (threadIdx.x == 0) {
            __builtin_amdgcn_fence(__ATOMIC_RELEASE, "agent");
            asm volatile("s_waitcnt vmcnt(0)" ::: "memory");
            __hip_atomic_fetch_add(cnt + u.pm * 16, 1u, __ATOMIC_RELAXED, __HIP_MEMORY_SCOPE_AGENT);
            unsigned sp = 0;
            while (__hip_atomic_load(cnt + u.pm * 16, __ATOMIC_RELAXED, __HIP_MEMORY_SCOPE_AGENT) < 4u) { __builtin_amdgcn_s_sleep(1); if (++sp > (1u << 20)) break; }
            __builtin_amdgcn_fence(__ATOMIC_ACQUIRE, "agent");
            asm volatile("s_waitcnt vmcnt(0)" ::: "memory");
        }
        __syncthreads();
#pragma unroll
        for (int ai = 0; ai < 2; ++ai)
#pragma unroll
            for (int m = 0; m < 4; ++m) { const int row = row0 + ai * HALF + m * 16;
                const float rs = 1.0f / sqrtf(__hip_atomic_load(rowss + row, __ATOMIC_RELAXED, __HIP_MEMORY_SCOPE_AGENT) * (1.f / 1024.f) + EPS);
                f32x4 xv[2][2];
#pragma unroll
                for (int bj = 0; bj < 2; ++bj) { const size_t off = (size_t)row * 1024 + col0 + bj * HALF; xv[bj][0] = *(const f32x4*)(X + off); xv[bj][1] = *(const f32x4*)(X + off + 4); }
#pragma unroll
                for (int bj = 0; bj < 2; ++bj) { const size_t off = (size_t)row * 1024 + col0 + bj * HALF;
                    const f32x4 w0 = *(const f32x4*)(PW + col0 + bj * HALF), w1 = *(const f32x4*)(PW + col0 + bj * HALF + 4);
                    *(f32x4*)(O + off) = xv[bj][0] + acc[ai][bj][m][0] * rs * w0; *(f32x4*)(O + off + 4) = xv[bj][1] + acc[ai][bj][m][1] * rs * w1; }
                if (m & 1) { asm volatile("" ::: "memory"); __builtin_amdgcn_sched_barrier(0); } }
    }
};
}

#define XB_TMO      128
#define XB_XCNT(j)  (256  + 64 * (j))
#define XB_XSUB(j)  (1280 + 64 * (j))
#define XB_XGEN(j)  (2304 + 64 * (j))
#define XB_TOP      3328
#define XB_TOPGEN   3392
#define XCD_BAR_WORDS 3456
#define XB_SPIN_CAP (1u << 18)

__device__ __forceinline__ unsigned xb_ld(unsigned* p)              { return __hip_atomic_load(p, __ATOMIC_RELAXED, __HIP_MEMORY_SCOPE_AGENT); }
__device__ __forceinline__ unsigned xb_add(unsigned* p, unsigned v) { return __hip_atomic_fetch_add(p, v, __ATOMIC_RELAXED, __HIP_MEMORY_SCOPE_AGENT); }
__device__ __forceinline__ unsigned xb_xcc_id() { return (unsigned)__builtin_amdgcn_s_getreg((3 << 11) | 20) & 0xFu; }
#define XB_SPIN(cond, bar) do { unsigned _sp = 0; while (cond) { __builtin_amdgcn_s_sleep(1); \
    if ((++_sp & 255u) == 0u) { if (xb_ld(&(bar)[XB_TMO])) break; if (_sp > XB_SPIN_CAP) { atomicAdd(&(bar)[XB_TMO], 1u); break; } } } } while (0)

struct XcdBarrier {
    unsigned* bar; unsigned x;
    volatile LAS unsigned* st;
};

__device__ __forceinline__ XcdBarrier xcd_barrier_post(unsigned* bar, volatile LAS unsigned* st) {
    XcdBarrier b; b.bar = bar; b.x = xb_xcc_id(); b.st = st;
    if (threadIdx.x == 0) (void)xb_add(&bar[XB_XCNT(b.x)], 1u);
    return b;
}
__device__ __forceinline__ void xcd_barrier_complete(unsigned* bar, unsigned x, unsigned& nloc, unsigned& nx) {
    const unsigned G = gridDim.x * gridDim.y * gridDim.z;
    unsigned sum, cnt, mine, sp = 0u;
    for (;;) {
        sum = 0u; cnt = 0u; mine = 0u;
#pragma unroll
        for (unsigned j = 0; j < 16; ++j) { const unsigned c = xb_ld(&bar[XB_XCNT(j)]); sum += c; cnt += (c > 0u) ? 1u : 0u; mine = (j == x) ? c : mine; }
        if (sum == G) break;
        __builtin_amdgcn_s_sleep(1);
        if ((++sp & 255u) == 0u) { if (xb_ld(&bar[XB_TMO])) break; if (sp > XB_SPIN_CAP) { atomicAdd(&bar[XB_TMO], 1u); break; } }
    }
    nloc = mine > 0u ? mine : 1u; nx = cnt > 0u ? cnt : 1u;
}

__device__ __forceinline__ void xcd_barrier(const XcdBarrier& b) {
    asm volatile("s_waitcnt vmcnt(0)" ::: "memory");
    __syncthreads();
    if (threadIdx.x == 0) {
        unsigned* bar = b.bar;
        __builtin_amdgcn_s_waitcnt(0);
        unsigned nloc = b.st[0], nx = b.st[1];
        if (nloc == 0u) { xcd_barrier_complete(bar, b.x, nloc, nx); b.st[0] = nloc; b.st[1] = nx; }
        const unsigned old = xb_add(&bar[XB_XSUB(b.x)], 1u);
        const unsigned gen = old / nloc;
        if (old + 1u == (gen + 1u) * nloc) {
            __builtin_amdgcn_fence(__ATOMIC_RELEASE, "agent");
            asm volatile("s_waitcnt vmcnt(0)" ::: "memory");
            const unsigned og = xb_add(&bar[XB_TOP], 1u);
            const unsigned tg = og / nx;
            if (og + 1u == (tg + 1u) * nx) xb_add(&bar[XB_TOPGEN], 1u);
            else XB_SPIN(xb_ld(&bar[XB_TOPGEN]) == tg, bar);
            __builtin_amdgcn_fence(__ATOMIC_ACQUIRE, "agent");
            xb_add(&bar[XB_XGEN(b.x)], 1u);
            asm volatile("s_waitcnt vmcnt(0)" ::: "memory");
        } else {
            XB_SPIN(xb_ld(&bar[XB_XGEN(b.x)]) == gen, bar);
            __builtin_amdgcn_fence(__ATOMIC_ACQUIRE, "agent");
            asm volatile("s_waitcnt vmcnt(0)" ::: "memory");
        }
    }
    __syncthreads();
}


struct Args {
    const float *x, *mem, *pre_w, *mem_w, *w_in, *conv_w, *a_log, *dt_bias, *dn_w, *mix_w, *pool_scale, *w_kv, *w_pp, *w_pd, *w_pm, *w_out, *post_w;
    float* out; unsigned char* ws; int ph_lo, ph_hi;
};

__device__ __forceinline__ float wave_sum(float v) {
    v += __builtin_bit_cast(float, __builtin_amdgcn_update_dpp(0, __builtin_bit_cast(int, v), 0xB1, 0xF, 0xF, false));
    v += __builtin_bit_cast(float, __builtin_amdgcn_update_dpp(0, __builtin_bit_cast(int, v), 0x4E, 0xF, 0xF, false));
    v += __builtin_bit_cast(float, __builtin_amdgcn_update_dpp(0, __builtin_bit_cast(int, v), 0x124, 0xF, 0xF, false));
    v += __builtin_bit_cast(float, __builtin_amdgcn_update_dpp(0, __builtin_bit_cast(int, v), 0x128, 0xF, 0xF, false));
    const int vi = __builtin_bit_cast(int, v);
    const float s0 = __builtin_bit_cast(float, __builtin_amdgcn_readlane(vi, 0)), s1 = __builtin_bit_cast(float, __builtin_amdgcn_readlane(vi, 16));
    const float s2 = __builtin_bit_cast(float, __builtin_amdgcn_readlane(vi, 32)), s3 = __builtin_bit_cast(float, __builtin_amdgcn_readlane(vi, 48));
    return (s0 + s1) + (s2 + s3);
}

__device__ __forceinline__ void p0_transpose_item(const float* W, int ldw, int K, bf16_t* WT, LAS float* scr, int kb, int nb, int lane) {
    const int k0 = 64 * kb, n0 = 32 * nb;
    float tv[32];
#pragma unroll
    for (int i = 0; i < 32; ++i) tv[i] = W[(size_t)(k0 + 2 * i + (lane >> 5)) * ldw + n0 + (lane & 31)];
#pragma unroll
    for (int i = 0; i < 32; ++i) scr[(2 * i + (lane >> 5)) * 33 + (lane & 31)] = tv[i];
    LDS_WAIT();
    const int c = lane & 7;
#pragma unroll
    for (int j = 0; j < 4; ++j) { const int n = (lane >> 3) + 8 * j; const LAS float* s = scr + (8 * c) * 33 + n;
        u32x4 o; o.x = pk2(s[0 * 33], s[1 * 33]); o.y = pk2(s[2 * 33], s[3 * 33]); o.z = pk2(s[4 * 33], s[5 * 33]); o.w = pk2(s[6 * 33], s[7 * 33]);
        *(u32x4*)(WT + (size_t)(n0 + n) * K + k0 + 8 * c) = o; }
    LDS_WAIT();
}

__device__ __forceinline__ void p0_prologue(const Args& a, LAS unsigned char* lds) {
    int tid_ = threadIdx.x; asm volatile("" : "+v"(tid_));
    const int tid = tid_, lane = tid & 63, wave = tid >> 6, G = gridDim.x;
    unsigned char* ws = a.ws;
    LAS float* W16 = (LAS float*)lds;
    LAS float* scr = (LAS float*)(lds + 65536 + wave * 8448);
    for (int idx = tid; idx < 4096; idx += 512) { const int i = idx >> 2, q = idx & 3; const int p = ((i >> 8) * 4 + (i & 3)) * 64 + ((i >> 2) & 63);
        *(LAS f32x4*)(W16 + (q * 1024 + p) * 4) = *(const f32x4*)(a.w_in + (size_t)i * INW + 4096 + 4 * q); }
    for (int i = blockIdx.x * 512 + tid; i < M; i += G * 512) ((float*)(ws + WS_ROWSS))[i] = 0.f;
    for (int i = blockIdx.x * 512 + tid; i < M * 8; i += G * 512) ((float*)(ws + WS_SUMSQ))[i] = 0.f;
    __syncthreads();
    const int gw = blockIdx.x * 8 + wave, NGW = G * 8;
    bf16_t* WT = (bf16_t*)(ws + WS_WT);
#define SEG(src, ldw, Kk, Nseg, dst) { const int ni = ((Kk) / 64) * ((Nseg) / 32); if (r < ni) { const int nblk = (Nseg) / 32; p0_transpose_item((src), (ldw), (Kk), (dst), scr, r / nblk, r % nblk, lane); continue; } r -= ni; }
    constexpr int NITEMS = 16 * 128 + 512 + 32;
    for (int it = gw; it < NITEMS; it += NGW) {
        int r = it;
        SEG(a.w_in + 0, INW, 1024, 512, WT)
        SEG(a.w_in + 5136, INW, 1024, 512, WT + (size_t)512 * 1024)
        SEG(a.w_in + 1024, INW, 1024, 3072, WT + (size_t)1024 * 1024)
        SEG(a.w_kv, 1024, 1024, 1024, (bf16_t*)(ws + WS_WKV))
        SEG(a.mix_w + 0 * 16384, 128, 128, 128, (bf16_t*)(ws + WS_WMIX) + 0 * 16384)
        SEG(a.mix_w + 1 * 16384, 128, 128, 128, (bf16_t*)(ws + WS_WMIX) + 1 * 16384)
        SEG(a.mix_w + 2 * 16384, 128, 128, 128, (bf16_t*)(ws + WS_WMIX) + 2 * 16384)
        SEG(a.mix_w + 3 * 16384, 128, 128, 128, (bf16_t*)(ws + WS_WMIX) + 3 * 16384)
    }
    f32x4 nwx[4], nwm[4];
#pragma unroll
    for (int j = 0; j < 4; ++j) { nwx[j] = ((const f32x4*)a.pre_w)[lane + 64 * j]; nwm[j] = ((const f32x4*)a.mem_w)[lane + 64 * j]; }
    f32x4 vnx[4];
    {   const int m = gw; const float* src = (m >= M) ? a.mem + (size_t)(m - M) * 1024 : a.x + (size_t)m * 1024;
#pragma unroll
        for (int j = 0; j < 4; ++j) vnx[j] = ((const f32x4*)src)[lane + 64 * j]; }
    for (int m = gw; m < M + NB * MEML; m += NGW) {
        const bool is_mem = m >= M;
        bf16_t* dst = is_mem ? (bf16_t*)(ws + WS_MEMN) + (size_t)(m - M) * 1024 : (bf16_t*)(ws + WS_H) + (size_t)m * 1024;
        f32x4 v[4]; float s = 0.f;
#pragma unroll
        for (int j = 0; j < 4; ++j) { v[j] = vnx[j]; s += (v[j].x * v[j].x + v[j].y * v[j].y) + (v[j].z * v[j].z + v[j].w * v[j].w); }
        {   const int m2 = (m + NGW < M + NB * MEML) ? m + NGW : m; const float* src = (m2 >= M) ? a.mem + (size_t)(m2 - M) * 1024 : a.x + (size_t)m2 * 1024;
#pragma unroll
            for (int j = 0; j < 4; ++j) vnx[j] = ((const f32x4*)src)[lane + 64 * j]; }
        const float rstd = 1.0f / sqrtf(wave_sum(s) * (1.f / 1024.f) + EPS);
#pragma unroll
        for (int j = 0; j < 4; ++j) { const f32x4 wv = is_mem ? nwm[j] : nwx[j]; v[j] = v[j] * rstd * wv;
            u32x2 o; o.x = pk2(v[j].x, v[j].y); o.y = pk2(v[j].z, v[j].w); ((u32x2*)dst)[lane + 64 * j] = o; }
        if (!is_mem) {
            f32x4 acc[4];
#pragma unroll
            for (int q = 0; q < 4; ++q) acc[q] = (f32x4){0.f, 0.f, 0.f, 0.f};
#pragma unroll
            for (int j = 0; j < 4; ++j)
#pragma unroll
                for (int e = 0; e < 4; ++e) { const float xv = v[j][e];
#pragma unroll
                    for (int q = 0; q < 4; ++q) { const f32x4 wv = *(const LAS f32x4*)(W16 + (q * 1024 + (j * 4 + e) * 64 + lane) * 4); acc[q] += xv * wv; } }
            float val = 0.f;
#pragma unroll
            for (int q = 0; q < 4; ++q)
#pragma unroll
                for (int e = 0; e < 4; ++e) { const float t = wave_sum(acc[q][e]); if (lane == q * 4 + e) val = t; }
            if (lane < 8) { const float z = val + a.dt_bias[lane]; const float sp = z > 20.f ? z : log1pf(expf(z));
                ((float*)(ws + WS_G))[(size_t)m * 8 + lane] = -expf(a.a_log[lane]) * sp; }
            else if (lane < 16) ((float*)(ws + WS_BETA))[(size_t)m * 8 + lane - 8] = 1.f / (1.f + expf(-val));
        }
    }
}

__device__ __forceinline__ void late_transposes(const Args& a, LAS unsigned char* lds, int c, int GG) {
    int tid_ = threadIdx.x; asm volatile("" : "+v"(tid_));
    const int tid = tid_, lane = tid & 63, wave = tid >> 6;
    unsigned char* ws = a.ws; bf16_t* WT = (bf16_t*)(ws + WS_WT);
    LAS float* scr = (LAS float*)(lds + wave * 8448);
    __syncthreads();
    const int gw = c * 8 + wave, NGW = GG * 8;
    constexpr int NITEMS = 16 * 160 + 256 + 512 + 256 + 512;
    for (int it = gw; it < NITEMS; it += NGW) {
        int r = it;
        SEG(a.w_in + 512, INW, 1024, 512, WT + (size_t)4096 * 1024)
        SEG(a.w_in + 4112, INW, 1024, 1024, WT + (size_t)4608 * 1024)
        SEG(a.w_in + 5648, INW, 1024, 512, WT + (size_t)5632 * 1024)
        SEG(a.w_in + 6160, INW, 1024, 3072, WT + (size_t)6144 * 1024)
        SEG(a.w_pp, 1024, 512, 1024, (bf16_t*)(ws + WS_WP))
        SEG(a.w_pd, 1024, 1024, 1024, (bf16_t*)(ws + WS_WD))
        SEG(a.w_pm, 1024, 512, 1024, (bf16_t*)(ws + WS_WM))
        SEG(a.w_out, 1024, 1024, 1024, (bf16_t*)(ws + WS_WOUT))
    }
    __syncthreads();
}
#undef SEG

__device__ __forceinline__ void chunk_load_raw(const Args& a, int item, u32x4 (&raw)[11], int tid) {
    const int n = item & 31, h = (item >> 5) & 7, b = item >> 8; const int r0 = b * SEQ + 64 * n, gci = b * 32 + n;
    const int ten = tid >> 7, cgp = tid & 15, rg = (tid >> 4) & 7;
    if (tid < 384) {
        const bf16_t* src = (const bf16_t*)(a.ws + WS_QKV) + (size_t)ten * M * 1024 + h * 128 + cgp * 8;
#pragma unroll
        for (int i = 0; i < 11; ++i) { const int rr = 8 * rg - 3 + i;
            if (rr >= 0) raw[i] = *(const u32x4*)(src + (size_t)(r0 + rr) * 1024);
            else if (n > 0) raw[i] = *(const u32x4*)((const bf16_t*)(a.ws + WS_HALO) + ((size_t)(gci - 1) * 3 + (rr + 3)) * 3072 + ten * 1024 + h * 128 + cgp * 8);
            else raw[i] = (u32x4){0u, 0u, 0u, 0u}; }
    }
}
__device__ __forceinline__ void chunk_prep_item(const Args& a, LAS unsigned char* lds, int item, u32x4 (&raw)[11], int item_next, float& gpre, float& bpre, int set, int stage, int nvalid) {
    int tid_ = threadIdx.x; asm volatile("" : "+v"(tid_));
    const int tid = tid_, lane = tid & 63, wid = tid >> 6, r16 = lane & 15, qp = lane >> 4;
    const int n = item & 31, h = (item >> 5) & 7, b = item >> 8;
    const int r0 = b * SEQ + 64 * n, gci = b * 32 + n;
    unsigned char* ws = a.ws;
    bf16_t* QKV = (bf16_t*)(ws + WS_QKV);
    LAS bf16_t* Kn = (LAS bf16_t*)(lds);
    LAS bf16_t* Qn = (LAS bf16_t*)(lds + 17408);
    const int sset = (stage == 1) ? (wid >> 2) : set;
    LAS bf16_t* Tb = (LAS bf16_t*)(lds + sset * 9216);
    LAS bf16_t* VbT = (LAS bf16_t*)(lds + 34816 + sset * 36864);
    LAS bf16_t* KbgT = (LAS bf16_t*)(lds + 53248 + sset * 36864);
    LAS float* Ap = (LAS float*)(lds + 108544 + sset * 17408);
    LAS float* gcs = (LAS float*)(lds + 143360 + sset * 512);
    LAS float* bts = gcs + 64;
    __syncthreads();
    if (stage == 0) {
    if (wid == 0) {
        float g = gpre;
        const float bt = bpre;
        if (item_next >= 0) { const int n2 = item_next & 31, h2 = (item_next >> 5) & 7, b2 = item_next >> 8; const int r2 = b2 * SEQ + 64 * n2;
            gpre = ((const float*)(ws + WS_G))[(size_t)(r2 + lane) * 8 + h2]; bpre = ((const float*)(ws + WS_BETA))[(size_t)(r2 + lane) * 8 + h2]; }
#pragma unroll
        for (int o = 1; o < 64; o <<= 1) { const float t = __shfl_up(g, o); if (lane >= o) g += t; }
        gcs[lane] = g; bts[lane] = bt;
        if (lane == 63) ((float*)(ws + WS_GL))[item] = __expf(g);
    }
    __syncthreads();
    u32x4 outA[8];
    const int ten = tid >> 7, cgp = tid & 15, rg = (tid >> 4) & 7;
    if (tid < 384) {
        f32x4 cw[4][2];
#pragma unroll
        for (int j = 0; j < 4; ++j) { const float* cp = a.conv_w + (size_t)j * 3072 + ten * 1024 + h * 128 + cgp * 8; cw[j][0] = *(const f32x4*)cp; cw[j][1] = *(const f32x4*)(cp + 4); }
        float y[8][8];
#pragma unroll
        for (int i = 0; i < 8; ++i) {
#pragma unroll
            for (int e = 0; e < 8; ++e) y[i][e] = 0.f;
#pragma unroll
            for (int j = 0; j < 4; ++j) { const u32x4 rv = raw[i + j];
                y[i][0] += cw[j][0][0] * bflo(rv.x); y[i][1] += cw[j][0][1] * bfhi(rv.x); y[i][2] += cw[j][0][2] * bflo(rv.y); y[i][3] += cw[j][0][3] * bfhi(rv.y);
                y[i][4] += cw[j][1][0] * bflo(rv.z); y[i][5] += cw[j][1][1] * bfhi(rv.z); y[i][6] += cw[j][1][2] * bflo(rv.w); y[i][7] += cw[j][1][3] * bfhi(rv.w); }
#pragma unroll
            for (int e = 0; e < 8; ++e) y[i][e] = silu_f(y[i][e]);
        }
        if (item_next >= 0) chunk_load_raw(a, item_next, raw, tid);
        const float gl = gcs[63];
        if (ten < 2) {
#pragma unroll
            for (int i = 0; i < 8; ++i) { float ss = 0.f;
#pragma unroll
                for (int e = 0; e < 8; ++e) ss += y[i][e] * y[i][e];
                ss += __shfl_xor(ss, 1); ss += __shfl_xor(ss, 2); ss += __shfl_xor(ss, 4); ss += __shfl_xor(ss, 8);
                const float sc = (1.0f / sqrtf(ss + EPS)) * (ten == 0 ? 0.08838834764831845f : 1.f);
#pragma unroll
                for (int e = 0; e < 8; ++e) y[i][e] *= sc; }
        }
        if (ten == 0) {
#pragma unroll
            for (int i = 0; i < 8; ++i) { const int row = 8 * rg + i; const float eg = __expf(gcs[row]);
                u32x4 w; w.x = pk2(y[i][0], y[i][1]); w.y = pk2(y[i][2], y[i][3]); w.z = pk2(y[i][4], y[i][5]); w.w = pk2(y[i][6], y[i][7]);
                *(LAS u32x4*)(Qn + row * 136 + cgp * 8) = w;
                outA[i].x = pk2(y[i][0] * eg, y[i][1] * eg); outA[i].y = pk2(y[i][2] * eg, y[i][3] * eg); outA[i].z = pk2(y[i][4] * eg, y[i][5] * eg); outA[i].w = pk2(y[i][6] * eg, y[i][7] * eg); }
        } else if (ten == 1) {
            float f1[8], f2[8];
#pragma unroll
            for (int i = 0; i < 8; ++i) { const int row = 8 * rg + i; const float gc = gcs[row]; f1[i] = bts[row] * __expf(gc); f2[i] = __expf(gl - gc);
                u32x4 w; w.x = pk2(y[i][0], y[i][1]); w.y = pk2(y[i][2], y[i][3]); w.z = pk2(y[i][4], y[i][5]); w.w = pk2(y[i][6], y[i][7]);
                *(LAS u32x4*)(Kn + row * 136 + cgp * 8) = w; }
#pragma unroll
            for (int e = 0; e < 8; ++e) { u32x4 w;
                w.x = pk2(y[0][e] * f1[0], y[1][e] * f1[1]); w.y = pk2(y[2][e] * f1[2], y[3][e] * f1[3]); w.z = pk2(y[4][e] * f1[4], y[5][e] * f1[5]); w.w = pk2(y[6][e] * f1[6], y[7][e] * f1[7]);
                *(LAS u32x4*)(KbgT + (cgp * 8 + e) * 72 + 8 * rg) = w;
                outA[e].x = pk2(y[0][e] * f2[0], y[1][e] * f2[1]); outA[e].y = pk2(y[2][e] * f2[2], y[3][e] * f2[3]); outA[e].z = pk2(y[4][e] * f2[4], y[5][e] * f2[5]); outA[e].w = pk2(y[6][e] * f2[6], y[7][e] * f2[7]); }
        } else {
            float f1[8];
#pragma unroll
            for (int i = 0; i < 8; ++i) f1[i] = bts[8 * rg + i];
#pragma unroll
            for (int e = 0; e < 8; ++e) { u32x4 w;
                w.x = pk2(y[0][e] * f1[0], y[1][e] * f1[1]); w.y = pk2(y[2][e] * f1[2], y[3][e] * f1[3]); w.z = pk2(y[4][e] * f1[4], y[5][e] * f1[5]); w.w = pk2(y[6][e] * f1[6], y[7][e] * f1[7]);
                *(LAS u32x4*)(VbT + (cgp * 8 + e) * 72 + 8 * rg) = w; }
        }
    }
    __syncthreads();
    if (tid < 128) {
#pragma unroll
        for (int i = 0; i < 8; ++i) *(u32x4*)(QKV + (size_t)(r0 + 8 * rg + i) * 1024 + h * 128 + cgp * 8) = outA[i];
    } else if (tid < 256) {
#pragma unroll
        for (int e = 0; e < 8; ++e) { const int k = cgp * 8 + e;
            *(u32x4*)((unsigned char*)(QKV + (size_t)2 * M * 1024 + (size_t)(r0 + (k >> 1)) * 1024 + h * 128) + (k & 1) * 128 + 16 * rg) = outA[e]; }
    }
    {
        const int mat = wid >> 2, ti = wid & 3;
        const LAS bf16_t* Bm = mat ? Qn : Kn;
        f32x4 c4[4];
#pragma unroll
        for (int tj = 0; tj < 4; ++tj) c4[tj] = (f32x4){0.f, 0.f, 0.f, 0.f};
#pragma unroll
        for (int ks = 0; ks < 4; ++ks) { const bf16x8 af = *(const LAS bf16x8*)(Kn + (ti * 16 + r16) * 136 + ks * 32 + 8 * qp);
#pragma unroll
            for (int tj = 0; tj < 4; ++tj) { const bf16x8 bf = *(const LAS bf16x8*)(Bm + (tj * 16 + r16) * 136 + ks * 32 + 8 * qp); c4[tj] = MFMA16(af, bf, c4[tj]); } }
        const int j0 = ti * 16 + 4 * qp;
        const f32x4 gj = *(const LAS f32x4*)(gcs + j0);
#pragma unroll
        for (int tj = 0; tj < 4; ++tj) { const int i = tj * 16 + r16; const float gi = gcs[i]; f32x4 v;
#pragma unroll
            for (int e = 0; e < 4; ++e) { const int j = j0 + e; const float d = __expf(fminf(gi - gj[e], 0.f)); const bool keep = mat ? (j <= i) : (j < i); v[e] = keep ? c4[tj][e] * d : 0.f; }
            if (mat == 0) { v = v * bts[i];
#pragma unroll
                for (int e = 0; e < 4; ++e) Ap[i * 68 + e * 16 + ti * 4 + qp] = v[e]; }
            else { u32x2 o; o.x = pk2(v[0], v[1]); o.y = pk2(v[2], v[3]); *(u32x2*)((bf16_t*)(ws + WS_AQK) + (size_t)item * 4096 + i * 64 + j0) = o; } }
    }
    }
    if (stage == 1 && (wid >> 2) < nvalid) {
        const int ph = lane & 3, c = 16 * (wid & 3) + (lane >> 2);
        float t[16];
#pragma unroll
        for (int m = 0; m < 16; ++m) t[m] = 0.f;
        f32x4 cf[3][4];
#define LOADROW(ii, slot) do { _Pragma("unroll") for (int m4 = 0; m4 < 4; ++m4) if (m4 * 16 < (ii) && (ii) < 64) cf[slot][m4] = *(const LAS f32x4*)(Ap + (ii) * 68 + ph * 16 + 4 * m4); } while (0)
        LOADROW(0, 0); LOADROW(1, 1); LOADROW(2, 2);
#pragma unroll
        for (int i = 0; i < 64; ++i) {
            float acc0 = 0.f, acc1 = 0.f;
#pragma unroll
            for (int m4 = 0; m4 * 16 < i; ++m4) { const f32x4 av = cf[i % 3][m4];
                acc0 += av[0] * t[4 * m4];
                if ((4 * m4 + 1) * 4 < i) acc1 += av[1] * t[4 * m4 + 1];
                if ((4 * m4 + 2) * 4 < i) acc0 += av[2] * t[4 * m4 + 2];
                if ((4 * m4 + 3) * 4 < i) acc1 += av[3] * t[4 * m4 + 3]; }
            __builtin_amdgcn_sched_barrier(0);
            LOADROW(i + 3, i % 3);
            __builtin_amdgcn_sched_barrier(0);
            float acc = acc0 + acc1;
            acc += __builtin_bit_cast(float, __builtin_amdgcn_update_dpp(0, __builtin_bit_cast(int, acc), 0xB1, 0xF, 0xF, false));
            acc += __builtin_bit_cast(float, __builtin_amdgcn_update_dpp(0, __builtin_bit_cast(int, acc), 0x4E, 0xF, 0xF, false));
            const float val = ((c == i) ? 1.f : 0.f) - acc;
            t[i >> 2] = (ph == (i & 3)) ? val : t[i >> 2];
        }
#undef LOADROW
#pragma unroll
        for (int m = 0; m < 16; ++m) Tb[(4 * m + ph) * 72 + c] = (bf16_t)f2bf(t[m]);
    }
    if (stage == 2) {
        f32x4 cu[4], cwv[4];
#pragma unroll
        for (int ct = 0; ct < 4; ++ct) { cu[ct] = (f32x4){0.f, 0.f, 0.f, 0.f}; cwv[ct] = (f32x4){0.f, 0.f, 0.f, 0.f}; }
#pragma unroll
        for (int ks = 0; ks < 2; ++ks) {
            const bf16x8 vb = *(const LAS bf16x8*)(VbT + (16 * wid + r16) * 72 + ks * 32 + 8 * qp);
            const bf16x8 kb = *(const LAS bf16x8*)(KbgT + (16 * wid + r16) * 72 + ks * 32 + 8 * qp);
#pragma unroll
            for (int ct = 0; ct < 4; ++ct) { const bf16x8 tf = *(const LAS bf16x8*)(Tb + (16 * ct + r16) * 72 + ks * 32 + 8 * qp);
                cu[ct] = MFMA16(tf, vb, cu[ct]); cwv[ct] = MFMA16(kb, tf, cwv[ct]); }
        }
#pragma unroll
        for (int ct = 0; ct < 4; ++ct) {
            u32x2 o; o.x = pk2(cu[ct][0], cu[ct][1]); o.y = pk2(cu[ct][2], cu[ct][3]);
            ((u32x2*)(ws + WS_U))[(((size_t)item * 8 + wid) * 4 + ct) * 64 + lane] = o;
            u32x2 w2; w2.x = pk2(-cwv[ct][0], -cwv[ct][1]); w2.y = pk2(-cwv[ct][2], -cwv[ct][3]);
            *(u32x2*)(QKV + (size_t)M * 1024 + (size_t)(r0 + 16 * ct + r16) * 1024 + h * 128 + 16 * wid + 4 * qp) = w2;
        }
    }
}

__device__ __forceinline__ bf16x8 ldA_perm(const LAS bf16_t* p) {
    const u32x2 lo = *(const LAS u32x2*)p, hi = *(const LAS u32x2*)(p + 16);
    u32x4 v; v.x = lo.x; v.y = lo.y; v.z = hi.x; v.w = hi.y; return __builtin_bit_cast(bf16x8, v);
}
__device__ __forceinline__ bf16x8 packB(f32x4 t0, f32x4 t1) {
    u32x4 v; v.x = pk2(t0[0], t0[1]); v.y = pk2(t0[2], t0[3]); v.z = pk2(t1[0], t1[1]); v.w = pk2(t1[2], t1[3]); return __builtin_bit_cast(bf16x8, v);
}
constexpr int SC_W = 0, SC_QG = 18432, SC_AQK = 36864, SC_KDT = 47104, SC_BUF = 67584, SC_RED = 2 * SC_BUF, SC_RSTD = SC_RED + 2048;

__device__ __forceinline__ void scan_load(const Args& a, int bh, int n, u32x4 (&stg)[7]) {
    const int tid = threadIdx.x, b = bh >> 3, h = bh & 7; const int r0 = b * SEQ + 64 * n; const int item = bh * 32 + n;
    const bf16_t* QKV = (const bf16_t*)(a.ws + WS_QKV);
    const int c = tid >> 4, k8 = tid & 15;
#pragma unroll
    for (int i = 0; i < 2; ++i) {
        stg[i] = *(const u32x4*)(QKV + (size_t)M * 1024 + (size_t)(r0 + c + 32 * i) * 1024 + h * 128 + k8 * 8);
        stg[2 + i] = *(const u32x4*)(QKV + (size_t)(r0 + c + 32 * i) * 1024 + h * 128 + k8 * 8);
        stg[4 + i] = *(const u32x4*)(QKV + (size_t)2 * M * 1024 + (size_t)(r0 + c + 32 * i) * 1024 + h * 128 + k8 * 8);
    }
    stg[6] = *(const u32x4*)((const bf16_t*)(a.ws + WS_AQK) + (size_t)item * 4096 + tid * 8);
}
__device__ __forceinline__ void st_perm(LAS unsigned char* rowp  , int a4  , u32x4 v) {
    const int p0 = (a4 & 1) * 16 + (a4 >> 1) * 4;
    u32x2 lo; lo.x = v.x; lo.y = v.y; u32x2 hi; hi.x = v.z; hi.y = v.w;
    *(LAS u32x2*)(rowp + p0 * 2) = lo; *(LAS u32x2*)(rowp + (p0 + 8) * 2) = hi;
}
__device__ __forceinline__ void scan_store(LAS unsigned char* buf, const u32x4 (&stg)[7]) {
    const int tid = threadIdx.x; const int c = tid >> 4, k8 = tid & 15;
#pragma unroll
    for (int i = 0; i < 2; ++i) {
        st_perm(buf + SC_W + ((c + 32 * i) * 144 + (k8 >> 2) * 32) * 2, k8 & 3, stg[i]);
        st_perm(buf + SC_QG + ((c + 32 * i) * 144 + (k8 >> 2) * 32) * 2, k8 & 3, stg[2 + i]);
        const int line = c + 32 * i, k = line * 2 + (k8 >> 3), c8 = k8 & 7;
        st_perm(buf + SC_KDT + (k * 80 + (c8 >> 2) * 32) * 2, c8 & 3, stg[4 + i]);
    }
    { const int cc = tid >> 3, j8 = tid & 7; st_perm(buf + SC_AQK + (cc * 80 + (j8 >> 2) * 32) * 2, j8 & 3, stg[6]); }
}
__device__ __forceinline__ float dpp_add16(float v) {
    v += __builtin_bit_cast(float, __builtin_amdgcn_update_dpp(0, __builtin_bit_cast(int, v), 0xB1, 0xF, 0xF, false));
    v += __builtin_bit_cast(float, __builtin_amdgcn_update_dpp(0, __builtin_bit_cast(int, v), 0x4E, 0xF, 0xF, false));
    v += __builtin_bit_cast(float, __builtin_amdgcn_update_dpp(0, __builtin_bit_cast(int, v), 0x124, 0xF, 0xF, false));
    v += __builtin_bit_cast(float, __builtin_amdgcn_update_dpp(0, __builtin_bit_cast(int, v), 0x128, 0xF, 0xF, false));
    return v;
}
#define LDA128(p) (*(const LAS bf16x8*)(p))

struct ScanSet { u32x4 stg[7]; u32x2 u[4]; float gl; };
__device__ __forceinline__ void scan_load_set(const Args& a, int bh, int n, ScanSet& t, int lane, int wid) {
    scan_load(a, bh, n, t.stg);
#pragma unroll
    for (int ct = 0; ct < 4; ++ct) t.u[ct] = ((const u32x2*)(a.ws + WS_U))[(((size_t)(bh * 32 + n) * 8 + wid) * 4 + ct) * 64 + lane];
    t.gl = ((const float*)(a.ws + WS_GL))[bh * 32 + n];
}
__device__ __forceinline__ void scan_step(const Args& a, LAS unsigned char* lds, int bh, int n, f32x4 (&S)[8], ScanSet& T, float dnw, int lane, int wid, int r16, int qp, bool accum) {
    const int tid = threadIdx.x, b = bh >> 3, h = bh & 7;
    bf16_t* Y = (bf16_t*)a.out;
    LAS unsigned char* buf = lds + (n & 1) * SC_BUF;
    const float gl = T.gl;
    f32x4 vn[4], o[4];
#pragma unroll
    for (int ct = 0; ct < 4; ++ct) { const u32x2 uu = T.u[ct];
        vn[ct] = (f32x4){bflo(uu.x), bfhi(uu.x), bflo(uu.y), bfhi(uu.y)}; o[ct] = (f32x4){0.f, 0.f, 0.f, 0.f}; }
    __builtin_amdgcn_sched_barrier(0);
    if (n + 1 < 32) scan_load_set(a, bh, n + 1, T, lane, wid);
    __builtin_amdgcn_sched_barrier(0);
    bf16x8 sb[4];
#pragma unroll
    for (int s = 0; s < 4; ++s) sb[s] = packB(S[2 * s], S[2 * s + 1]);
    const LAS bf16_t* Wb = (const LAS bf16_t*)(buf + SC_W); const LAS bf16_t* QGb = (const LAS bf16_t*)(buf + SC_QG);
    const LAS bf16_t* AQb = (const LAS bf16_t*)(buf + SC_AQK); const LAS bf16_t* KDb = (const LAS bf16_t*)(buf + SC_KDT);
    bf16x8 fa[8], fb[8];
#define SB() __builtin_amdgcn_sched_barrier(0)
#define LD_VO2(f, ca, cb, sh) do { _Pragma("unroll") for (int s_ = 0; s_ < 2; ++s_) { \
        f[4 * s_ + 0] = LDA128(Wb + (16 * (ca) + r16) * 144 + 32 * ((sh) + s_) + 8 * qp); f[4 * s_ + 1] = LDA128(Wb + (16 * (cb) + r16) * 144 + 32 * ((sh) + s_) + 8 * qp); \
        f[4 * s_ + 2] = LDA128(QGb + (16 * (ca) + r16) * 144 + 32 * ((sh) + s_) + 8 * qp); f[4 * s_ + 3] = LDA128(QGb + (16 * (cb) + r16) * 144 + 32 * ((sh) + s_) + 8 * qp); } } while (0)
#define MM_VO2(f, ca, cb, sh) do { _Pragma("unroll") for (int s_ = 0; s_ < 2; ++s_) { \
        vn[ca] = MFMA16(f[4 * s_ + 0], sb[(sh) + s_], vn[ca]); vn[cb] = MFMA16(f[4 * s_ + 1], sb[(sh) + s_], vn[cb]); \
        o[ca] = MFMA16(f[4 * s_ + 2], sb[(sh) + s_], o[ca]); o[cb] = MFMA16(f[4 * s_ + 3], sb[(sh) + s_], o[cb]); } } while (0)
#define LD_AQ(f) do { _Pragma("unroll") for (int c_ = 0; c_ < 4; ++c_) { f[c_] = LDA128(AQb + (16 * c_ + r16) * 80 + 8 * qp); f[4 + c_] = LDA128(AQb + (16 * c_ + r16) * 80 + 32 + 8 * qp); } } while (0)
#define MM_AQ(f) do { _Pragma("unroll") for (int c_ = 0; c_ < 4; ++c_) o[c_] = MFMA16(f[c_], vb[0], o[c_]); _Pragma("unroll") for (int c_ = 0; c_ < 4; ++c_) o[c_] = MFMA16(f[4 + c_], vb[1], o[c_]); } while (0)
#define LD_KD(f, k0) do { _Pragma("unroll") for (int c_ = 0; c_ < 4; ++c_) { f[c_] = LDA128(KDb + (16 * ((k0) + c_) + r16) * 80 + 8 * qp); f[4 + c_] = LDA128(KDb + (16 * ((k0) + c_) + r16) * 80 + 32 + 8 * qp); } } while (0)
#define MM_KD(f, k0) do { _Pragma("unroll") for (int c_ = 0; c_ < 4; ++c_) S[(k0) + c_] = MFMA16(f[c_], vb[0], S[(k0) + c_] * gl); _Pragma("unroll") for (int c_ = 0; c_ < 4; ++c_) S[(k0) + c_] = MFMA16(f[4 + c_], vb[1], S[(k0) + c_]); } while (0)
    LD_VO2(fa, 0, 1, 0); LD_VO2(fb, 0, 1, 2); SB();
    MM_VO2(fa, 0, 1, 0); SB(); LD_VO2(fa, 2, 3, 0); SB();
    MM_VO2(fb, 0, 1, 2); SB(); LD_VO2(fb, 2, 3, 2); SB();
    MM_VO2(fa, 2, 3, 0); SB(); LD_AQ(fa); SB();
    MM_VO2(fb, 2, 3, 2); SB(); LD_KD(fb, 0); SB();
    bf16x8 vb[2];
#pragma unroll
    for (int s = 0; s < 2; ++s) vb[s] = packB(vn[2 * s], vn[2 * s + 1]);
    MM_AQ(fa); SB(); LD_KD(fa, 4); SB();
    MM_KD(fb, 0); SB();
    MM_KD(fa, 4); SB();
#undef SB
#undef LD_VO2
#undef MM_VO2
#undef LD_AQ
#undef MM_AQ
#undef LD_KD
#undef MM_KD
    {
        float v16[16];
#pragma unroll
        for (int ct = 0; ct < 4; ++ct)
#pragma unroll
            for (int e = 0; e < 4; ++e) v16[4 * ct + e] = o[ct][e] * o[ct][e];
#define DPPF(x, ctrl) __builtin_bit_cast(float, __builtin_amdgcn_update_dpp(0, __builtin_bit_cast(int, (x)), (ctrl), 0xF, 0xF, false))
        float w8[8], w4[4], w2[2];
        const bool b3 = r16 & 8, b2 = r16 & 4, b1 = r16 & 2, b0 = r16 & 1;
#pragma unroll
        for (int j = 0; j < 8; ++j) { const float keep = b3 ? v16[j + 8] : v16[j], send = b3 ? v16[j] : v16[j + 8]; w8[j] = keep + DPPF(send, 0x128); }
#pragma unroll
        for (int j = 0; j < 4; ++j) { const float keep = b2 ? w8[j + 4] : w8[j], send = b2 ? w8[j] : w8[j + 4]; w4[j] = keep + DPPF(send, 0x141); }
#pragma unroll
        for (int j = 0; j < 2; ++j) { const float keep = b1 ? w4[j + 2] : w4[j], send = b1 ? w4[j] : w4[j + 2]; w2[j] = keep + DPPF(send, 0x1B); }
        const float keep = b0 ? w2[1] : w2[0], send = b0 ? w2[0] : w2[1];
        const float tot = keep + DPPF(send, 0xB1);
#undef DPPF
        if (accum) atomicAdd((float*)(a.ws + WS_SUMSQ) + (size_t)(b * SEQ + 64 * n + 16 * (r16 >> 2) + 4 * qp + (r16 & 3)) * 8 + h, tot);
    }
    if (n + 1 < 32) scan_store(lds + ((n + 1) & 1) * SC_BUF, T.stg);
    const int rowb = b * SEQ + 64 * n;
#pragma unroll
    for (int ct = 0; ct < 4; ++ct)
#pragma unroll
        for (int e = 0; e < 4; ++e) Y[(size_t)(rowb + 16 * ct + 4 * qp + e) * 2048 + 512 + h * 128 + 16 * wid + r16] = (bf16_t)f2bf(o[ct][e] * dnw);
    __syncthreads();
}

__device__ __forceinline__ void scan_bh(const Args& a, LAS unsigned char* lds, int bh, bool accum = true) {
    int tid_ = threadIdx.x; asm volatile("" : "+v"(tid_));
    const int tid = tid_, lane = tid & 63, wid = tid >> 6, r16 = lane & 15, qp = lane >> 4;
    const float dnw = a.dn_w[16 * wid + r16];
    f32x4 S[8];
#pragma unroll
    for (int kt = 0; kt < 8; ++kt) S[kt] = (f32x4){0.f, 0.f, 0.f, 0.f};
    ScanSet T;
    __syncthreads();
    scan_load_set(a, bh, 0, T, lane, wid);
    scan_store(lds, T.stg);
    __syncthreads();
#pragma unroll 1
    for (int n = 0; n < 32; ++n) scan_step(a, lds, bh, n, S, T, dnw, lane, wid, r16, qp, accum);
}

__device__ __forceinline__ void attn_item(const Args& a, LAS unsigned char* lds, int item) {
    int tid_ = threadIdx.x; asm volatile("" : "+v"(tid_));
    const int tid = tid_, lane = tid & 63, wid = tid >> 6, r16 = lane & 15, qp = lane >> 4;
    const int qt = item & 15, head = (item >> 4) & 3, b = item >> 6;
    LAS bf16_t* Ks = (LAS bf16_t*)lds;
    LAS bf16_t* Vt = (LAS bf16_t*)(lds + 69632);
    const bf16_t* KM = (const bf16_t*)(a.ws + WS_KMEM); const bf16_t* VM = (const bf16_t*)(a.ws + WS_VMEMT); const bf16_t* QM = (const bf16_t*)(a.ws + WS_QM);
    __syncthreads();
#pragma unroll
    for (int i = 0; i < 8; ++i) { const int p = tid + 512 * i;
        { const int key = p >> 4, d8 = p & 15; *(LAS u32x4*)(Ks + key * 136 + d8 * 8) = *(const u32x4*)(KM + (size_t)(b * 256 + key) * 512 + head * 128 + d8 * 8); }
        { const int d = p >> 5, k8 = p & 31; *(LAS u32x4*)(Vt + d * 264 + k8 * 8) = *(const u32x4*)(VM + (size_t)(head * 128 + d) * 2048 + b * 256 + k8 * 8); } }
    const int qrow = b * SEQ + qt * 128 + 16 * wid + r16;
    bf16x8 qf[4];
#pragma unroll
    for (int s = 0; s < 4; ++s) qf[s] = *(const bf16x8*)(QM + (size_t)qrow * 512 + head * 128 + 32 * s + 8 * qp);
    __syncthreads();
    f32x4 sc[16];
#pragma unroll
    for (int kt = 0; kt < 16; ++kt) { sc[kt] = (f32x4){0.f, 0.f, 0.f, 0.f};
#pragma unroll
        for (int s = 0; s < 4; ++s) sc[kt] = MFMA16(*(const LAS bf16x8*)(Ks + (16 * kt + r16) * 136 + 32 * s + 8 * qp), qf[s], sc[kt]); }
    float mx = -3.0e38f;
#pragma unroll
    for (int kt = 0; kt < 16; ++kt) mx = fmaxf(fmaxf(fmaxf(sc[kt][0], sc[kt][1]), fmaxf(sc[kt][2], sc[kt][3])), mx);
    mx = fmaxf(mx, __shfl_xor(mx, 16)); mx = fmaxf(mx, __shfl_xor(mx, 32));
    const float scl = 0.08838834764831845f; float sum = 0.f;
#pragma unroll
    for (int kt = 0; kt < 16; ++kt)
#pragma unroll
        for (int e = 0; e < 4; ++e) { const float p = __expf((sc[kt][e] - mx) * scl); sc[kt][e] = p; sum += p; }
    sum += __shfl_xor(sum, 16); sum += __shfl_xor(sum, 32);
    f32x4 o[8];
#pragma unroll
    for (int dt = 0; dt < 8; ++dt) o[dt] = (f32x4){0.f, 0.f, 0.f, 0.f};
#pragma unroll
    for (int s = 0; s < 8; ++s) { const bf16x8 pb = packB(sc[2 * s], sc[2 * s + 1]);
#pragma unroll
        for (int dt = 0; dt < 8; ++dt) o[dt] = MFMA16(ldA_perm(Vt + (16 * dt + r16) * 264 + 32 * s + 4 * qp), pb, o[dt]); }
    const float inv = 1.f / sum;
    bf16_t* Y = (bf16_t*)a.out;
#pragma unroll
    for (int dt = 0; dt < 8; ++dt) { u32x2 w; w.x = pk2(o[dt][0] * inv, o[dt][1] * inv); w.y = pk2(o[dt][2] * inv, o[dt][3] * inv);
        *(u32x2*)(Y + (size_t)qrow * 2048 + 1536 + head * 128 + 16 * dt + 4 * qp) = w; }
}

__device__ __forceinline__ void pool_item(const Args& a, LAS unsigned char* lds, int item) {
    int tid_ = threadIdx.x; asm volatile("" : "+v"(tid_));
    const int tid = tid_, lane = tid & 63, wid = tid >> 6, r16 = lane & 15, qp = lane >> 4;
    const int g = item & 3, tt = (item >> 2) & 31, b = item >> 7;
    LAS bf16_t* Xs = (LAS bf16_t*)lds;
    LAS bf16_t* Ps = (LAS bf16_t*)(lds + 20480);
    const bf16_t* XA = (const bf16_t*)(a.ws + WS_XA);
    const int t0 = tt * 64;
    __syncthreads();
    for (int p = tid; p < 1280; p += 512) { const int row = p >> 4, c8 = p & 15; const int t = t0 - 16 + row; u32x4 v = (u32x4){0u, 0u, 0u, 0u};
        if (t >= 0) v = *(const u32x4*)(XA + (size_t)(b * SEQ + t) * 512 + g * 128 + c8 * 8);
        *(LAS u32x4*)(Xs + row * 128 + c8 * 8) = v; }
    __syncthreads();
    {
        const int c = tid & 127, rgp = tid >> 7, w = 2 << g; float sum = 0.f;
        for (int j = 1; j < w; ++j) sum += bflo((unsigned)Xs[(16 + 16 * rgp - j) * 128 + c]);
        const float invw = 1.f / (float)w;
#pragma unroll 4
        for (int i = 0; i < 16; ++i) { const int row = 16 * rgp + i; const float xv = bflo((unsigned)Xs[(16 + row) * 128 + c]); sum += xv;
            const int t = t0 + row; const float mean = (t + 1 >= w) ? sum * invw : sum / (float)(t + 1);
            Ps[row * 136 + c] = (bf16_t)f2bf(mean - xv);
            sum -= bflo((unsigned)Xs[(16 + row - (w - 1)) * 128 + c]); }
    }
    __syncthreads();
    const bf16_t* WX = (const bf16_t*)(a.ws + WS_WMIX) + g * 16384;
    f32x4 acc[4];
#pragma unroll
    for (int t4 = 0; t4 < 4; ++t4) acc[t4] = (f32x4){0.f, 0.f, 0.f, 0.f};
#pragma unroll
    for (int s = 0; s < 4; ++s) { const bf16x8 af = *(const bf16x8*)(WX + (16 * wid + r16) * 128 + 32 * s + 8 * qp);
#pragma unroll
        for (int t4 = 0; t4 < 4; ++t4) acc[t4] = MFMA16(af, *(const LAS bf16x8*)(Ps + (16 * t4 + r16) * 136 + 32 * s + 8 * qp), acc[t4]); }
    const f32x4 psc = *(const f32x4*)(a.pool_scale + g * 128 + 16 * wid + 4 * qp);
    bf16_t* Y = (bf16_t*)a.out;
#pragma unroll
    for (int t4 = 0; t4 < 4; ++t4) { u32x2 w2; w2.x = pk2(acc[t4][0] * psc[0], acc[t4][1] * psc[1]); w2.y = pk2(acc[t4][2] * psc[2], acc[t4][3] * psc[3]);
        *(u32x2*)(Y + (size_t)(b * SEQ + t0 + 16 * t4 + r16) * 2048 + g * 128 + 16 * wid + 4 * qp) = w2; }
}

#ifndef REP_P0
#define REP_P0 1
#endif
#ifndef REP_P1
#define REP_P1 1
#endif
#ifndef REP_P3
#define REP_P3 1
#endif
#ifndef REP_P5
#define REP_P5 1
#endif
#define P0_BODY if (IN(0)) p0_prologue(a, lds);
#define P1_BODY \
    if (IN(1)) { \
        {   pg8::Gemm g{(const bf16_t*)(ws + WS_H), (const bf16_t*)(ws + WS_WT), 1024, 1024, 1024}; pg8::StaticOrder S; S.init(M, 4096, G, bx); \
            pg8::EpiStage1 E{(bf16_t*)(ws + WS_XA), (bf16_t*)(ws + WS_QM), (bf16_t*)(ws + WS_QKV), (bf16_t*)(ws + WS_HALO)}; \
            pg8::gemm_phase(lds, g, S, E); } \
    }
#ifndef REP_SCAN
#define REP_SCAN 1
#endif
#ifndef REP_ATTN
#define REP_ATTN 1
#endif
#ifndef REP_POOL
#define REP_POOL 1
#endif
#define P3_BODY \
    if (IN(3)) { \
        unsigned* kvcnt = (unsigned*)(ws + WS_CTL) + 8192; \
        if (G >= 128) { \
            if (bx < 64) { for (int rep = 0; rep < REP_SCAN; ++rep) scan_bh(a, lds, bx, rep == 0); } \
            else { const int c = bx - 64, GG = G - 64; \
                if (c < 32) { \
                    pg8::OneUnit S1; \
                    if (c < 16) { S1.u.pm = c >> 1; S1.u.pn = c & 1; pg8::Gemm g{(const bf16_t*)(ws + WS_MEMN), (const bf16_t*)(ws + WS_WKV), 1024, 1024, 1024}; pg8::EpiPlain E{(bf16_t*)(ws + WS_KMEM), 512}; pg8::gemm_phase(lds, g, S1, E); } \
                    else { S1.u.pm = (c - 16) >> 3; S1.u.pn = (c - 16) & 7; pg8::Gemm g{(const bf16_t*)(ws + WS_WKV) + (size_t)512 * 1024, (const bf16_t*)(ws + WS_MEMN), 1024, 1024, 1024}; pg8::EpiPlain E{(bf16_t*)(ws + WS_VMEMT), 2048}; pg8::gemm_phase(lds, g, S1, E); } \
                    asm volatile("s_waitcnt vmcnt(0)" ::: "memory"); __syncthreads(); \
                    if (tid == 0) { __builtin_amdgcn_fence(__ATOMIC_RELEASE, "agent"); asm volatile("s_waitcnt vmcnt(0)" ::: "memory"); __hip_atomic_fetch_add(kvcnt, 1u, __ATOMIC_RELAXED, __HIP_MEMORY_SCOPE_AGENT); } \
                } \
                bool kv_ok = false; \
                for (int it = c; it < 1024 * REP_POOL + 512 * REP_ATTN; it += GG) { \
                    if (it < 1024 * REP_POOL) pool_item(a, lds, it & 1023); \
                    else { \
                        if (!kv_ok) { if (tid == 0) { unsigned sp = 0; while (__hip_atomic_load(kvcnt, __ATOMIC_RELAXED, __HIP_MEMORY_SCOPE_AGENT) < 32u) { __builtin_amdgcn_s_sleep(2); if (++sp > (1u << 20)) break; } \
                                __builtin_amdgcn_fence(__ATOMIC_ACQUIRE, "agent"); asm volatile("s_waitcnt vmcnt(0)" ::: "memory"); } __syncthreads(); kv_ok = true; } \
                        attn_item(a, lds, (it - 1024 * REP_POOL) & 511); } } \
                late_transposes(a, lds, c, GG); } \
        } else { \
            for (int it = bx; it < 32; it += G) { pg8::OneUnit S1; \
                    if (it < 16) { S1.u.pm = it >> 1; S1.u.pn = it & 1; pg8::Gemm g{(const bf16_t*)(ws + WS_MEMN), (const bf16_t*)(ws + WS_WKV), 1024, 1024, 1024}; pg8::EpiPlain E{(bf16_t*)(ws + WS_KMEM), 512}; pg8::gemm_phase(lds, g, S1, E); } \
                    else { S1.u.pm = (it - 16) >> 3; S1.u.pn = (it - 16) & 7; pg8::Gemm g{(const bf16_t*)(ws + WS_WKV) + (size_t)512 * 1024, (const bf16_t*)(ws + WS_MEMN), 1024, 1024, 1024}; pg8::EpiPlain E{(bf16_t*)(ws + WS_VMEMT), 2048}; pg8::gemm_phase(lds, g, S1, E); } } \
            xcd_barrier(xbar); \
            for (int it = bx; it < 64 + 512 + 1024; it += G) { if (it < 64) scan_bh(a, lds, it); else if (it < 576) attn_item(a, lds, it - 64); else pool_item(a, lds, it - 576); } \
            late_transposes(a, lds, bx, G); \
        } \
    }
#define P5_BODY \
    if (IN(5)) { \
        pg8::StaticOrder SO; SO.init(M, 1024, G, bx); \
        pg8::OneUnit S1; \
        if (SO.next(0, S1.u)) { \
            bf16_t* Y = (bf16_t*)(ws + WS_Y); const bf16_t* YC = (const bf16_t*)a.out; const bf16_t* GT = (const bf16_t*)(ws + WS_GATE); \
            {   pg8::Gemm g{YC, (const bf16_t*)(ws + WS_WP), 2048, 512, 512}; pg8::EpiProj<0> E{GT, Y}; pg8::gemm_phase(lds, g, S1, E); } \
            {   pg8::Gemm g{YC + 512, (const bf16_t*)(ws + WS_WD), 2048, 1024, 1024}; pg8::EpiProj<1> E{GT, Y}; pg8::gemm_phase(lds, g, S1, E); } \
            {   pg8::Gemm g{YC + 1536, (const bf16_t*)(ws + WS_WM), 2048, 512, 512}; pg8::EpiProj<2> E{GT, Y}; pg8::gemm_phase(lds, g, S1, E); } \
        } \
    }
__global__ void __launch_bounds__(512, 2) hybrid_fwd(Args a) {
    extern __shared__ __attribute__((aligned(16))) unsigned char lds_raw[];
    LAS unsigned char* lds = (LAS unsigned char*)lds_raw;
    const int G = gridDim.x, bx = blockIdx.x, tid = threadIdx.x;
    unsigned char* ws = a.ws;
    const int lo = a.ph_lo, hi = a.ph_hi;
    volatile LAS unsigned* xst = (volatile LAS unsigned*)(lds + LDS_BYTES - 16);
    if (tid < 4) xst[tid] = 0u;
    __syncthreads();
    XcdBarrier xbar; xbar.bar = (unsigned*)(ws + WS_CTL); xbar.x = 0; xbar.st = xst;
    if (hi - lo > 1) xbar = xcd_barrier_post((unsigned*)(ws + WS_CTL), xst);
    if (lo == 0x7fffffff) cg::this_grid().sync();
#define IN(k) (lo <= (k) && (k) < hi)
#define SEAM(k) do { if (IN(k) && IN((k) + 1)) xcd_barrier(xbar); } while (0)
    P0_BODY
#if REP_P0 > 1
    xcd_barrier(xbar);
    P0_BODY
#endif
    SEAM(0);
#ifndef REP_P12
#define REP_P12 1
#endif
    for (int rep12 = 0; rep12 < REP_P12; ++rep12) {
    if (rep12) xcd_barrier(xbar);
    P1_BODY
#if REP_P1 > 1
    xcd_barrier(xbar);
    P1_BODY
#endif
    SEAM(1);
#ifndef NO_P2
    if (IN(2)) { u32x4 raw[11]; float gpre = 0.f, bpre = 0.f; if (bx < 2048) { chunk_load_raw(a, bx, raw, tid); if (tid < 64) { const int n2 = bx & 31, h2 = (bx >> 5) & 7, b2 = bx >> 8; const int r2 = b2 * SEQ + 64 * n2; gpre = ((const float*)(ws + WS_G))[(size_t)(r2 + tid) * 8 + h2]; bpre = ((const float*)(ws + WS_BETA))[(size_t)(r2 + tid) * 8 + h2]; } }
#pragma unroll 1
        for (int it0 = bx; it0 < 2048; it0 += 2 * G) {
            const int it1 = it0 + G; const int nvalid = (it1 < 2048) ? 2 : 1;
#pragma unroll 1
            for (int ms = 0; ms < 5; ++ms) {
                const int st = (ms < 2) ? 0 : (ms == 2 ? 1 : 2); const int st_set = (ms == 1 || ms == 4) ? 1 : 0;
                if (st != 1 && st_set == 1 && nvalid < 2) continue;
                const int itc = st_set ? it1 : it0;
                chunk_prep_item(a, lds, itc, raw, (itc + G < 2048) ? itc + G : -1, gpre, bpre, st_set, st, nvalid);
            }
        } }
#endif
    }
    SEAM(2);
    P3_BODY
#if REP_P3 > 1
    xcd_barrier(xbar);
    P3_BODY
#endif
    SEAM(3);
    if (IN(4)) {
        {   pg8::Gemm g{(const bf16_t*)(ws + WS_H), (const bf16_t*)(ws + WS_WT) + (size_t)4096 * 1024, 1024, 1024, 1024}; pg8::StaticOrder S; S.init(M, 2048, G, bx);
            pg8::EpiZ E{(bf16_t*)a.out, (const float*)(ws + WS_SUMSQ)}; pg8::gemm_phase(lds, g, S, E); }
        {   pg8::Gemm g{(const bf16_t*)(ws + WS_H), (const bf16_t*)(ws + WS_WT) + (size_t)6144 * 1024, 1024, 1024, 1024}; pg8::StaticOrder S; S.init(M, 3072, G, bx);
            pg8::EpiGate E{(bf16_t*)(ws + WS_GATE)}; pg8::gemm_phase(lds, g, S, E); }
    }
    SEAM(4);
    P5_BODY
#if REP_P5 > 1
    xcd_barrier(xbar);
    P5_BODY
#endif
    SEAM(5);
    if (IN(6)) {
        pg8::Gemm g{(const bf16_t*)(ws + WS_Y), (const bf16_t*)(ws + WS_WOUT), 1024, 1024, 1024}; pg8::StaticOrder S; S.init(M, 1024, G, bx);
        pg8::EpiOutNorm E{a.out, a.x, a.post_w, (float*)(ws + WS_ROWSS), (unsigned*)(ws + WS_CTL) + 4096};
        pg8::gemm_phase(lds, g, S, E);
    }
#undef IN
#undef SEAM
}

extern "C" void kernel_launch(void* const* d_in, const int* in_sizes, int n_in, void* d_out, int out_size, void* d_ws, size_t ws_size, hipStream_t stream) {
    static int grid = 0;
    if (grid == 0) {
        if (n_in != 17 || out_size != M * DM || ws_size < WS_END) { fprintf(stderr, "kernel_launch: unexpected shapes (n_in %d out %d ws %zu)\n", n_in, out_size, ws_size); grid = -1; return; }
        int dev = 0, cus = 0, per_cu = 0;
        hipGetDevice(&dev); hipDeviceGetAttribute(&cus, hipDeviceAttributeMultiprocessorCount, dev);
        if (hipFuncSetAttribute((const void*)hybrid_fwd, hipFuncAttributeMaxDynamicSharedMemorySize, LDS_BYTES) != hipSuccess) { fprintf(stderr, "kernel_launch: hipFuncSetAttribute failed\n"); grid = -1; return; }
        if (hipOccupancyMaxActiveBlocksPerMultiprocessor(&per_cu, (const void*)hybrid_fwd, 512, LDS_BYTES) != hipSuccess || per_cu < 1) { fprintf(stderr, "kernel_launch: occupancy query gives %d\n", per_cu); per_cu = 1; }
        (void)hipGetLastError();
        grid = cus * 1;
        if (grid > 256) grid = 256;
    }
    if (grid < 0) return;
    Args a{};
    a.x = (const float*)d_in[0]; a.mem = (const float*)d_in[1]; a.pre_w = (const float*)d_in[2]; a.mem_w = (const float*)d_in[3]; a.w_in = (const float*)d_in[4];
    a.conv_w = (const float*)d_in[5]; a.a_log = (const float*)d_in[6]; a.dt_bias = (const float*)d_in[7]; a.dn_w = (const float*)d_in[8]; a.mix_w = (const float*)d_in[9];
    a.pool_scale = (const float*)d_in[10]; a.w_kv = (const float*)d_in[11]; a.w_pp = (const float*)d_in[12]; a.w_pd = (const float*)d_in[13]; a.w_pm = (const float*)d_in[14];
    a.w_out = (const float*)d_in[15]; a.post_w = (const float*)d_in[16];
    a.out = (float*)d_out; a.ws = (unsigned char*)d_ws;
#if MK_PER_PHASE
    for (int p = 0; p < 7; ++p) { a.ph_lo = p; a.ph_hi = p + 1; hipLaunchKernelGGL(hybrid_fwd, dim3(grid), dim3(512), LDS_BYTES, stream, a); }
#else
    a.ph_lo = 0; a.ph_hi = 7;
    if (hipMemsetAsync((char*)d_ws + WS_CTL, 0, 65536, stream) != hipSuccess) { fprintf(stderr, "kernel_launch: memset of the barrier words failed\n"); return; }
    void* args[] = {&a};
    hipError_t e = hipLaunchCooperativeKernel((const void*)hybrid_fwd, dim3(grid), dim3(512), args, LDS_BYTES, stream);
    if (e != hipSuccess) fprintf(stderr, "kernel_launch: cooperative launch failed: %s (grid %d)\n", hipGetErrorString(e), grid);
#endif
}
```

```cpp
#include <hip/hip_runtime.h>
#include <hip/hip_cooperative_groups.h>
#include <cstdio>
#include <cstdint>
namespace cg = cooperative_groups;

#ifndef MK_PER_PHASE
#define MK_PER_PHASE 0
#endif

#define LAS __attribute__((address_space(3)))
typedef unsigned short bf16_t;
typedef short bf16x8 __attribute__((ext_vector_type(8)));
typedef float f32x4 __attribute__((ext_vector_type(4)));
typedef unsigned u32x4 __attribute__((ext_vector_type(4)));
typedef unsigned u32x2 __attribute__((ext_vector_type(2)));

constexpr int DM = 1024, NB = 8, SEQ = 2048, M = NB * SEQ, INW = 9232, MEML = 256;
constexpr float EPS = 1e-6f;
constexpr size_t MiB = 1u << 20;
constexpr size_t WS_WT = 0;
constexpr size_t WS_WKV = 18 * MiB;
constexpr size_t WS_WP = 20 * MiB;
constexpr size_t WS_WD = 21 * MiB;
constexpr size_t WS_WM = 23 * MiB;
constexpr size_t WS_WOUT = 24 * MiB;
constexpr size_t WS_WMIX = 26 * MiB;
constexpr size_t WS_G = 26 * MiB + 256 * 1024;
constexpr size_t WS_BETA = WS_G + 512 * 1024;
constexpr size_t WS_ROWSS = WS_BETA + 512 * 1024;
constexpr size_t WS_GL = WS_ROWSS + 64 * 1024;
constexpr size_t WS_SUMSQ = 27 * MiB + 384 * 1024;
constexpr size_t WS_H = 28 * MiB;
constexpr size_t WS_MEMN = 60 * MiB;
constexpr size_t WS_KMEM = 64 * MiB;
constexpr size_t WS_VMEMT = 66 * MiB;
constexpr size_t WS_XA = 68 * MiB;
constexpr size_t WS_QM = 84 * MiB;
constexpr size_t WS_QKV = 100 * MiB;
constexpr size_t WS_HALO = 196 * MiB;
constexpr size_t WS_U = 201 * MiB;
constexpr size_t WS_AQK = 233 * MiB;
constexpr size_t WS_CTL = 250 * MiB;
constexpr size_t WS_END = 251 * MiB;
constexpr size_t WS_Y = WS_XA;
constexpr size_t WS_GATE = WS_QKV;
constexpr int LDS_BYTES = 147456;

__device__ __forceinline__ unsigned f2bf(float f) { unsigned u = __float_as_uint(f); return (u + 0x7fffu + ((u >> 16) & 1u)) >> 16; }
typedef __bf16 bf16x2_t __attribute__((ext_vector_type(2)));
typedef float f32x2_t __attribute__((ext_vector_type(2)));
__device__ __forceinline__ unsigned pk2(float lo, float hi) { f32x2_t v = {lo, hi}; bf16x2_t b = __builtin_convertvector(v, bf16x2_t); return __builtin_bit_cast(unsigned, b); }
__device__ __forceinline__ float bflo(unsigned u) { return __uint_as_float(u << 16); }
__device__ __forceinline__ float bfhi(unsigned u) { return __uint_as_float(u & 0xffff0000u); }
__device__ __forceinline__ unsigned cvt_pk_bf16(float lo, float hi) { unsigned r; asm volatile("v_cvt_pk_bf16_f32 %0, %1, %2" : "=v"(r) : "v"(lo), "v"(hi)); return r; }
__device__ __forceinline__ float silu_f(float z) { return z * __builtin_amdgcn_rcpf(1.f + __expf(-z)); }
__device__ __forceinline__ float sigm_f(float z) { return __builtin_amdgcn_rcpf(1.f + __expf(-z)); }
#define LDS_WAIT() asm volatile("s_waitcnt lgkmcnt(0)" ::: "memory")
#define MFMA16(a, b, c) __builtin_amdgcn_mfma_f32_16x16x32_bf16((a), (b), (c), 0, 0, 0)

namespace pg8 {
constexpr int BM = 256, BK = 64, HALF = 128, HTB = HALF * BK * 2, STAGE_BYTES = 8 * HTB, NXCD = 8, WGM = 8;
__host__ __device__ __forceinline__ int lds_byte(int r, int c) { const int st = (r >> 4) * 2 + (c >> 5), rr = r & 15, cc = c & 31, ob = rr * 64 + cc * 2; return st * 1024 + (ob ^ (((ob >> 9) & 1) << 5)); }
__host__ __device__ __forceinline__ void stage_rc(int b, int& R, int& C) { const int st = b / 1024, sb = b % 1024, swz = sb ^ (((sb >> 9) & 1) << 5); R = (st >> 1) * 16 + swz / 64; C = (st & 1) * 32 + (swz % 64) / 2; }
__host__ __device__ __forceinline__ int perm32(int rho) { const int n = rho >> 4, i = rho & 15; return 8 * (i >> 2) + 4 * n + (i & 3); }
struct Unit { int pm, pn; };
struct Gemm { const bf16_t* A; const bf16_t* Bt; int lda, ldb, K; };
struct StaticOrder {
    int nM, nN, nwg, G, c;
    __device__ void init(int Mr, int Nc, int G_, int c_) { nM = Mr / BM; nN = Nc / BM; nwg = nM * nN; G = G_; c = c_; }
    __device__ bool next(int i, Unit& u) const {
        const long L = (long)i * G + c; if (L >= nwg) return false;
        int wgid = (int)L; { const int q = nwg / NXCD, r = nwg % NXCD, xcd = wgid % NXCD, off = wgid / NXCD; wgid = (xcd < r ? xcd * (q + 1) : r * (q + 1) + (xcd - r) * q) + off; }
        const int nig = WGM * nN, gid = wgid / nig, fm = gid * WGM, gsz = (nM - fm) < WGM ? (nM - fm) : WGM;
        u.pm = fm + ((wgid % nig) % gsz); u.pn = (wgid % nig) / gsz; return true;
    }
};
struct OneUnit {
    Unit u;
    __device__ bool next(int i, Unit& o) const { if (i) return false; o = u; return true; }
};

template <class Epi, class Sched>
__device__ __forceinline__ void gemm_phase(LAS unsigned char* lds, const Gemm g, const Sched& S, const Epi& E) {
    int tid_ = threadIdx.x; asm volatile("" : "+v"(tid_));
    const int tid = tid_, wid = __builtin_amdgcn_readfirstlane(tid >> 6), lane = tid & 63, wr = wid >> 2, wc = wid & 3, fr = lane & 15, fq = lane >> 4;
    const int K = g.K, nt = K / BK;
    unsigned voffA[2], voffB[2];
#pragma unroll
    for (int i = 0; i < 2; ++i) { int R, C; stage_rc(tid * 16 + i * 8192, R, C); const int Rb = (R & ~31) + perm32(R & 31);
        voffA[i] = (unsigned)(R * g.lda + C) * 2u; voffB[i] = (unsigned)(Rb * g.ldb + C) * 2u; }
    const size_t kstep = (size_t)(BK * 2);
    const size_t hstepA = (size_t)HALF * g.lda * 2, hstepB = (size_t)HALF * g.ldb * 2;
    const size_t tstepA = 2 * hstepA, tstepB = 2 * hstepB;
    const unsigned ldsw = (unsigned)wid * 1024u;
    const int aoff = lds_byte(wr * 64 + fr, fq * 8), boff = lds_byte(wc * 32 + fr, fq * 8);
#define PG8_SA(b, h) (((b) * 2 + (h)) * HTB)
#define PG8_SB(b, h) ((4 + (b) * 2 + (h)) * HTB)
#define PG8_STAGE(bufoff, gbase, voff) do { _Pragma("unroll") for (int _i = 0; _i < 2; ++_i) \
        __builtin_amdgcn_global_load_lds((const unsigned*)((const char*)(gbase) + (voff)[_i]), (LAS unsigned*)(lds + (bufoff) + ldsw + _i * 8192), 16, 0, 0); } while (0)
#define PG8_LDA(dst, b, h) do { _Pragma("unroll") for (int m = 0; m < 4; ++m) _Pragma("unroll") for (int k = 0; k < 2; ++k) dst[m][k] = *(const LAS bf16x8*)(lds + PG8_SA(b, h) + aoff + m * 2048 + k * 1024); } while (0)
#define PG8_LDB(dst, b, h) do { _Pragma("unroll") for (int n = 0; n < 2; ++n) _Pragma("unroll") for (int k = 0; k < 2; ++k) dst[n][k] = *(const LAS bf16x8*)(lds + PG8_SB(b, h) + boff + n * 2048 + k * 1024); } while (0)
#define PG8_MMA(ai, bj, At, Bt) do { __builtin_amdgcn_s_setprio(1); _Pragma("unroll") for (int m = 0; m < 4; ++m) _Pragma("unroll") for (int n = 0; n < 2; ++n) _Pragma("unroll") for (int k = 0; k < 2; ++k) \
        acc[ai][bj][m][n] = __builtin_amdgcn_mfma_f32_16x16x32_bf16(Bt[n][k], At[m][k], acc[ai][bj][m][n], 0, 0, 0); __builtin_amdgcn_s_setprio(0); } while (0)
#define PG8_WAIT_V(n) asm volatile("s_waitcnt vmcnt(" #n ")" ::: "memory")
#define PG8_WAIT_L(n) asm volatile("s_waitcnt lgkmcnt(" #n ")" ::: "memory")
#define PG8_BAR __builtin_amdgcn_s_barrier()
#define PG8_SCHED __builtin_amdgcn_sched_barrier(0)
    Unit cur, nxt; int ui = 0;
    if (!S.next(0, cur)) return;
    f32x4 acc[2][2][4][2];
#pragma unroll
    for (int a = 0; a < 2; ++a)
#pragma unroll
        for (int b = 0; b < 2; ++b)
#pragma unroll
            for (int m = 0; m < 4; ++m)
#pragma unroll
                for (int n = 0; n < 2; ++n) acc[a][b][m][n] = (f32x4){0.f, 0.f, 0.f, 0.f};
    bf16x8 At[4][2], B0[2][2], B1[2][2];
    const char* cA = (const char*)g.A + (size_t)cur.pm * tstepA; const char* cB = (const char*)g.Bt + (size_t)cur.pn * tstepB;
    {
        PG8_STAGE(PG8_SB(0, 0), cB, voffB); PG8_STAGE(PG8_SB(0, 1), cB + hstepB, voffB); PG8_STAGE(PG8_SA(0, 0), cA, voffA); PG8_STAGE(PG8_SA(0, 1), cA + hstepA, voffA);
        if (wr == 1) PG8_BAR;
        PG8_WAIT_V(2); PG8_BAR;
        PG8_STAGE(PG8_SB(1, 0), cB + kstep, voffB); PG8_STAGE(PG8_SA(1, 0), cA + kstep, voffA); PG8_STAGE(PG8_SB(1, 1), cB + hstepB + kstep, voffB);
        PG8_WAIT_V(6); PG8_BAR;
    }
    for (;;) {
        const bool has_next = S.next(ui + 1, nxt);
        const char* nA = has_next ? (const char*)g.A + (size_t)nxt.pm * tstepA : cA; const char* nB = has_next ? (const char*)g.Bt + (size_t)nxt.pn * tstepB : cB;
        for (int t = 0; t < nt; t += 2) {
            const bool last = (t == nt - 2);
            const char* a1 = cA + (size_t)(t + 1) * kstep;
            const char* a2 = last ? nA : cA + (size_t)(t + 2) * kstep; const char* b2 = last ? nB : cB + (size_t)(t + 2) * kstep;
            const char* a3 = a2 + kstep; const char* b3 = b2 + kstep;
            PG8_LDB(B0, 0, 0); PG8_LDB(B1, 0, 1); PG8_SCHED; PG8_LDA(At, 0, 0); PG8_STAGE(PG8_SA(1, 1), a1 + hstepA, voffA);
            PG8_WAIT_V(8); PG8_WAIT_L(0); PG8_BAR; PG8_MMA(0, 0, At, B0); PG8_MMA(0, 1, At, B1); PG8_BAR; PG8_SCHED;
            PG8_LDA(At, 0, 1); PG8_STAGE(PG8_SB(0, 0), b2, voffB); PG8_STAGE(PG8_SB(0, 1), b2 + hstepB, voffB); PG8_STAGE(PG8_SA(0, 0), a2, voffA);
            PG8_WAIT_V(8); PG8_WAIT_L(0); PG8_BAR; PG8_MMA(1, 0, At, B0); PG8_MMA(1, 1, At, B1); PG8_BAR; PG8_SCHED;
            PG8_LDB(B0, 1, 0); PG8_LDB(B1, 1, 1); PG8_SCHED; PG8_LDA(At, 1, 0); PG8_STAGE(PG8_SA(0, 1), a2 + hstepA, voffA);
            PG8_WAIT_V(8); PG8_WAIT_L(0); PG8_BAR; PG8_MMA(0, 0, At, B0); PG8_MMA(0, 1, At, B1); PG8_BAR; PG8_SCHED;
            PG8_LDA(At, 1, 1); PG8_STAGE(PG8_SB(1, 0), b3, voffB); PG8_STAGE(PG8_SB(1, 1), b3 + hstepB, voffB); PG8_STAGE(PG8_SA(1, 0), a3, voffA);
            PG8_WAIT_V(8); PG8_WAIT_L(0); PG8_BAR; PG8_MMA(1, 0, At, B0); PG8_MMA(1, 1, At, B1); PG8_BAR; PG8_SCHED;
        }
        if (wr == 0) PG8_BAR;
        E(acc, cur, wr, wc, fr, fq);
        if (!has_next) break;
#pragma unroll
        for (int a = 0; a < 2; ++a)
#pragma unroll
            for (int b = 0; b < 2; ++b)
#pragma unroll
                for (int m = 0; m < 4; ++m)
#pragma unroll
                    for (int n = 0; n < 2; ++n) acc[a][b][m][n] = (f32x4){0.f, 0.f, 0.f, 0.f};
        cur = nxt; cA = nA; cB = nB; ++ui;
        if (wr == 1) PG8_BAR;
    }
    PG8_WAIT_V(0);
    PG8_BAR;
#undef PG8_SA
#undef PG8_SB
#undef PG8_STAGE
#undef PG8_LDA
#undef PG8_LDB
#undef PG8_MMA
#undef PG8_WAIT_V
#undef PG8_WAIT_L
#undef PG8_BAR
#undef PG8_SCHED
}

typedef const f32x4 (&AccRef)[2][2][4][2];
__device__ __forceinline__ u32x4 pack8(f32x4 v0, f32x4 v1) { u32x4 w; w.x = pk2(v0[0], v0[1]); w.y = pk2(v0[2], v0[3]); w.z = pk2(v1[0], v1[1]); w.w = pk2(v1[2], v1[3]); return w; }

struct EpiPlain {
    bf16_t* O; int ldc;
    __device__ __forceinline__ void operator()(AccRef acc, const Unit& u, int wr, int wc, int fr, int fq) const {
        const int row0 = u.pm * BM + wr * 64 + fr, col0 = u.pn * BM + wc * 32 + 8 * fq;
#pragma unroll
        for (int ai = 0; ai < 2; ++ai)
#pragma unroll
            for (int m = 0; m < 4; ++m) { bf16_t* rowp = O + (size_t)(row0 + ai * HALF + m * 16) * ldc + col0;
#pragma unroll
                for (int bj = 0; bj < 2; ++bj) *(u32x4*)(rowp + bj * HALF) = pack8(acc[ai][bj][m][0], acc[ai][bj][m][1]); }
    }
};
struct EpiStage1 {
    bf16_t *xa, *qm, *qkv, *halo;
    __device__ __forceinline__ void operator()(AccRef acc, const Unit& u, int wr, int wc, int fr, int fq) const {
        const int pn = u.pn; bf16_t* base; int ldc, colt;
        if (pn < 2) { base = xa; ldc = 512; colt = pn * 256; }
        else if (pn < 4) { base = qm; ldc = 512; colt = (pn - 2) * 256; }
        else { const int t = (pn - 4) >> 2; base = qkv + (size_t)t * M * 1024; ldc = 1024; colt = ((pn - 4) & 3) * 256; }
        const int row0 = u.pm * BM + wr * 64 + fr, col0 = colt + wc * 32 + 8 * fq;
#pragma unroll
        for (int ai = 0; ai < 2; ++ai)
#pragma unroll
            for (int m = 0; m < 4; ++m) { const int row = row0 + ai * HALF + m * 16; bf16_t* rowp = base + (size_t)row * ldc + col0;
#pragma unroll
                for (int bj = 0; bj < 2; ++bj) { const u32x4 w = pack8(acc[ai][bj][m][0], acc[ai][bj][m][1]);
                    *(u32x4*)(rowp + bj * HALF) = w;
                    if (m == 3 && pn >= 4 && fr >= 13) *(u32x4*)(halo + ((size_t)(row >> 6) * 3 + (fr - 13)) * 3072 + (pn - 4) * 256 + bj * HALF + wc * 32 + 8 * fq) = w; } }
    }
};
struct EpiZ {
    bf16_t* Y; const float* SUMSQ;
    __device__ __forceinline__ void operator()(AccRef acc, const Unit& u, int wr, int wc, int fr, int fq) const {
        int tid = threadIdx.x; asm volatile("" : "+v"(tid)); fr = tid & 15; fq = (tid >> 4) & 3;
        const int row0 = u.pm * BM + wr * 64 + fr, col0 = u.pn * BM + wc * 32 + 8 * fq;
        const bool isdn = (col0 >= 512) && (col0 < 1536); const int hd = isdn ? ((col0 - 512) >> 7) : 0;
#pragma unroll
        for (int ai = 0; ai < 2; ++ai)
#pragma unroll
            for (int mh = 0; mh < 2; ++mh) {
                u32x4 o[2][2]; float sq[2][2];
#pragma unroll
                for (int mm = 0; mm < 2; ++mm)
#pragma unroll
                    for (int bj = 0; bj < 2; ++bj) { const size_t row = (size_t)(row0 + ai * HALF + (2 * mh + mm) * 16);
                        o[mm][bj] = *(const u32x4*)(Y + row * 2048 + col0 + bj * HALF); sq[mm][bj] = SUMSQ[row * 8 + (isdn ? hd + bj : 0)]; }
#pragma unroll
                for (int mm = 0; mm < 2; ++mm)
#pragma unroll
                    for (int bj = 0; bj < 2; ++bj) { const int m = 2 * mh + mm; const size_t row = (size_t)(row0 + ai * HALF + m * 16);
                        const f32x4 a0 = acc[ai][bj][m][0], a1 = acc[ai][bj][m][1]; const u32x4 ov = o[mm][bj];
                        const float fac = isdn ? (1.0f / sqrtf(sq[mm][bj] * (1.f / 128.f) + EPS)) : 1.f;
                        f32x4 v0, v1;
                        v0[0] = bflo(ov.x) * silu_f(a0[0]); v0[1] = bfhi(ov.x) * silu_f(a0[1]); v0[2] = bflo(ov.y) * silu_f(a0[2]); v0[3] = bfhi(ov.y) * silu_f(a0[3]);
                        v1[0] = bflo(ov.z) * silu_f(a1[0]); v1[1] = bfhi(ov.z) * silu_f(a1[1]); v1[2] = bflo(ov.w) * silu_f(a1[2]); v1[3] = bfhi(ov.w) * silu_f(a1[3]);
                        *(u32x4*)(Y + row * 2048 + col0 + bj * HALF) = pack8(v0 * fac, v1 * fac); }
                asm volatile("" ::: "memory"); __builtin_amdgcn_sched_barrier(0);
            }
    }
};
struct EpiGate {
    bf16_t* GATE;
    __device__ __forceinline__ void operator()(AccRef acc, const Unit& u, int wr, int wc, int fr, int fq) const {
        int tid = threadIdx.x; asm volatile("" : "+v"(tid)); fr = tid & 15; fq = (tid >> 4) & 3;
        const int row0 = u.pm * BM + wr * 64 + fr, col0 = u.pn * BM + wc * 32 + 8 * fq;
#pragma unroll
        for (int ai = 0; ai < 2; ++ai)
#pragma unroll
            for (int m = 0; m < 4; ++m) { bf16_t* rowp = GATE + (size_t)(row0 + ai * HALF + m * 16) * 3072 + col0;
#pragma unroll
                for (int bj = 0; bj < 2; ++bj) { const f32x4 a0 = acc[ai][bj][m][0], a1 = acc[ai][bj][m][1]; f32x4 v0, v1;
#pragma unroll
                    for (int e = 0; e < 4; ++e) { v0[e] = sigm_f(a0[e]); v1[e] = sigm_f(a1[e]); }
                    *(u32x4*)(rowp + bj * HALF) = pack8(v0, v1); } }
    }
};
template <int BR> struct EpiProj {
    const bf16_t* GATE; bf16_t* Y;
    __device__ __forceinline__ void operator()(AccRef acc, const Unit& u, int wr, int wc, int fr, int fq) const {
        int tid = threadIdx.x; asm volatile("" : "+v"(tid)); fr = tid & 15; fq = (tid >> 4) & 3;
        const int row0 = u.pm * BM + wr * 64 + fr, col0 = u.pn * BM + wc * 32 + 8 * fq;
#pragma unroll
        for (int ai = 0; ai < 2; ++ai)
#pragma unroll
            for (int mh = 0; mh < 2; ++mh) {
                u32x4 gq[2][2], yo[2][2];
#pragma unroll
                for (int mm = 0; mm < 2; ++mm)
#pragma unroll
                    for (int bj = 0; bj < 2; ++bj) { const size_t row = (size_t)(row0 + ai * HALF + (2 * mh + mm) * 16);
                        gq[mm][bj] = *(const u32x4*)(GATE + row * 3072 + BR * 1024 + col0 + bj * HALF);
                        if (BR > 0) yo[mm][bj] = *(const u32x4*)(Y + row * 1024 + col0 + bj * HALF); }
#pragma unroll
                for (int mm = 0; mm < 2; ++mm)
#pragma unroll
                    for (int bj = 0; bj < 2; ++bj) { const int m = 2 * mh + mm; const size_t row = (size_t)(row0 + ai * HALF + m * 16);
                        const f32x4 a0 = acc[ai][bj][m][0], a1 = acc[ai][bj][m][1]; const u32x4 g4 = gq[mm][bj];
                        f32x4 v0, v1;
                        v0[0] = bflo(g4.x) * a0[0]; v0[1] = bfhi(g4.x) * a0[1]; v0[2] = bflo(g4.y) * a0[2]; v0[3] = bfhi(g4.y) * a0[3];
                        v1[0] = bflo(g4.z) * a1[0]; v1[1] = bfhi(g4.z) * a1[1]; v1[2] = bflo(g4.w) * a1[2]; v1[3] = bfhi(g4.w) * a1[3];
                        if (BR > 0) { const u32x4 y4 = yo[mm][bj];
                            v0[0] += bflo(y4.x); v0[1] += bfhi(y4.x); v0[2] += bflo(y4.y); v0[3] += bfhi(y4.y); v1[0] += bflo(y4.z); v1[1] += bfhi(y4.z); v1[2] += bflo(y4.w); v1[3] += bfhi(y4.w); }
                        *(u32x4*)(Y + row * 1024 + col0 + bj * HALF) = pack8(v0, v1); }
                asm volatile("" ::: "memory"); __builtin_amdgcn_sched_barrier(0);
            }
    }
};
struct EpiOutNorm {
    float* O; const float* X; const float* PW; float* rowss; unsigned* cnt;
    __device__ __forceinline__ void operator()(AccRef acc, const Unit& u, int wr, int wc, int fr, int fq) const {
        int tid = threadIdx.x; asm volatile("" : "+v"(tid)); fr = tid & 15; fq = (tid >> 4) & 3;
        const int row0 = u.pm * BM + wr * 64 + fr, col0 = u.pn * BM + wc * 32 + 8 * fq;
#pragma unroll
        for (int ai = 0; ai < 2; ++ai)
#pragma unroll
            for (int m = 0; m < 4; ++m) { const int row = row0 + ai * HALF + m * 16; float ss = 0.f;
#pragma unroll
                for (int bj = 0; bj < 2; ++bj) { const f32x4 a0 = acc[ai][bj][m][0], a1 = acc[ai][bj][m][1];
                    ss += (a0[0] * a0[0] + a0[1] * a0[1]) + (a0[2] * a0[2] + a0[3] * a0[3]) + (a1[0] * a1[0] + a1[1] * a1[1]) + (a1[2] * a1[2] + a1[3] * a1[3]); }
                ss += __shfl_xor(ss, 16); ss += __shfl_xor(ss, 32);
                if (fq == 0) atomicAdd(rowss + row, ss); }
        asm volatile("s_waitcnt vmcnt(0)" ::: "memory");
        __syncthreads();
        if (threadIdx.x == 0) {
            __hip_atomic_fetch_add(cnt + u.pm * 16, 1u, __ATOMIC_RELAXED, __HIP_MEMORY_SCOPE_AGENT);
            unsigned sp = 0;
            while (__hip_atomic_load(cnt + u.pm * 16, __ATOMIC_RELAXED, __HIP_MEMORY_SCOPE_AGENT) < 4u) { __builtin_amdgcn_s_sleep(1); if (++sp > (1u << 20)) break; }
        }
        __syncthreads();
#pragma unroll
        for (int ai = 0; ai < 2; ++ai)
#pragma unroll
            for (int m = 0; m < 4; ++m) { const int row = row0 + ai * HALF + m * 16;
                const float rs = 1.0f / sqrtf(__hip_atomic_load(rowss + row, __ATOMIC_RELAXED, __HIP_MEMORY_SCOPE_AGENT) * (1.f / 1024.f) + EPS);
                f32x4 xv[2][2];
#pragma unroll
                for (int bj = 0; bj < 2; ++bj) { const size_t off = (size_t)row * 1024 + col0 + bj * HALF; xv[bj][0] = *(const f32x4*)(X + off); xv[bj][1] = *(const f32x4*)(X + off + 4); }
#pragma unroll
                for (int bj = 0; bj < 2; ++bj) { const size_t off = (size_t)row * 1024 + col0 + bj * HALF;
                    const f32x4 w0 = *(const f32x4*)(PW + col0 + bj * HALF), w1 = *(const f32x4*)(PW + col0 + bj * HALF + 4);
                    *(f32x4*)(O + off) = xv[bj][0] + acc[ai][bj][m][0] * rs * w0; *(f32x4*)(O + off + 4) = xv[bj][1] + acc[ai][bj][m][1] * rs * w1; }
                if (m & 1) { asm volatile("" ::: "memory"); __builtin_amdgcn_sched_barrier(0); } }
    }
};
}

#define XB_TMO      128
#define XB_XCNT(j)  (256  + 64 * (j))
#define XB_XSUB(j)  (1280 + 64 * (j))
#define XB_XGEN(j)  (2304 + 64 * (j))
#define XB_TOP      3328
#define XB_TOPGEN   3392
#define XCD_BAR_WORDS 3456
#define XB_SPIN_CAP (1u << 18)

__device__ __forceinline__ unsigned xb_ld(unsigned* p)              { return __hip_atomic_load(p, __ATOMIC_RELAXED, __HIP_MEMORY_SCOPE_AGENT); }
__device__ __forceinline__ unsigned xb_add(unsigned* p, unsigned v) { return __hip_atomic_fetch_add(p, v, __ATOMIC_RELAXED, __HIP_MEMORY_SCOPE_AGENT); }
__device__ __forceinline__ unsigned xb_xcc_id() { return (unsigned)__builtin_amdgcn_s_getreg((3 << 11) | 20) & 0xFu; }
#define XB_SPIN(cond, bar) do { unsigned _sp = 0; while (cond) { __builtin_amdgcn_s_sleep(1); \
    if ((++_sp & 255u) == 0u) { if (xb_ld(&(bar)[XB_TMO])) break; if (_sp > XB_SPIN_CAP) { atomicAdd(&(bar)[XB_TMO], 1u); break; } } } } while (0)

struct XcdBarrier {
    unsigned* bar; unsigned x;
    volatile LAS unsigned* st;
};

__device__ __forceinline__ XcdBarrier xcd_barrier_post(unsigned* bar, volatile LAS unsigned* st) {
    XcdBarrier b; b.bar = bar; b.x = xb_xcc_id(); b.st = st;
    if (threadIdx.x == 0) (void)xb_add(&bar[XB_XCNT(b.x)], 1u);
    return b;
}
__device__ __forceinline__ void xcd_barrier_complete(unsigned* bar, unsigned x, unsigned& nloc, unsigned& nx) {
    const unsigned G = gridDim.x * gridDim.y * gridDim.z;
    unsigned sum, cnt, mine, sp = 0u;
    for (;;) {
        sum = 0u; cnt = 0u; mine = 0u;
#pragma unroll
        for (unsigned j = 0; j < 16; ++j) { const unsigned c = xb_ld(&bar[XB_XCNT(j)]); sum += c; cnt += (c > 0u) ? 1u : 0u; mine = (j == x) ? c : mine; }
        if (sum == G) break;
        __builtin_amdgcn_s_sleep(1);
        if ((++sp & 255u) == 0u) { if (xb_ld(&bar[XB_TMO])) break; if (sp > XB_SPIN_CAP) { atomicAdd(&bar[XB_TMO], 1u); break; } }
    }
    nloc = mine > 0u ? mine : 1u; nx = cnt > 0u ? cnt : 1u;
}

__device__ __forceinline__ void xcd_barrier(const XcdBarrier& b) {
    asm volatile("s_waitcnt vmcnt(0)" ::: "memory");
    __syncthreads();
    if (threadIdx.x == 0) {
        unsigned* bar = b.bar;
        __builtin_amdgcn_s_waitcnt(0);
        unsigned nloc = b.st[0], nx = b.st[1];
        if (nloc == 0u) { xcd_barrier_complete(bar, b.x, nloc, nx); b.st[0] = nloc; b.st[1] = nx; }
        const unsigned old = xb_add(&bar[XB_XSUB(b.x)], 1u);
        const unsigned gen = old / nloc;
        if (old + 1u == (gen + 1u) * nloc) {
            __builtin_amdgcn_fence(__ATOMIC_RELEASE, "agent");
            asm volatile("s_waitcnt vmcnt(0)" ::: "memory");
            const unsigned og = xb_add(&bar[XB_TOP], 1u);
            const unsigned tg = og / nx;
            if (og + 1u == (tg + 1u) * nx) xb_add(&bar[XB_TOPGEN], 1u);
            else XB_SPIN(xb_ld(&bar[XB_TOPGEN]) == tg, bar);
            __builtin_amdgcn_fence(__ATOMIC_ACQUIRE, "agent");
            xb_add(&bar[XB_XGEN(b.x)], 1u);
            asm volatile("s_waitcnt vmcnt(0)" ::: "memory");
        } else {
            XB_SPIN(xb_ld(&bar[XB_XGEN(b.x)]) == gen, bar);
            __builtin_amdgcn_fence(__ATOMIC_ACQUIRE, "agent");
            asm volatile("s_waitcnt vmcnt(0)" ::: "memory");
        }
    }
    __syncthreads();
}


struct Args {
    const float *x, *mem, *pre_w, *mem_w, *w_in, *conv_w, *a_log, *dt_bias, *dn_w, *mix_w, *pool_scale, *w_kv, *w_pp, *w_pd, *w_pm, *w_out, *post_w;
    float* out; unsigned char* ws; int ph_lo, ph_hi;
};

__device__ __forceinline__ float wave_sum(float v) {
    v += __builtin_bit_cast(float, __builtin_amdgcn_update_dpp(0, __builtin_bit_cast(int, v), 0xB1, 0xF, 0xF, false));
    v += __builtin_bit_cast(float, __builtin_amdgcn_update_dpp(0, __builtin_bit_cast(int, v), 0x4E, 0xF, 0xF, false));
    v += __builtin_bit_cast(float, __builtin_amdgcn_update_dpp(0, __builtin_bit_cast(int, v), 0x124, 0xF, 0xF, false));
    v += __builtin_bit_cast(float, __builtin_amdgcn_update_dpp(0, __builtin_bit_cast(int, v), 0x128, 0xF, 0xF, false));
    const int vi = __builtin_bit_cast(int, v);
    const float s0 = __builtin_bit_cast(float, __builtin_amdgcn_readlane(vi, 0)), s1 = __builtin_bit_cast(float, __builtin_amdgcn_readlane(vi, 16));
    const float s2 = __builtin_bit_cast(float, __builtin_amdgcn_readlane(vi, 32)), s3 = __builtin_bit_cast(float, __builtin_amdgcn_readlane(vi, 48));
    return (s0 + s1) + (s2 + s3);
}

__device__ __forceinline__ void p0_transpose_item(const float* W, int ldw, int K, bf16_t* WT, LAS float* scr, int kb, int nb, int lane) {
    const int k0 = 64 * kb, n0 = 32 * nb;
    float tv[32];
#pragma unroll
    for (int i = 0; i < 32; ++i) tv[i] = W[(size_t)(k0 + 2 * i + (lane >> 5)) * ldw + n0 + (lane & 31)];
#pragma unroll
    for (int i = 0; i < 32; ++i) scr[(2 * i + (lane >> 5)) * 33 + (lane & 31)] = tv[i];
    LDS_WAIT();
    const int c = lane & 7;
#pragma unroll
    for (int j = 0; j < 4; ++j) { const int n = (lane >> 3) + 8 * j; const LAS float* s = scr + (8 * c) * 33 + n;
        u32x4 o; o.x = pk2(s[0 * 33], s[1 * 33]); o.y = pk2(s[2 * 33], s[3 * 33]); o.z = pk2(s[4 * 33], s[5 * 33]); o.w = pk2(s[6 * 33], s[7 * 33]);
        *(u32x4*)(WT + (size_t)(n0 + n) * K + k0 + 8 * c) = o; }
    LDS_WAIT();
}

__device__ __forceinline__ void p0_prologue(const Args& a, LAS unsigned char* lds) {
    int tid_ = threadIdx.x; asm volatile("" : "+v"(tid_));
    const int tid = tid_, lane = tid & 63, wave = tid >> 6, G = gridDim.x;
    unsigned char* ws = a.ws;
    LAS float* W16 = (LAS float*)lds;
    LAS float* scr = (LAS float*)(lds + 65536 + wave * 8448);
    for (int idx = tid; idx < 4096; idx += 512) { const int i = idx >> 2, q = idx & 3; const int p = ((i >> 8) * 4 + (i & 3)) * 64 + ((i >> 2) & 63);
        *(LAS f32x4*)(W16 + (q * 1024 + p) * 4) = *(const f32x4*)(a.w_in + (size_t)i * INW + 4096 + 4 * q); }
    for (int i = blockIdx.x * 512 + tid; i < M; i += G * 512) ((float*)(ws + WS_ROWSS))[i] = 0.f;
    for (int i = blockIdx.x * 512 + tid; i < M * 8; i += G * 512) ((float*)(ws + WS_SUMSQ))[i] = 0.f;
    __syncthreads();
    const int gw = blockIdx.x * 8 + wave, NGW = G * 8;
    bf16_t* WT = (bf16_t*)(ws + WS_WT);
#define SEG(src, ldw, Kk, Nseg, dst) { const int ni = ((Kk) / 64) * ((Nseg) / 32); if (r < ni) { const int nblk = (Nseg) / 32; p0_transpose_item((src), (ldw), (Kk), (dst), scr, r / nblk, r % nblk, lane); continue; } r -= ni; }
    constexpr int NITEMS = 16 * 128 + 512 + 32;
    for (int it = gw; it < NITEMS; it += NGW) {
        int r = it;
        SEG(a.w_in + 0, INW, 1024, 512, WT)
        SEG(a.w_in + 5136, INW, 1024, 512, WT + (size_t)512 * 1024)
        SEG(a.w_in + 1024, INW, 1024, 3072, WT + (size_t)1024 * 1024)
        SEG(a.w_kv, 1024, 1024, 1024, (bf16_t*)(ws + WS_WKV))
        SEG(a.mix_w + 0 * 16384, 128, 128, 128, (bf16_t*)(ws + WS_WMIX) + 0 * 16384)
        SEG(a.mix_w + 1 * 16384, 128, 128, 128, (bf16_t*)(ws + WS_WMIX) + 1 * 16384)
        SEG(a.mix_w + 2 * 16384, 128, 128, 128, (bf16_t*)(ws + WS_WMIX) + 2 * 16384)
        SEG(a.mix_w + 3 * 16384, 128, 128, 128, (bf16_t*)(ws + WS_WMIX) + 3 * 16384)
    }
    f32x4 nwx[4], nwm[4];
#pragma unroll
    for (int j = 0; j < 4; ++j) { nwx[j] = ((const f32x4*)a.pre_w)[lane + 64 * j]; nwm[j] = ((const f32x4*)a.mem_w)[lane + 64 * j]; }
    f32x4 vnx[4];
    {   const int m = gw; const float* src = (m >= M) ? a.mem + (size_t)(m - M) * 1024 : a.x + (size_t)m * 1024;
#pragma unroll
        for (int j = 0; j < 4; ++j) vnx[j] = ((const f32x4*)src)[lane + 64 * j]; }
    for (int m = gw; m < M + NB * MEML; m += NGW) {
        const bool is_mem = m >= M;
        bf16_t* dst = is_mem ? (bf16_t*)(ws + WS_MEMN) + (size_t)(m - M) * 1024 : (bf16_t*)(ws + WS_H) + (size_t)m * 1024;
        f32x4 v[4]; float s = 0.f;
#pragma unroll
        for (int j = 0; j < 4; ++j) { v[j] = vnx[j]; s += (v[j].x * v[j].x + v[j].y * v[j].y) + (v[j].z * v[j].z + v[j].w * v[j].w); }
        {   const int m2 = (m + NGW < M + NB * MEML) ? m + NGW : m; const float* src = (m2 >= M) ? a.mem + (size_t)(m2 - M) * 1024 : a.x + (size_t)m2 * 1024;
#pragma unroll
            for (int j = 0; j < 4; ++j) vnx[j] = ((const f32x4*)src)[lane + 64 * j]; }
        const float rstd = 1.0f / sqrtf(wave_sum(s) * (1.f / 1024.f) + EPS);
#pragma unroll
        for (int j = 0; j < 4; ++j) { const f32x4 wv = is_mem ? nwm[j] : nwx[j]; v[j] = v[j] * rstd * wv;
            u32x2 o; o.x = pk2(v[j].x, v[j].y); o.y = pk2(v[j].z, v[j].w); ((u32x2*)dst)[lane + 64 * j] = o; }
        if (!is_mem) {
            f32x4 acc[4];
#pragma unroll
            for (int q = 0; q < 4; ++q) acc[q] = (f32x4){0.f, 0.f, 0.f, 0.f};
#pragma unroll
            for (int j = 0; j < 4; ++j)
#pragma unroll
                for (int e = 0; e < 4; ++e) { const float xv = v[j][e];
#pragma unroll
                    for (int q = 0; q < 4; ++q) { const f32x4 wv = *(const LAS f32x4*)(W16 + (q * 1024 + (j * 4 + e) * 64 + lane) * 4); acc[q] += xv * wv; } }
            float val = 0.f;
#pragma unroll
            for (int q = 0; q < 4; ++q)
#pragma unroll
                for (int e = 0; e < 4; ++e) { const float t = wave_sum(acc[q][e]); if (lane == q * 4 + e) val = t; }
            if (lane < 8) { const float z = val + a.dt_bias[lane]; const float sp = z > 20.f ? z : log1pf(expf(z));
                ((float*)(ws + WS_G))[(size_t)m * 8 + lane] = -expf(a.a_log[lane]) * sp; }
            else if (lane < 16) ((float*)(ws + WS_BETA))[(size_t)m * 8 + lane - 8] = 1.f / (1.f + expf(-val));
        }
    }
}

__device__ __forceinline__ void late_transposes(const Args& a, LAS unsigned char* lds, int c, int GG) {
    int tid_ = threadIdx.x; asm volatile("" : "+v"(tid_));
    const int tid = tid_, lane = tid & 63, wave = tid >> 6;
    unsigned char* ws = a.ws; bf16_t* WT = (bf16_t*)(ws + WS_WT);
    LAS float* scr = (LAS float*)(lds + wave * 8448);
    __syncthreads();
    const int gw = c * 8 + wave, NGW = GG * 8;
    constexpr int NITEMS = 16 * 160 + 256 + 512 + 256 + 512;
    for (int it = gw; it < NITEMS; it += NGW) {
        int r = it;
        SEG(a.w_in + 512, INW, 1024, 512, WT + (size_t)4096 * 1024)
        SEG(a.w_in + 4112, INW, 1024, 1024, WT + (size_t)4608 * 1024)
        SEG(a.w_in + 5648, INW, 1024, 512, WT + (size_t)5632 * 1024)
        SEG(a.w_in + 6160, INW, 1024, 3072, WT + (size_t)6144 * 1024)
        SEG(a.w_pp, 1024, 512, 1024, (bf16_t*)(ws + WS_WP))
        SEG(a.w_pd, 1024, 1024, 1024, (bf16_t*)(ws + WS_WD))
        SEG(a.w_pm, 1024, 512, 1024, (bf16_t*)(ws + WS_WM))
        SEG(a.w_out, 1024, 1024, 1024, (bf16_t*)(ws + WS_WOUT))
    }
    __syncthreads();
}
#undef SEG

__device__ __forceinline__ void chunk_load_raw(const Args& a, int item, u32x4 (&raw)[11], int tid) {
    const int n = item & 31, h = (item >> 5) & 7, b = item >> 8; const int r0 = b * SEQ + 64 * n, gci = b * 32 + n;
    const int ten = tid >> 7, cgp = tid & 15, rg = (tid >> 4) & 7;
    if (tid < 384) {
        const bf16_t* src = (const bf16_t*)(a.ws + WS_QKV) + (size_t)ten * M * 1024 + h * 128 + cgp * 8;
#pragma unroll
        for (int i = 0; i < 11; ++i) { const int rr = 8 * rg - 3 + i;
            if (rr >= 0) raw[i] = *(const u32x4*)(src + (size_t)(r0 + rr) * 1024);
            else if (n > 0) raw[i] = *(const u32x4*)((const bf16_t*)(a.ws + WS_HALO) + ((size_t)(gci - 1) * 3 + (rr + 3)) * 3072 + ten * 1024 + h * 128 + cgp * 8);
            else raw[i] = (u32x4){0u, 0u, 0u, 0u}; }
    }
}
__device__ __forceinline__ void chunk_prep_item(const Args& a, LAS unsigned char* lds, int item, u32x4 (&raw)[11], int item_next, float& gpre, float& bpre, int set, int stage, int nvalid) {
    int tid_ = threadIdx.x; asm volatile("" : "+v"(tid_));
    const int tid = tid_, lane = tid & 63, wid = tid >> 6, r16 = lane & 15, qp = lane >> 4;
    const int n = item & 31, h = (item >> 5) & 7, b = item >> 8;
    const int r0 = b * SEQ + 64 * n, gci = b * 32 + n;
    unsigned char* ws = a.ws;
    bf16_t* QKV = (bf16_t*)(ws + WS_QKV);
    LAS bf16_t* Kn = (LAS bf16_t*)(lds);
    LAS bf16_t* Qn = (LAS bf16_t*)(lds + 17408);
    const int sset = (stage == 1) ? (wid >> 2) : set;
    LAS bf16_t* Tb = (LAS bf16_t*)(lds + sset * 9216);
    LAS bf16_t* VbT = (LAS bf16_t*)(lds + 34816 + sset * 36864);
    LAS bf16_t* KbgT = (LAS bf16_t*)(lds + 53248 + sset * 36864);
    LAS float* Ap = (LAS float*)(lds + 108544 + sset * 17408);
    LAS float* gcs = (LAS float*)(lds + 143360 + sset * 512);
    LAS float* bts = gcs + 64;
    __syncthreads();
    if (stage == 0) {
    if (wid == 0) {
        float g = gpre;
        const float bt = bpre;
        if (item_next >= 0) { const int n2 = item_next & 31, h2 = (item_next >> 5) & 7, b2 = item_next >> 8; const int r2 = b2 * SEQ + 64 * n2;
            gpre = ((const float*)(ws + WS_G))[(size_t)(r2 + lane) * 8 + h2]; bpre = ((const float*)(ws + WS_BETA))[(size_t)(r2 + lane) * 8 + h2]; }
#pragma unroll
        for (int o = 1; o < 64; o <<= 1) { const float t = __shfl_up(g, o); if (lane >= o) g += t; }
        gcs[lane] = g; bts[lane] = bt;
        if (lane == 63) ((float*)(ws + WS_GL))[item] = __expf(g);
    }
    __syncthreads();
    u32x4 outA[8];
    const int ten = tid >> 7, cgp = tid & 15, rg = (tid >> 4) & 7;
    if (tid < 384) {
        f32x4 cw[4][2];
#pragma unroll
        for (int j = 0; j < 4; ++j) { const float* cp = a.conv_w + (size_t)j * 3072 + ten * 1024 + h * 128 + cgp * 8; cw[j][0] = *(const f32x4*)cp; cw[j][1] = *(const f32x4*)(cp + 4); }
        float y[8][8];
#pragma unroll
        for (int i = 0; i < 8; ++i) {
#pragma unroll
            for (int e = 0; e < 8; ++e) y[i][e] = 0.f;
#pragma unroll
            for (int j = 0; j < 4; ++j) { const u32x4 rv = raw[i + j];
                y[i][0] += cw[j][0][0] * bflo(rv.x); y[i][1] += cw[j][0][1] * bfhi(rv.x); y[i][2] += cw[j][0][2] * bflo(rv.y); y[i][3] += cw[j][0][3] * bfhi(rv.y);
                y[i][4] += cw[j][1][0] * bflo(rv.z); y[i][5] += cw[j][1][1] * bfhi(rv.z); y[i][6] += cw[j][1][2] * bflo(rv.w); y[i][7] += cw[j][1][3] * bfhi(rv.w); }
#pragma unroll
            for (int e = 0; e < 8; ++e) y[i][e] = silu_f(y[i][e]);
        }
        if (item_next >= 0) chunk_load_raw(a, item_next, raw, tid);
        const float gl = gcs[63];
        if (ten < 2) {
#pragma unroll
            for (int i = 0; i < 8; ++i) { float ss = 0.f;
#pragma unroll
                for (int e = 0; e < 8; ++e) ss += y[i][e] * y[i][e];
                ss += __shfl_xor(ss, 1); ss += __shfl_xor(ss, 2); ss += __shfl_xor(ss, 4); ss += __shfl_xor(ss, 8);
                const float sc = (1.0f / sqrtf(ss + EPS)) * (ten == 0 ? 0.08838834764831845f : 1.f);
#pragma unroll
                for (int e = 0; e < 8; ++e) y[i][e] *= sc; }
        }
        if (ten == 0) {
#pragma unroll
            for (int i = 0; i < 8; ++i) { const int row = 8 * rg + i; const float eg = __expf(gcs[row]);
                u32x4 w; w.x = pk2(y[i][0], y[i][1]); w.y = pk2(y[i][2], y[i][3]); w.z = pk2(y[i][4], y[i][5]); w.w = pk2(y[i][6], y[i][7]);
                *(LAS u32x4*)(Qn + row * 136 + cgp * 8) = w;
                outA[i].x = pk2(y[i][0] * eg, y[i][1] * eg); outA[i].y = pk2(y[i][2] * eg, y[i][3] * eg); outA[i].z = pk2(y[i][4] * eg, y[i][5] * eg); outA[i].w = pk2(y[i][6] * eg, y[i][7] * eg); }
        } else if (ten == 1) {
            float f1[8], f2[8];
#pragma unroll
            for (int i = 0; i < 8; ++i) { const int row = 8 * rg + i; const float gc = gcs[row]; f1[i] = bts[row] * __expf(gc); f2[i] = __expf(gl - gc);
                u32x4 w; w.x = pk2(y[i][0], y[i][1]); w.y = pk2(y[i][2], y[i][3]); w.z = pk2(y[i][4], y[i][5]); w.w = pk2(y[i][6], y[i][7]);
                *(LAS u32x4*)(Kn + row * 136 + cgp * 8) = w; }
#pragma unroll
            for (int e = 0; e < 8; ++e) { u32x4 w;
                w.x = pk2(y[0][e] * f1[0], y[1][e] * f1[1]); w.y = pk2(y[2][e] * f1[2], y[3][e] * f1[3]); w.z = pk2(y[4][e] * f1[4], y[5][e] * f1[5]); w.w = pk2(y[6][e] * f1[6], y[7][e] * f1[7]);
                *(LAS u32x4*)(KbgT + (cgp * 8 + e) * 72 + 8 * rg) = w;
                outA[e].x = pk2(y[0][e] * f2[0], y[1][e] * f2[1]); outA[e].y = pk2(y[2][e] * f2[2], y[3][e] * f2[3]); outA[e].z = pk2(y[4][e] * f2[4], y[5][e] * f2[5]); outA[e].w = pk2(y[6][e] * f2[6], y[7][e] * f2[7]); }
        } else {
            float f1[8];
#pragma unroll
            for (int i = 0; i < 8; ++i) f1[i] = bts[8 * rg + i];
#pragma unroll
            for (int e = 0; e < 8; ++e) { u32x4 w;
                w.x = pk2(y[0][e] * f1[0], y[1][e] * f1[1]); w.y = pk2(y[2][e] * f1[2], y[3][e] * f1[3]); w.z = pk2(y[4][e] * f1[4], y[5][e] * f1[5]); w.w = pk2(y[6][e] * f1[6], y[7][e] * f1[7]);
                *(LAS u32x4*)(VbT + (cgp * 8 + e) * 72 + 8 * rg) = w; }
        }
    }
    __syncthreads();
    if (tid < 128) {
#pragma unroll
        for (int i = 0; i < 8; ++i) *(u32x4*)(QKV + (size_t)(r0 + 8 * rg + i) * 1024 + h * 128 + cgp * 8) = outA[i];
    } else if (tid < 256) {
#pragma unroll
        for (int e = 0; e < 8; ++e) { const int k = cgp * 8 + e;
            *(u32x4*)((unsigned char*)(QKV + (size_t)2 * M * 1024 + (size_t)(r0 + (k >> 1)) * 1024 + h * 128) + (k & 1) * 128 + 16 * rg) = outA[e]; }
    }
    {
        const int mat = wid >> 2, ti = wid & 3;
        const LAS bf16_t* Bm = mat ? Qn : Kn;
        f32x4 c4[4];
#pragma unroll
        for (int tj = 0; tj < 4; ++tj) c4[tj] = (f32x4){0.f, 0.f, 0.f, 0.f};
#pragma unroll
        for (int ks = 0; ks < 4; ++ks) { const bf16x8 af = *(const LAS bf16x8*)(Kn + (ti * 16 + r16) * 136 + ks * 32 + 8 * qp);
#pragma unroll
            for (int tj = 0; tj < 4; ++tj) { const bf16x8 bf = *(const LAS bf16x8*)(Bm + (tj * 16 + r16) * 136 + ks * 32 + 8 * qp); c4[tj] = MFMA16(af, bf, c4[tj]); } }
        const int j0 = ti * 16 + 4 * qp;
        const f32x4 gj = *(const LAS f32x4*)(gcs + j0);
#pragma unroll
        for (int tj = 0; tj < 4; ++tj) { const int i = tj * 16 + r16; const float gi = gcs[i]; f32x4 v;
#pragma unroll
            for (int e = 0; e < 4; ++e) { const int j = j0 + e; const float d = __expf(fminf(gi - gj[e], 0.f)); const bool keep = mat ? (j <= i) : (j < i); v[e] = keep ? c4[tj][e] * d : 0.f; }
            if (mat == 0) { v = v * bts[i];
#pragma unroll
                for (int e = 0; e < 4; ++e) Ap[i * 68 + e * 16 + ti * 4 + qp] = v[e]; }
            else { u32x2 o; o.x = pk2(v[0], v[1]); o.y = pk2(v[2], v[3]); *(u32x2*)((bf16_t*)(ws + WS_AQK) + (size_t)item * 4096 + i * 64 + j0) = o; } }
    }
    }
    if (stage == 1 && (wid >> 2) < nvalid) {
        const int ph = lane & 3, c = 16 * (wid & 3) + (lane >> 2);
        float t[16];
#pragma unroll
        for (int m = 0; m < 16; ++m) t[m] = 0.f;
        f32x4 cf[3][4];
#define LOADROW(ii, slot) do { _Pragma("unroll") for (int m4 = 0; m4 < 4; ++m4) if (m4 * 16 < (ii) && (ii) < 64) cf[slot][m4] = *(const LAS f32x4*)(Ap + (ii) * 68 + ph * 16 + 4 * m4); } while (0)
        LOADROW(0, 0); LOADROW(1, 1); LOADROW(2, 2);
#pragma unroll
        for (int i = 0; i < 64; ++i) {
            float acc0 = 0.f, acc1 = 0.f;
#pragma unroll
            for (int m4 = 0; m4 * 16 < i; ++m4) { const f32x4 av = cf[i % 3][m4];
                acc0 += av[0] * t[4 * m4];
                if ((4 * m4 + 1) * 4 < i) acc1 += av[1] * t[4 * m4 + 1];
                if ((4 * m4 + 2) * 4 < i) acc0 += av[2] * t[4 * m4 + 2];
                if ((4 * m4 + 3) * 4 < i) acc1 += av[3] * t[4 * m4 + 3]; }
            __builtin_amdgcn_sched_barrier(0);
            LOADROW(i + 3, i % 3);
            __builtin_amdgcn_sched_barrier(0);
            float acc = acc0 + acc1;
            acc += __builtin_bit_cast(float, __builtin_amdgcn_update_dpp(0, __builtin_bit_cast(int, acc), 0xB1, 0xF, 0xF, false));
            acc += __builtin_bit_cast(float, __builtin_amdgcn_update_dpp(0, __builtin_bit_cast(int, acc), 0x4E, 0xF, 0xF, false));
            const float val = ((c == i) ? 1.f : 0.f) - acc;
            t[i >> 2] = (ph == (i & 3)) ? val : t[i >> 2];
        }
#undef LOADROW
#pragma unroll
        for (int m = 0; m < 16; ++m) Tb[(4 * m + ph) * 72 + c] = (bf16_t)f2bf(t[m]);
    }
    if (stage == 2) {
        f32x4 cu[4], cwv[4];
#pragma unroll
        for (int ct = 0; ct < 4; ++ct) { cu[ct] = (f32x4){0.f, 0.f, 0.f, 0.f}; cwv[ct] = (f32x4){0.f, 0.f, 0.f, 0.f}; }
#pragma unroll
        for (int ks = 0; ks < 2; ++ks) {
            const bf16x8 vb = *(const LAS bf16x8*)(VbT + (16 * wid + r16) * 72 + ks * 32 + 8 * qp);
            const bf16x8 kb = *(const LAS bf16x8*)(KbgT + (16 * wid + r16) * 72 + ks * 32 + 8 * qp);
#pragma unroll
            for (int ct = 0; ct < 4; ++ct) { const bf16x8 tf = *(const LAS bf16x8*)(Tb + (16 * ct + r16) * 72 + ks * 32 + 8 * qp);
                cu[ct] = MFMA16(tf, vb, cu[ct]); cwv[ct] = MFMA16(kb, tf, cwv[ct]); }
        }
#pragma unroll
        for (int ct = 0; ct < 4; ++ct) {
            u32x2 o; o.x = pk2(cu[ct][0], cu[ct][1]); o.y = pk2(cu[ct][2], cu[ct][3]);
            ((u32x2*)(ws + WS_U))[(((size_t)item * 8 + wid) * 4 + ct) * 64 + lane] = o;
            u32x2 w2; w2.x = pk2(-cwv[ct][0], -cwv[ct][1]); w2.y = pk2(-cwv[ct][2], -cwv[ct][3]);
            *(u32x2*)(QKV + (size_t)M * 1024 + (size_t)(r0 + 16 * ct + r16) * 1024 + h * 128 + 16 * wid + 4 * qp) = w2;
        }
    }
}

__device__ __forceinline__ bf16x8 ldA_perm(const LAS bf16_t* p) {
    const u32x2 lo = *(const LAS u32x2*)p, hi = *(const LAS u32x2*)(p + 16);
    u32x4 v; v.x = lo.x; v.y = lo.y; v.z = hi.x; v.w = hi.y; return __builtin_bit_cast(bf16x8, v);
}
__device__ __forceinline__ bf16x8 packB(f32x4 t0, f32x4 t1) {
    u32x4 v; v.x = pk2(t0[0], t0[1]); v.y = pk2(t0[2], t0[3]); v.z = pk2(t1[0], t1[1]); v.w = pk2(t1[2], t1[3]); return __builtin_bit_cast(bf16x8, v);
}
constexpr int SC_W = 0, SC_QG = 18432, SC_AQK = 36864, SC_KDT = 47104, SC_BUF = 67584, SC_RED = 2 * SC_BUF, SC_RSTD = SC_RED + 2048;

__device__ __forceinline__ void scan_load(const Args& a, int bh, int n, u32x4 (&stg)[7]) {
    const int tid = threadIdx.x, b = bh >> 3, h = bh & 7; const int r0 = b * SEQ + 64 * n; const int item = bh * 32 + n;
    const bf16_t* QKV = (const bf16_t*)(a.ws + WS_QKV);
    const int c = tid >> 4, k8 = tid & 15;
#pragma unroll
    for (int i = 0; i < 2; ++i) {
        stg[i] = *(const u32x4*)(QKV + (size_t)M * 1024 + (size_t)(r0 + c + 32 * i) * 1024 + h * 128 + k8 * 8);
        stg[2 + i] = *(const u32x4*)(QKV + (size_t)(r0 + c + 32 * i) * 1024 + h * 128 + k8 * 8);
        stg[4 + i] = *(const u32x4*)(QKV + (size_t)2 * M * 1024 + (size_t)(r0 + c + 32 * i) * 1024 + h * 128 + k8 * 8);
    }
    stg[6] = *(const u32x4*)((const bf16_t*)(a.ws + WS_AQK) + (size_t)item * 4096 + tid * 8);
}
__device__ __forceinline__ void st_perm(LAS unsigned char* rowp  , int a4  , u32x4 v) {
    const int p0 = (a4 & 1) * 16 + (a4 >> 1) * 4;
    u32x2 lo; lo.x = v.x; lo.y = v.y; u32x2 hi; hi.x = v.z; hi.y = v.w;
    *(LAS u32x2*)(rowp + p0 * 2) = lo; *(LAS u32x2*)(rowp + (p0 + 8) * 2) = hi;
}
__device__ __forceinline__ void scan_store(LAS unsigned char* buf, const u32x4 (&stg)[7]) {
    const int tid = threadIdx.x; const int c = tid >> 4, k8 = tid & 15;
#pragma unroll
    for (int i = 0; i < 2; ++i) {
        st_perm(buf + SC_W + ((c + 32 * i) * 144 + (k8 >> 2) * 32) * 2, k8 & 3, stg[i]);
        st_perm(buf + SC_QG + ((c + 32 * i) * 144 + (k8 >> 2) * 32) * 2, k8 & 3, stg[2 + i]);
        const int line = c + 32 * i, k = line * 2 + (k8 >> 3), c8 = k8 & 7;
        st_perm(buf + SC_KDT + (k * 80 + (c8 >> 2) * 32) * 2, c8 & 3, stg[4 + i]);
    }
    { const int cc = tid >> 3, j8 = tid & 7; st_perm(buf + SC_AQK + (cc * 80 + (j8 >> 2) * 32) * 2, j8 & 3, stg[6]); }
}
__device__ __forceinline__ float dpp_add16(float v) {
    v += __builtin_bit_cast(float, __builtin_amdgcn_update_dpp(0, __builtin_bit_cast(int, v), 0xB1, 0xF, 0xF, false));
    v += __builtin_bit_cast(float, __builtin_amdgcn_update_dpp(0, __builtin_bit_cast(int, v), 0x4E, 0xF, 0xF, false));
    v += __builtin_bit_cast(float, __builtin_amdgcn_update_dpp(0, __builtin_bit_cast(int, v), 0x124, 0xF, 0xF, false));
    v += __builtin_bit_cast(float, __builtin_amdgcn_update_dpp(0, __builtin_bit_cast(int, v), 0x128, 0xF, 0xF, false));
    return v;
}
#define LDA128(p) (*(const LAS bf16x8*)(p))

struct ScanSet { u32x4 stg[7]; u32x2 u[4]; float gl; };
__device__ __forceinline__ void scan_load_set(const Args& a, int bh, int n, ScanSet& t, int lane, int wid) {
    scan_load(a, bh, n, t.stg);
#pragma unroll
    for (int ct = 0; ct < 4; ++ct) t.u[ct] = ((const u32x2*)(a.ws + WS_U))[(((size_t)(bh * 32 + n) * 8 + wid) * 4 + ct) * 64 + lane];
    t.gl = ((const float*)(a.ws + WS_GL))[bh * 32 + n];
}
__device__ __forceinline__ void scan_step(const Args& a, LAS unsigned char* lds, int bh, int n, f32x4 (&S)[8], ScanSet& T, float dnw, int lane, int wid, int r16, int qp, bool accum) {
    const int tid = threadIdx.x, b = bh >> 3, h = bh & 7;
    bf16_t* Y = (bf16_t*)a.out;
    LAS unsigned char* buf = lds + (n & 1) * SC_BUF;
    const float gl = T.gl;
    f32x4 vn[4], o[4];
#pragma unroll
    for (int ct = 0; ct < 4; ++ct) { const u32x2 uu = T.u[ct];
        vn[ct] = (f32x4){bflo(uu.x), bfhi(uu.x), bflo(uu.y), bfhi(uu.y)}; o[ct] = (f32x4){0.f, 0.f, 0.f, 0.f}; }
    __builtin_amdgcn_sched_barrier(0);
    if (n + 1 < 32) scan_load_set(a, bh, n + 1, T, lane, wid);
    __builtin_amdgcn_sched_barrier(0);
    bf16x8 sb[4];
#pragma unroll
    for (int s = 0; s < 4; ++s) sb[s] = packB(S[2 * s], S[2 * s + 1]);
    const LAS bf16_t* Wb = (const LAS bf16_t*)(buf + SC_W); const LAS bf16_t* QGb = (const LAS bf16_t*)(buf + SC_QG);
    const LAS bf16_t* AQb = (const LAS bf16_t*)(buf + SC_AQK); const LAS bf16_t* KDb = (const LAS bf16_t*)(buf + SC_KDT);
    bf16x8 fa[8], fb[8];
#define SB() __builtin_amdgcn_sched_barrier(0)
#define LD_VO2(f, ca, cb, sh) do { _Pragma("unroll") for (int s_ = 0; s_ < 2; ++s_) { \
        f[4 * s_ + 0] = LDA128(Wb + (16 * (ca) + r16) * 144 + 32 * ((sh) + s_) + 8 * qp); f[4 * s_ + 1] = LDA128(Wb + (16 * (cb) + r16) * 144 + 32 * ((sh) + s_) + 8 * qp); \
        f[4 * s_ + 2] = LDA128(QGb + (16 * (ca) + r16) * 144 + 32 * ((sh) + s_) + 8 * qp); f[4 * s_ + 3] = LDA128(QGb + (16 * (cb) + r16) * 144 + 32 * ((sh) + s_) + 8 * qp); } } while (0)
#define MM_VO2(f, ca, cb, sh) do { _Pragma("unroll") for (int s_ = 0; s_ < 2; ++s_) { \
        vn[ca] = MFMA16(f[4 * s_ + 0], sb[(sh) + s_], vn[ca]); vn[cb] = MFMA16(f[4 * s_ + 1], sb[(sh) + s_], vn[cb]); \
        o[ca] = MFMA16(f[4 * s_ + 2], sb[(sh) + s_], o[ca]); o[cb] = MFMA16(f[4 * s_ + 3], sb[(sh) + s_], o[cb]); } } while (0)
#define LD_AQ(f) do { _Pragma("unroll") for (int c_ = 0; c_ < 4; ++c_) { f[c_] = LDA128(AQb + (16 * c_ + r16) * 80 + 8 * qp); f[4 + c_] = LDA128(AQb + (16 * c_ + r16) * 80 + 32 + 8 * qp); } } while (0)
#define MM_AQ(f) do { _Pragma("unroll") for (int c_ = 0; c_ < 4; ++c_) o[c_] = MFMA16(f[c_], vb[0], o[c_]); _Pragma("unroll") for (int c_ = 0; c_ < 4; ++c_) o[c_] = MFMA16(f[4 + c_], vb[1], o[c_]); } while (0)
#define LD_KD(f, k0) do { _Pragma("unroll") for (int c_ = 0; c_ < 4; ++c_) { f[c_] = LDA128(KDb + (16 * ((k0) + c_) + r16) * 80 + 8 * qp); f[4 + c_] = LDA128(KDb + (16 * ((k0) + c_) + r16) * 80 + 32 + 8 * qp); } } while (0)
#define MM_KD(f, k0) do { _Pragma("unroll") for (int c_ = 0; c_ < 4; ++c_) S[(k0) + c_] = MFMA16(f[c_], vb[0], S[(k0) + c_] * gl); _Pragma("unroll") for (int c_ = 0; c_ < 4; ++c_) S[(k0) + c_] = MFMA16(f[4 + c_], vb[1], S[(k0) + c_]); } while (0)
    LD_VO2(fa, 0, 1, 0); LD_VO2(fb, 0, 1, 2); SB();
    MM_VO2(fa, 0, 1, 0); SB(); LD_VO2(fa, 2, 3, 0); SB();
    MM_VO2(fb, 0, 1, 2); SB(); LD_VO2(fb, 2, 3, 2); SB();
    MM_VO2(fa, 2, 3, 0); SB(); LD_AQ(fa); SB();
    MM_VO2(fb, 2, 3, 2); SB(); LD_KD(fb, 0); SB();
    bf16x8 vb[2];
#pragma unroll
    for (int s = 0; s < 2; ++s) vb[s] = packB(vn[2 * s], vn[2 * s + 1]);
    MM_AQ(fa); SB(); LD_KD(fa, 4); SB();
    MM_KD(fb, 0); SB();
    MM_KD(fa, 4); SB();
#undef SB
#undef LD_VO2
#undef MM_VO2
#undef LD_AQ
#undef MM_AQ
#undef LD_KD
#undef MM_KD
    {
        float v16[16];
#pragma unroll
        for (int ct = 0; ct < 4; ++ct)
#pragma unroll
            for (int e = 0; e < 4; ++e) v16[4 * ct + e] = o[ct][e] * o[ct][e];
#define DPPF(x, ctrl) __builtin_bit_cast(float, __builtin_amdgcn_update_dpp(0, __builtin_bit_cast(int, (x)), (ctrl), 0xF, 0xF, false))
        float w8[8], w4[4], w2[2];
        const bool b3 = r16 & 8, b2 = r16 & 4, b1 = r16 & 2, b0 = r16 & 1;
#pragma unroll
        for (int j = 0; j < 8; ++j) { const float keep = b3 ? v16[j + 8] : v16[j], send = b3 ? v16[j] : v16[j + 8]; w8[j] = keep + DPPF(send, 0x128); }
#pragma unroll
        for (int j = 0; j < 4; ++j) { const float keep = b2 ? w8[j + 4] : w8[j], send = b2 ? w8[j] : w8[j + 4]; w4[j] = keep + DPPF(send, 0x141); }
#pragma unroll
        for (int j = 0; j < 2; ++j) { const float keep = b1 ? w4[j + 2] : w4[j], send = b1 ? w4[j] : w4[j + 2]; w2[j] = keep + DPPF(send, 0x1B); }
        const float keep = b0 ? w2[1] : w2[0], send = b0 ? w2[0] : w2[1];
        const float tot = keep + DPPF(send, 0xB1);
#undef DPPF
        if (accum) atomicAdd((float*)(a.ws + WS_SUMSQ) + (size_t)(b * SEQ + 64 * n + 16 * (r16 >> 2) + 4 * qp + (r16 & 3)) * 8 + h, tot);
    }
    if (n + 1 < 32) scan_store(lds + ((n + 1) & 1) * SC_BUF, T.stg);
    const int rowb = b * SEQ + 64 * n;
#pragma unroll
    for (int ct = 0; ct < 4; ++ct)
#pragma unroll
        for (int e = 0; e < 4; ++e) Y[(size_t)(rowb + 16 * ct + 4 * qp + e) * 2048 + 512 + h * 128 + 16 * wid + r16] = (bf16_t)f2bf(o[ct][e] * dnw);
    __syncthreads();
}

__device__ __forceinline__ void scan_bh(const Args& a, LAS unsigned char* lds, int bh, bool accum = true) {
    int tid_ = threadIdx.x; asm volatile("" : "+v"(tid_));
    const int tid = tid_, lane = tid & 63, wid = tid >> 6, r16 = lane & 15, qp = lane >> 4;
    const float dnw = a.dn_w[16 * wid + r16];
    f32x4 S[8];
#pragma unroll
    for (int kt = 0; kt < 8; ++kt) S[kt] = (f32x4){0.f, 0.f, 0.f, 0.f};
    ScanSet T;
    __syncthreads();
    scan_load_set(a, bh, 0, T, lane, wid);
    scan_store(lds, T.stg);
    __syncthreads();
#pragma unroll 1
    for (int n = 0; n < 32; ++n) scan_step(a, lds, bh, n, S, T, dnw, lane, wid, r16, qp, accum);
}

__device__ __forceinline__ void attn_item(const Args& a, LAS unsigned char* lds, int item) {
    int tid_ = threadIdx.x; asm volatile("" : "+v"(tid_));
    const int tid = tid_, lane = tid & 63, wid = tid >> 6, r16 = lane & 15, qp = lane >> 4;
    const int qt = item & 15, head = (item >> 4) & 3, b = item >> 6;
    LAS bf16_t* Ks = (LAS bf16_t*)lds;
    LAS bf16_t* Vt = (LAS bf16_t*)(lds + 69632);
    const bf16_t* KM = (const bf16_t*)(a.ws + WS_KMEM); const bf16_t* VM = (const bf16_t*)(a.ws + WS_VMEMT); const bf16_t* QM = (const bf16_t*)(a.ws + WS_QM);
    __syncthreads();
#pragma unroll
    for (int i = 0; i < 8; ++i) { const int p = tid + 512 * i;
        { const int key = p >> 4, d8 = p & 15; *(LAS u32x4*)(Ks + key * 136 + d8 * 8) = *(const u32x4*)(KM + (size_t)(b * 256 + key) * 512 + head * 128 + d8 * 8); }
        { const int d = p >> 5, k8 = p & 31; *(LAS u32x4*)(Vt + d * 264 + k8 * 8) = *(const u32x4*)(VM + (size_t)(head * 128 + d) * 2048 + b * 256 + k8 * 8); } }
    const int qrow = b * SEQ + qt * 128 + 16 * wid + r16;
    bf16x8 qf[4];
#pragma unroll
    for (int s = 0; s < 4; ++s) qf[s] = *(const bf16x8*)(QM + (size_t)qrow * 512 + head * 128 + 32 * s + 8 * qp);
    __syncthreads();
    f32x4 sc[16];
#pragma unroll
    for (int kt = 0; kt < 16; ++kt) { sc[kt] = (f32x4){0.f, 0.f, 0.f, 0.f};
#pragma unroll
        for (int s = 0; s < 4; ++s) sc[kt] = MFMA16(*(const LAS bf16x8*)(Ks + (16 * kt + r16) * 136 + 32 * s + 8 * qp), qf[s], sc[kt]); }
    float mx = -3.0e38f;
#pragma unroll
    for (int kt = 0; kt < 16; ++kt) mx = fmaxf(fmaxf(fmaxf(sc[kt][0], sc[kt][1]), fmaxf(sc[kt][2], sc[kt][3])), mx);
    mx = fmaxf(mx, __shfl_xor(mx, 16)); mx = fmaxf(mx, __shfl_xor(mx, 32));
    const float scl = 0.08838834764831845f; float sum = 0.f;
#pragma unroll
    for (int kt = 0; kt < 16; ++kt)
#pragma unroll
        for (int e = 0; e < 4; ++e) { const float p = __expf((sc[kt][e] - mx) * scl); sc[kt][e] = p; sum += p; }
    sum += __shfl_xor(sum, 16); sum += __shfl_xor(sum, 32);
    f32x4 o[8];
#pragma unroll
    for (int dt = 0; dt < 8; ++dt) o[dt] = (f32x4){0.f, 0.f, 0.f, 0.f};
#pragma unroll
    for (int s = 0; s < 8; ++s) { const bf16x8 pb = packB(sc[2 * s], sc[2 * s + 1]);
#pragma unroll
        for (int dt = 0; dt < 8; ++dt) o[dt] = MFMA16(ldA_perm(Vt + (16 * dt + r16) * 264 + 32 * s + 4 * qp), pb, o[dt]); }
    const float inv = 1.f / sum;
    bf16_t* Y = (bf16_t*)a.out;
#pragma unroll
    for (int dt = 0; dt < 8; ++dt) { u32x2 w; w.x = pk2(o[dt][0] * inv, o[dt][1] * inv); w.y = pk2(o[dt][2] * inv, o[dt][3] * inv);
        *(u32x2*)(Y + (size_t)qrow * 2048 + 1536 + head * 128 + 16 * dt + 4 * qp) = w; }
}

__device__ __forceinline__ void pool_item(const Args& a, LAS unsigned char* lds, int item) {
    int tid_ = threadIdx.x; asm volatile("" : "+v"(tid_));
    const int tid = tid_, lane = tid & 63, wid = tid >> 6, r16 = lane & 15, qp = lane >> 4;
    const int g = item & 3, tt = (item >> 2) & 31, b = item >> 7;
    LAS bf16_t* Xs = (LAS bf16_t*)lds;
    LAS bf16_t* Ps = (LAS bf16_t*)(lds + 20480);
    const bf16_t* XA = (const bf16_t*)(a.ws + WS_XA);
    const int t0 = tt * 64;
    __syncthreads();
    for (int p = tid; p < 1280; p += 512) { const int row = p >> 4, c8 = p & 15; const int t = t0 - 16 + row; u32x4 v = (u32x4){0u, 0u, 0u, 0u};
        if (t >= 0) v = *(const u32x4*)(XA + (size_t)(b * SEQ + t) * 512 + g * 128 + c8 * 8);
        *(LAS u32x4*)(Xs + row * 128 + c8 * 8) = v; }
    __syncthreads();
    {
        const int c = tid & 127, rgp = tid >> 7, w = 2 << g; float sum = 0.f;
        for (int j = 1; j < w; ++j) sum += bflo((unsigned)Xs[(16 + 16 * rgp - j) * 128 + c]);
        const float invw = 1.f / (float)w;
#pragma unroll 4
        for (int i = 0; i < 16; ++i) { const int row = 16 * rgp + i; const float xv = bflo((unsigned)Xs[(16 + row) * 128 + c]); sum += xv;
            const int t = t0 + row; const float mean = (t + 1 >= w) ? sum * invw : sum / (float)(t + 1);
            Ps[row * 136 + c] = (bf16_t)f2bf(mean - xv);
            sum -= bflo((unsigned)Xs[(16 + row - (w - 1)) * 128 + c]); }
    }
    __syncthreads();
    const bf16_t* WX = (const bf16_t*)(a.ws + WS_WMIX) + g * 16384;
    f32x4 acc[4];
#pragma unroll
    for (int t4 = 0; t4 < 4; ++t4) acc[t4] = (f32x4){0.f, 0.f, 0.f, 0.f};
#pragma unroll
    for (int s = 0; s < 4; ++s) { const bf16x8 af = *(const bf16x8*)(WX + (16 * wid + r16) * 128 + 32 * s + 8 * qp);
#pragma unroll
        for (int t4 = 0; t4 < 4; ++t4) acc[t4] = MFMA16(af, *(const LAS bf16x8*)(Ps + (16 * t4 + r16) * 136 + 32 * s + 8 * qp), acc[t4]); }
    const f32x4 psc = *(const f32x4*)(a.pool_scale + g * 128 + 16 * wid + 4 * qp);
    bf16_t* Y = (bf16_t*)a.out;
#pragma unroll
    for (int t4 = 0; t4 < 4; ++t4) { u32x2 w2; w2.x = pk2(acc[t4][0] * psc[0], acc[t4][1] * psc[1]); w2.y = pk2(acc[t4][2] * psc[2], acc[t4][3] * psc[3]);
        *(u32x2*)(Y + (size_t)(b * SEQ + t0 + 16 * t4 + r16) * 2048 + g * 128 + 16 * wid + 4 * qp) = w2; }
}

#ifndef REP_P0
#define REP_P0 1
#endif
#ifndef REP_P1
#define REP_P1 1
#endif
#ifndef REP_P3
#define REP_P3 1
#endif
#ifndef REP_P5
#define REP_P5 1
#endif
#define P0_BODY if (IN(0)) p0_prologue(a, lds);
#define P1_BODY \
    if (IN(1)) { \
        {   pg8::Gemm g{(const bf16_t*)(ws + WS_H), (const bf16_t*)(ws + WS_WT), 1024, 1024, 1024}; pg8::StaticOrder S; S.init(M, 4096, G, bx); \
            pg8::EpiStage1 E{(bf16_t*)(ws + WS_XA), (bf16_t*)(ws + WS_QM), (bf16_t*)(ws + WS_QKV), (bf16_t*)(ws + WS_HALO)}; \
            pg8::gemm_phase(lds, g, S, E); } \
    }
#ifndef REP_SCAN
#define REP_SCAN 1
#endif
#ifndef REP_ATTN
#define REP_ATTN 1
#endif
#ifndef REP_POOL
#define REP_POOL 1
#endif
#define P3_BODY \
    if (IN(3)) { \
        unsigned* kvcnt = (unsigned*)(ws + WS_CTL) + 8192; \
        if (G >= 128) { \
            if (bx < 64) { for (int rep = 0; rep < REP_SCAN; ++rep) scan_bh(a, lds, bx, rep == 0); } \
            else { const int c = bx - 64, GG = G - 64; \
                if (c < 32) { \
                    pg8::OneUnit S1; \
                    if (c < 16) { S1.u.pm = c >> 1; S1.u.pn = c & 1; pg8::Gemm g{(const bf16_t*)(ws + WS_MEMN), (const bf16_t*)(ws + WS_WKV), 1024, 1024, 1024}; pg8::EpiPlain E{(bf16_t*)(ws + WS_KMEM), 512}; pg8::gemm_phase(lds, g, S1, E); } \
                    else { S1.u.pm = (c - 16) >> 3; S1.u.pn = (c - 16) & 7; pg8::Gemm g{(const bf16_t*)(ws + WS_WKV) + (size_t)512 * 1024, (const bf16_t*)(ws + WS_MEMN), 1024, 1024, 1024}; pg8::EpiPlain E{(bf16_t*)(ws + WS_VMEMT), 2048}; pg8::gemm_phase(lds, g, S1, E); } \
                    asm volatile("s_waitcnt vmcnt(0)" ::: "memory"); __syncthreads(); \
                    if (tid == 0) { __builtin_amdgcn_fence(__ATOMIC_RELEASE, "agent"); asm volatile("s_waitcnt vmcnt(0)" ::: "memory"); __hip_atomic_fetch_add(kvcnt, 1u, __ATOMIC_RELAXED, __HIP_MEMORY_SCOPE_AGENT); } \
                } \
                bool kv_ok = false; \
                for (int it = c; it < 1024 * REP_POOL + 512 * REP_ATTN; it += GG) { \
                    if (it < 1024 * REP_POOL) pool_item(a, lds, it & 1023); \
                    else { \
                        if (!kv_ok) { if (tid == 0) { unsigned sp = 0; while (__hip_atomic_load(kvcnt, __ATOMIC_RELAXED, __HIP_MEMORY_SCOPE_AGENT) < 32u) { __builtin_amdgcn_s_sleep(2); if (++sp > (1u << 20)) break; } \
                                __builtin_amdgcn_fence(__ATOMIC_ACQUIRE, "agent"); asm volatile("s_waitcnt vmcnt(0)" ::: "memory"); } __syncthreads(); kv_ok = true; } \
                        attn_item(a, lds, (it - 1024 * REP_POOL) & 511); } } \
                late_transposes(a, lds, c, GG); } \
        } else { \
            for (int it = bx; it < 32; it += G) { pg8::OneUnit S1; \
                    if (it < 16) { S1.u.pm = it >> 1; S1.u.pn = it & 1; pg8::Gemm g{(const bf16_t*)(ws + WS_MEMN), (const bf16_t*)(ws + WS_WKV), 1024, 1024, 1024}; pg8::EpiPlain E{(bf16_t*)(ws + WS_KMEM), 512}; pg8::gemm_phase(lds, g, S1, E); } \
                    else { S1.u.pm = (it - 16) >> 3; S1.u.pn = (it - 16) & 7; pg8::Gemm g{(const bf16_t*)(ws + WS_WKV) + (size_t)512 * 1024, (const bf16_t*)(ws + WS_MEMN), 1024, 1024, 1024}; pg8::EpiPlain E{(bf16_t*)(ws + WS_VMEMT), 2048}; pg8::gemm_phase(lds, g, S1, E); } } \
            xcd_barrier(xbar); \
            for (int it = bx; it < 64 + 512 + 1024; it += G) { if (it < 64) scan_bh(a, lds, it); else if (it < 576) attn_item(a, lds, it - 64); else pool_item(a, lds, it - 576); } \
            late_transposes(a, lds, bx, G); \
        } \
    }
#define P5_BODY \
    if (IN(5)) { \
        pg8::StaticOrder SO; SO.init(M, 1024, G, bx); \
        pg8::OneUnit S1; \
        if (SO.next(0, S1.u)) { \
            bf16_t* Y = (bf16_t*)(ws + WS_Y); const bf16_t* YC = (const bf16_t*)a.out; const bf16_t* GT = (const bf16_t*)(ws + WS_GATE); \
            {   pg8::Gemm g{YC, (const bf16_t*)(ws + WS_WP), 2048, 512, 512}; pg8::EpiProj<0> E{GT, Y}; pg8::gemm_phase(lds, g, S1, E); } \
            {   pg8::Gemm g{YC + 512, (const bf16_t*)(ws + WS_WD), 2048, 1024, 1024}; pg8::EpiProj<1> E{GT, Y}; pg8::gemm_phase(lds, g, S1, E); } \
            {   pg8::Gemm g{YC + 1536, (const bf16_t*)(ws + WS_WM), 2048, 512, 512}; pg8::EpiProj<2> E{GT, Y}; pg8::gemm_phase(lds, g, S1, E); } \
        } \
    }
__global__ void __launch_bounds__(512, 2) hybrid_fwd(Args a) {
    extern __shared__ __attribute__((aligned(16))) unsigned char lds_raw[];
    LAS unsigned char* lds = (LAS unsigned char*)lds_raw;
    const int G = gridDim.x, bx = blockIdx.x, tid = threadIdx.x;
    unsigned char* ws = a.ws;
    const int lo = a.ph_lo, hi = a.ph_hi;
    volatile LAS unsigned* xst = (volatile LAS unsigned*)(lds + LDS_BYTES - 16);
    if (tid < 4) xst[tid] = 0u;
    __syncthreads();
    XcdBarrier xbar; xbar.bar = (unsigned*)(ws + WS_CTL); xbar.x = 0; xbar.st = xst;
    if (hi - lo > 1) xbar = xcd_barrier_post((unsigned*)(ws + WS_CTL), xst);
    if (lo == 0x7fffffff) cg::this_grid().sync();
#define IN(k) (lo <= (k) && (k) < hi)
#define SEAM(k) do { if (IN(k) && IN((k) + 1)) xcd_barrier(xbar); } while (0)
    P0_BODY
#if REP_P0 > 1
    xcd_barrier(xbar);
    P0_BODY
#endif
    SEAM(0);
#ifndef REP_P12
#define REP_P12 1
#endif
    for (int rep12 = 0; rep12 < REP_P12; ++rep12) {
    if (rep12) xcd_barrier(xbar);
    P1_BODY
#if REP_P1 > 1
    xcd_barrier(xbar);
    P1_BODY
#endif
    SEAM(1);
#ifndef NO_P2
    if (IN(2)) { u32x4 raw[11]; float gpre = 0.f, bpre = 0.f; if (bx < 2048) { chunk_load_raw(a, bx, raw, tid); if (tid < 64) { const int n2 = bx & 31, h2 = (bx >> 5) & 7, b2 = bx >> 8; const int r2 = b2 * SEQ + 64 * n2; gpre = ((const float*)(ws + WS_G))[(size_t)(r2 + tid) * 8 + h2]; bpre = ((const float*)(ws + WS_BETA))[(size_t)(r2 + tid) * 8 + h2]; } }
#pragma unroll 1
        for (int it0 = bx; it0 < 2048; it0 += 2 * G) {
            const int it1 = it0 + G; const int nvalid = (it1 < 2048) ? 2 : 1;
#pragma unroll 1
            for (int ms = 0; ms < 5; ++ms) {
                const int st = (ms < 2) ? 0 : (ms == 2 ? 1 : 2); const int st_set = (ms == 1 || ms == 4) ? 1 : 0;
                if (st != 1 && st_set == 1 && nvalid < 2) continue;
                const int itc = st_set ? it1 : it0;
                chunk_prep_item(a, lds, itc, raw, (itc + G < 2048) ? itc + G : -1, gpre, bpre, st_set, st, nvalid);
            }
        } }
#endif
    }
    SEAM(2);
    P3_BODY
#if REP_P3 > 1
    xcd_barrier(xbar);
    P3_BODY
#endif
    SEAM(3);
    if (IN(4)) {
        {   pg8::Gemm g{(const bf16_t*)(ws + WS_H), (const bf16_t*)(ws + WS_WT) + (size_t)4096 * 1024, 1024, 1024, 1024}; pg8::StaticOrder S; S.init(M, 2048, G, bx);
            pg8::EpiZ E{(bf16_t*)a.out, (const float*)(ws + WS_SUMSQ)}; pg8::gemm_phase(lds, g, S, E); }
        {   pg8::Gemm g{(const bf16_t*)(ws + WS_H), (const bf16_t*)(ws + WS_WT) + (size_t)6144 * 1024, 1024, 1024, 1024}; pg8::StaticOrder S; S.init(M, 3072, G, bx);
            pg8::EpiGate E{(bf16_t*)(ws + WS_GATE)}; pg8::gemm_phase(lds, g, S, E); }
    }
    SEAM(4);
    P5_BODY
#if REP_P5 > 1
    xcd_barrier(xbar);
    P5_BODY
#endif
    SEAM(5);
    if (IN(6)) {
        pg8::Gemm g{(const bf16_t*)(ws + WS_Y), (const bf16_t*)(ws + WS_WOUT), 1024, 1024, 1024}; pg8::StaticOrder S; S.init(M, 1024, G, bx);
        pg8::EpiOutNorm E{a.out, a.x, a.post_w, (float*)(ws + WS_ROWSS), (unsigned*)(ws + WS_CTL) + 4096};
        pg8::gemm_phase(lds, g, S, E);
    }
#undef IN
#undef SEAM
}

extern "C" void kernel_launch(void* const* d_in, const int* in_sizes, int n_in, void* d_out, int out_size, void* d_ws, size_t ws_size, hipStream_t stream) {
    static int grid = 0;
    if (grid == 0) {
        if (n_in != 17 || out_size != M * DM || ws_size < WS_END) { fprintf(stderr, "kernel_launch: unexpected shapes (n_in %d out %d ws %zu)\n", n_in, out_size, ws_size); grid = -1; return; }
        int dev = 0, cus = 0, per_cu = 0;
        hipGetDevice(&dev); hipDeviceGetAttribute(&cus, hipDeviceAttributeMultiprocessorCount, dev);
        if (hipFuncSetAttribute((const void*)hybrid_fwd, hipFuncAttributeMaxDynamicSharedMemorySize, LDS_BYTES) != hipSuccess) { fprintf(stderr, "kernel_launch: hipFuncSetAttribute failed\n"); grid = -1; return; }
        if (hipOccupancyMaxActiveBlocksPerMultiprocessor(&per_cu, (const void*)hybrid_fwd, 512, LDS_BYTES) != hipSuccess || per_cu < 1) { fprintf(stderr, "kernel_launch: occupancy query gives %d\n", per_cu); per_cu = 1; }
        (void)hipGetLastError();
        grid = cus * 1;
        if (grid > 256) grid = 256;
    }
    if (grid < 0) return;
    Args a{};
    a.x = (const float*)d_in[0]; a.mem = (const float*)d_in[1]; a.pre_w = (const float*)d_in[2]; a.mem_w = (const float*)d_in[3]; a.w_in = (const float*)d_in[4];
    a.conv_w = (const float*)d_in[5]; a.a_log = (const float*)d_in[6]; a.dt_bias = (const float*)d_in[7]; a.dn_w = (const float*)d_in[8]; a.mix_w = (const float*)d_in[9];
    a.pool_scale = (const float*)d_in[10]; a.w_kv = (const float*)d_in[11]; a.w_pp = (const float*)d_in[12]; a.w_pd = (const float*)d_in[13]; a.w_pm = (const float*)d_in[14];
    a.w_out = (const float*)d_in[15]; a.post_w = (const float*)d_in[16];
    a.out = (float*)d_out; a.ws = (unsigned char*)d_ws;
#if MK_PER_PHASE
    for (int p = 0; p < 7; ++p) { a.ph_lo = p; a.ph_hi = p + 1; hipLaunchKernelGGL(hybrid_fwd, dim3(grid), dim3(512), LDS_BYTES, stream, a); }
#else
    a.ph_lo = 0; a.ph_hi = 7;
    if (hipMemsetAsync((char*)d_ws + WS_CTL, 0, 65536, stream) != hipSuccess) { fprintf(stderr, "kernel_launch: memset of the barrier words failed\n"); return; }
    void* args[] = {&a};
    hipError_t e = hipLaunchCooperativeKernel((const void*)hybrid_fwd, dim3(grid), dim3(512), args, LDS_BYTES, stream);
    if (e != hipSuccess) fprintf(stderr, "kernel_launch: cooperative launch failed: %s (grid %d)\n", hipGetErrorString(e), grid);
#endif
}
```

```cpp
#include <hip/hip_runtime.h>
#include <hip/hip_cooperative_groups.h>
#include <cstdio>
#include <cstdint>
namespace cg = cooperative_groups;

#ifndef MK_PER_PHASE
#define MK_PER_PHASE 0
#endif

#define LAS __attribute__((address_space(3)))
typedef unsigned short bf16_t;
typedef short bf16x8 __attribute__((ext_vector_type(8)));
typedef float f32x4 __attribute__((ext_vector_type(4)));
typedef unsigned u32x4 __attribute__((ext_vector_type(4)));
typedef unsigned u32x2 __attribute__((ext_vector_type(2)));

constexpr int DM = 1024, NB = 8, SEQ = 2048, M = NB * SEQ, INW = 9232, MEML = 256;
constexpr float EPS = 1e-6f;
constexpr size_t MiB = 1u << 20;
constexpr size_t WS_WT = 0;
constexpr size_t WS_WKV = 18 * MiB;
constexpr size_t WS_WP = 20 * MiB;
constexpr size_t WS_WD = 21 * MiB;
constexpr size_t WS_WM = 23 * MiB;
constexpr size_t WS_WOUT = 24 * MiB;
constexpr size_t WS_WMIX = 26 * MiB;
constexpr size_t WS_G = 26 * MiB + 256 * 1024;
constexpr size_t WS_BETA = WS_G + 512 * 1024;
constexpr size_t WS_ROWSS = WS_BETA + 512 * 1024;
constexpr size_t WS_GL = WS_ROWSS + 64 * 1024;
constexpr size_t WS_SUMSQ = 27 * MiB + 384 * 1024;
constexpr size_t WS_H = 28 * MiB;
constexpr size_t WS_MEMN = 60 * MiB;
constexpr size_t WS_KMEM = 64 * MiB;
constexpr size_t WS_VMEMT = 66 * MiB;
constexpr size_t WS_XA = 68 * MiB;
constexpr size_t WS_QM = 84 * MiB;
constexpr size_t WS_QKV = 100 * MiB;
constexpr size_t WS_HALO = 196 * MiB;
constexpr size_t WS_U = 201 * MiB;
constexpr size_t WS_AQK = 233 * MiB;
constexpr size_t WS_CTL = 250 * MiB;
constexpr size_t WS_END = 251 * MiB;
constexpr size_t WS_Y = WS_XA;
constexpr size_t WS_GATE = WS_QKV;
constexpr int LDS_BYTES = 147456;

__device__ __forceinline__ unsigned f2bf(float f) { unsigned u = __float_as_uint(f); return (u + 0x7fffu + ((u >> 16) & 1u)) >> 16; }
typedef __bf16 bf16x2_t __attribute__((ext_vector_type(2)));
typedef float f32x2_t __attribute__((ext_vector_type(2)));
__device__ __forceinline__ unsigned pk2(float lo, float hi) { f32x2_t v = {lo, hi}; bf16x2_t b = __builtin_convertvector(v, bf16x2_t); return __builtin_bit_cast(unsigned, b); }
__device__ __forceinline__ float bflo(unsigned u) { return __uint_as_float(u << 16); }
__device__ __forceinline__ float bfhi(unsigned u) { return __uint_as_float(u & 0xffff0000u); }
__device__ __forceinline__ unsigned cvt_pk_bf16(float lo, float hi) { unsigned r; asm volatile("v_cvt_pk_bf16_f32 %0, %1, %2" : "=v"(r) : "v"(lo), "v"(hi)); return r; }
__device__ __forceinline__ float silu_f(float z) { return z * __builtin_amdgcn_rcpf(1.f + __expf(-z)); }
__device__ __forceinline__ float sigm_f(float z) { return __builtin_amdgcn_rcpf(1.f + __expf(-z)); }
#define LDS_WAIT() asm volatile("s_waitcnt lgkmcnt(0)" ::: "memory")
#define MFMA16(a, b, c) __builtin_amdgcn_mfma_f32_16x16x32_bf16((a), (b), (c), 0, 0, 0)

namespace pg8 {
constexpr int BM = 256, BK = 64, HALF = 128, HTB = HALF * BK * 2, STAGE_BYTES = 8 * HTB, NXCD = 8, WGM = 4;
__host__ __device__ __forceinline__ int lds_byte(int r, int c) { const int st = (r >> 4) * 2 + (c >> 5), rr = r & 15, cc = c & 31, ob = rr * 64 + cc * 2; return st * 1024 + (ob ^ (((ob >> 9) & 1) << 5)); }
__host__ __device__ __forceinline__ void stage_rc(int b, int& R, int& C) { const int st = b / 1024, sb = b % 1024, swz = sb ^ (((sb >> 9) & 1) << 5); R = (st >> 1) * 16 + swz / 64; C = (st & 1) * 32 + (swz % 64) / 2; }
__host__ __device__ __forceinline__ int perm32(int rho) { const int n = rho >> 4, i = rho & 15; return 8 * (i >> 2) + 4 * n + (i & 3); }
struct Unit { int pm, pn; };
struct Gemm { const bf16_t* A; const bf16_t* Bt; int lda, ldb, K; };
struct StaticOrder {
    int nM, nN, nwg, G, c;
    __device__ void init(int Mr, int Nc, int G_, int c_) { nM = Mr / BM; nN = Nc / BM; nwg = nM * nN; G = G_; c = c_; }
    __device__ bool next(int i, Unit& u) const {
        const long L = (long)i * G + c; if (L >= nwg) return false;
        int wgid = (int)L; { const int q = nwg / NXCD, r = nwg % NXCD, xcd = wgid % NXCD, off = wgid / NXCD; wgid = (xcd < r ? xcd * (q + 1) : r * (q + 1) + (xcd - r) * q) + off; }
        const int nig = WGM * nN, gid = wgid / nig, fm = gid * WGM, gsz = (nM - fm) < WGM ? (nM - fm) : WGM;
        u.pm = fm + ((wgid % nig) % gsz); u.pn = (wgid % nig) / gsz; return true;
    }
};
struct OneUnit {
    Unit u;
    __device__ bool next(int i, Unit& o) const { if (i) return false; o = u; return true; }
};

template <class Epi, class Sched>
__device__ __forceinline__ void gemm_phase(LAS unsigned char* lds, const Gemm g, const Sched& S, const Epi& E) {
    int tid_ = threadIdx.x; asm volatile("" : "+v"(tid_));
    const int tid = tid_, wid = __builtin_amdgcn_readfirstlane(tid >> 6), lane = tid & 63, wr = wid >> 2, wc = wid & 3, fr = lane & 15, fq = lane >> 4;
    const int K = g.K, nt = K / BK;
    unsigned voffA[2], voffB[2];
#pragma unroll
    for (int i = 0; i < 2; ++i) { int R, C; stage_rc(tid * 16 + i * 8192, R, C); const int Rb = (R & ~31) + perm32(R & 31);
        voffA[i] = (unsigned)(R * g.lda + C) * 2u; voffB[i] = (unsigned)(Rb * g.ldb + C) * 2u; }
    const size_t kstep = (size_t)(BK * 2);
    const size_t hstepA = (size_t)HALF * g.lda * 2, hstepB = (size_t)HALF * g.ldb * 2;
    const size_t tstepA = 2 * hstepA, tstepB = 2 * hstepB;
    const unsigned ldsw = (unsigned)wid * 1024u;
    const int aoff = lds_byte(wr * 64 + fr, fq * 8), boff = lds_byte(wc * 32 + fr, fq * 8);
#define PG8_SA(b, h) (((b) * 2 + (h)) * HTB)
#define PG8_SB(b, h) ((4 + (b) * 2 + (h)) * HTB)
#define PG8_STAGE(bufoff, gbase, voff) do { _Pragma("unroll") for (int _i = 0; _i < 2; ++_i) \
        __builtin_amdgcn_global_load_lds((const unsigned*)((const char*)(gbase) + (voff)[_i]), (LAS unsigned*)(lds + (bufoff) + ldsw + _i * 8192), 16, 0, 0); } while (0)
#define PG8_LDA(dst, b, h) do { _Pragma("unroll") for (int m = 0; m < 4; ++m) _Pragma("unroll") for (int k = 0; k < 2; ++k) dst[m][k] = *(const LAS bf16x8*)(lds + PG8_SA(b, h) + aoff + m * 2048 + k * 1024); } while (0)
#define PG8_LDB(dst, b, h) do { _Pragma("unroll") for (int n = 0; n < 2; ++n) _Pragma("unroll") for (int k = 0; k < 2; ++k) dst[n][k] = *(const LAS bf16x8*)(lds + PG8_SB(b, h) + boff + n * 2048 + k * 1024); } while (0)
#define PG8_MMA(ai, bj, At, Bt) do { __builtin_amdgcn_s_setprio(1); _Pragma("unroll") for (int m = 0; m < 4; ++m) _Pragma("unroll") for (int n = 0; n < 2; ++n) _Pragma("unroll") for (int k = 0; k < 2; ++k) \
        acc[ai][bj][m][n] = __builtin_amdgcn_mfma_f32_16x16x32_bf16(Bt[n][k], At[m][k], acc[ai][bj][m][n], 0, 0, 0); __builtin_amdgcn_s_setprio(0); } while (0)
#define PG8_WAIT_V(n) asm volatile("s_waitcnt vmcnt(" #n ")" ::: "memory")
#define PG8_WAIT_L(n) asm volatile("s_waitcnt lgkmcnt(" #n ")" ::: "memory")
#define PG8_BAR __builtin_amdgcn_s_barrier()
#define PG8_SCHED __builtin_amdgcn_sched_barrier(0)
    Unit cur, nxt; int ui = 0;
    if (!S.next(0, cur)) return;
    f32x4 acc[2][2][4][2];
#pragma unroll
    for (int a = 0; a < 2; ++a)
#pragma unroll
        for (int b = 0; b < 2; ++b)
#pragma unroll
            for (int m = 0; m < 4; ++m)
#pragma unroll
                for (int n = 0; n < 2; ++n) acc[a][b][m][n] = (f32x4){0.f, 0.f, 0.f, 0.f};
    bf16x8 At[4][2], B0[2][2], B1[2][2];
    const char* cA = (const char*)g.A + (size_t)cur.pm * tstepA; const char* cB = (const char*)g.Bt + (size_t)cur.pn * tstepB;
    {
        PG8_STAGE(PG8_SB(0, 0), cB, voffB); PG8_STAGE(PG8_SB(0, 1), cB + hstepB, voffB); PG8_STAGE(PG8_SA(0, 0), cA, voffA); PG8_STAGE(PG8_SA(0, 1), cA + hstepA, voffA);
        if (wr == 1) PG8_BAR;
        PG8_WAIT_V(2); PG8_BAR;
        PG8_STAGE(PG8_SB(1, 0), cB + kstep, voffB); PG8_STAGE(PG8_SA(1, 0), cA + kstep, voffA); PG8_STAGE(PG8_SB(1, 1), cB + hstepB + kstep, voffB);
        PG8_WAIT_V(6); PG8_BAR;
    }
    for (;;) {
        const bool has_next = S.next(ui + 1, nxt);
        const char* nA = has_next ? (const char*)g.A + (size_t)nxt.pm * tstepA : cA; const char* nB = has_next ? (const char*)g.Bt + (size_t)nxt.pn * tstepB : cB;
        for (int t = 0; t < nt; t += 2) {
            const bool last = (t == nt - 2);
            const char* a1 = cA + (size_t)(t + 1) * kstep;
            const char* a2 = last ? nA : cA + (size_t)(t + 2) * kstep; const char* b2 = last ? nB : cB + (size_t)(t + 2) * kstep;
            const char* a3 = a2 + kstep; const char* b3 = b2 + kstep;
            PG8_LDB(B0, 0, 0); PG8_LDB(B1, 0, 1); PG8_SCHED; PG8_LDA(At, 0, 0); PG8_STAGE(PG8_SA(1, 1), a1 + hstepA, voffA);
            PG8_WAIT_V(8); PG8_WAIT_L(0); PG8_BAR; PG8_MMA(0, 0, At, B0); PG8_MMA(0, 1, At, B1); PG8_BAR; PG8_SCHED;
            PG8_LDA(At, 0, 1); PG8_STAGE(PG8_SB(0, 0), b2, voffB); PG8_STAGE(PG8_SB(0, 1), b2 + hstepB, voffB); PG8_STAGE(PG8_SA(0, 0), a2, voffA);
            PG8_WAIT_V(8); PG8_WAIT_L(0); PG8_BAR; PG8_MMA(1, 0, At, B0); PG8_MMA(1, 1, At, B1); PG8_BAR; PG8_SCHED;
            PG8_LDB(B0, 1, 0); PG8_LDB(B1, 1, 1); PG8_SCHED; PG8_LDA(At, 1, 0); PG8_STAGE(PG8_SA(0, 1), a2 + hstepA, voffA);
            PG8_WAIT_V(8); PG8_WAIT_L(0); PG8_BAR; PG8_MMA(0, 0, At, B0); PG8_MMA(0, 1, At, B1); PG8_BAR; PG8_SCHED;
            PG8_LDA(At, 1, 1); PG8_STAGE(PG8_SB(1, 0), b3, voffB); PG8_STAGE(PG8_SB(1, 1), b3 + hstepB, voffB); PG8_STAGE(PG8_SA(1, 0), a3, voffA);
            PG8_WAIT_V(8); PG8_WAIT_L(0); PG8_BAR; PG8_MMA(1, 0, At, B0); PG8_MMA(1, 1, At, B1); PG8_BAR; PG8_SCHED;
        }
        if (wr == 0) PG8_BAR;
        E(acc, cur, wr, wc, fr, fq);
        if (!has_next) break;
#pragma unroll
        for (int a = 0; a < 2; ++a)
#pragma unroll
            for (int b = 0; b < 2; ++b)
#pragma unroll
                for (int m = 0; m < 4; ++m)
#pragma unroll
                    for (int n = 0; n < 2; ++n) acc[a][b][m][n] = (f32x4){0.f, 0.f, 0.f, 0.f};
        cur = nxt; cA = nA; cB = nB; ++ui;
        if (wr == 1) PG8_BAR;
    }
    PG8_WAIT_V(0);
    PG8_BAR;
#undef PG8_SA
#undef PG8_SB
#undef PG8_STAGE
#undef PG8_LDA
#undef PG8_LDB
#undef PG8_MMA
#undef PG8_WAIT_V
#undef PG8_WAIT_L
#undef PG8_BAR
#undef PG8_SCHED
}

typedef const f32x4 (&AccRef)[2][2][4][2];
__device__ __forceinline__ u32x4 pack8(f32x4 v0, f32x4 v1) { u32x4 w; w.x = pk2(v0[0], v0[1]); w.y = pk2(v0[2], v0[3]); w.z = pk2(v1[0], v1[1]); w.w = pk2(v1[2], v1[3]); return w; }

struct EpiPlain {
    bf16_t* O; int ldc;
    __device__ __forceinline__ void operator()(AccRef acc, const Unit& u, int wr, int wc, int fr, int fq) const {
        const int row0 = u.pm * BM + wr * 64 + fr, col0 = u.pn * BM + wc * 32 + 8 * fq;
#pragma unroll
        for (int ai = 0; ai < 2; ++ai)
#pragma unroll
            for (int m = 0; m < 4; ++m) { bf16_t* rowp = O + (size_t)(row0 + ai * HALF + m * 16) * ldc + col0;
#pragma unroll
                for (int bj = 0; bj < 2; ++bj) *(u32x4*)(rowp + bj * HALF) = pack8(acc[ai][bj][m][0], acc[ai][bj][m][1]); }
    }
};
struct EpiStage1 {
    bf16_t *xa, *qm, *qkv, *halo;
    __device__ __forceinline__ void operator()(AccRef acc, const Unit& u, int wr, int wc, int fr, int fq) const {
        const int pn = u.pn; bf16_t* base; int ldc, colt;
        if (pn < 2) { base = xa; ldc = 512; colt = pn * 256; }
        else if (pn < 4) { base = qm; ldc = 512; colt = (pn - 2) * 256; }
        else { const int t = (pn - 4) >> 2; base = qkv + (size_t)t * M * 1024; ldc = 1024; colt = ((pn - 4) & 3) * 256; }
        const int row0 = u.pm * BM + wr * 64 + fr, col0 = colt + wc * 32 + 8 * fq;
#pragma unroll
        for (int ai = 0; ai < 2; ++ai)
#pragma unroll
            for (int m = 0; m < 4; ++m) { const int row = row0 + ai * HALF + m * 16; bf16_t* rowp = base + (size_t)row * ldc + col0;
#pragma unroll
                for (int bj = 0; bj < 2; ++bj) { const u32x4 w = pack8(acc[ai][bj][m][0], acc[ai][bj][m][1]);
                    *(u32x4*)(rowp + bj * HALF) = w;
                    if (m == 3 && pn >= 4 && fr >= 13) *(u32x4*)(halo + ((size_t)(row >> 6) * 3 + (fr - 13)) * 3072 + (pn - 4) * 256 + bj * HALF + wc * 32 + 8 * fq) = w; } }
    }
};
struct EpiZ {
    bf16_t* Y; const float* SUMSQ;
    __device__ __forceinline__ void operator()(AccRef acc, const Unit& u, int wr, int wc, int fr, int fq) const {
        int tid = threadIdx.x; asm volatile("" : "+v"(tid)); fr = tid & 15; fq = (tid >> 4) & 3;
        const int row0 = u.pm * BM + wr * 64 + fr, col0 = u.pn * BM + wc * 32 + 8 * fq;
        const bool isdn = (col0 >= 512) && (col0 < 1536); const int hd = isdn ? ((col0 - 512) >> 7) : 0;
#pragma unroll
        for (int ai = 0; ai < 2; ++ai)
#pragma unroll
            for (int mh = 0; mh < 2; ++mh) {
                u32x4 o[2][2]; float sq[2][2];
#pragma unroll
                for (int mm = 0; mm < 2; ++mm)
#pragma unroll
                    for (int bj = 0; bj < 2; ++bj) { const size_t row = (size_t)(row0 + ai * HALF + (2 * mh + mm) * 16);
                        o[mm][bj] = *(const u32x4*)(Y + row * 2048 + col0 + bj * HALF); sq[mm][bj] = SUMSQ[row * 8 + (isdn ? hd + bj : 0)]; }
#pragma unroll
                for (int mm = 0; mm < 2; ++mm)
#pragma unroll
                    for (int bj = 0; bj < 2; ++bj) { const int m = 2 * mh + mm; const size_t row = (size_t)(row0 + ai * HALF + m * 16);
                        const f32x4 a0 = acc[ai][bj][m][0], a1 = acc[ai][bj][m][1]; const u32x4 ov = o[mm][bj];
                        const float fac = isdn ? (1.0f / sqrtf(sq[mm][bj] * (1.f / 128.f) + EPS)) : 1.f;
                        f32x4 v0, v1;
                        v0[0] = bflo(ov.x) * silu_f(a0[0]); v0[1] = bfhi(ov.x) * silu_f(a0[1]); v0[2] = bflo(ov.y) * silu_f(a0[2]); v0[3] = bfhi(ov.y) * silu_f(a0[3]);
                        v1[0] = bflo(ov.z) * silu_f(a1[0]); v1[1] = bfhi(ov.z) * silu_f(a1[1]); v1[2] = bflo(ov.w) * silu_f(a1[2]); v1[3] = bfhi(ov.w) * silu_f(a1[3]);
                        *(u32x4*)(Y + row * 2048 + col0 + bj * HALF) = pack8(v0 * fac, v1 * fac); }
                asm volatile("" ::: "memory"); __builtin_amdgcn_sched_barrier(0);
            }
    }
};
struct EpiGate {
    bf16_t* GATE;
    __device__ __forceinline__ void operator()(AccRef acc, const Unit& u, int wr, int wc, int fr, int fq) const {
        int tid = threadIdx.x; asm volatile("" : "+v"(tid)); fr = tid & 15; fq = (tid >> 4) & 3;
        const int row0 = u.pm * BM + wr * 64 + fr, col0 = u.pn * BM + wc * 32 + 8 * fq;
#pragma unroll
        for (int ai = 0; ai < 2; ++ai)
#pragma unroll
            for (int m = 0; m < 4; ++m) { bf16_t* rowp = GATE + (size_t)(row0 + ai * HALF + m * 16) * 3072 + col0;
#pragma unroll
                for (int bj = 0; bj < 2; ++bj) { const f32x4 a0 = acc[ai][bj][m][0], a1 = acc[ai][bj][m][1]; f32x4 v0, v1;
#pragma unroll
                    for (int e = 0; e < 4; ++e) { v0[e] = sigm_f(a0[e]); v1[e] = sigm_f(a1[e]); }
                    *(u32x4*)(rowp + bj * HALF) = pack8(v0, v1); } }
    }
};
template <int BR> struct EpiProj {
    const bf16_t* GATE; bf16_t* Y;
    __device__ __forceinline__ void operator()(AccRef acc, const Unit& u, int wr, int wc, int fr, int fq) const {
        int tid = threadIdx.x; asm volatile("" : "+v"(tid)); fr = tid & 15; fq = (tid >> 4) & 3;
        const int row0 = u.pm * BM + wr * 64 + fr, col0 = u.pn * BM + wc * 32 + 8 * fq;
#pragma unroll
        for (int ai = 0; ai < 2; ++ai)
#pragma unroll
            for (int mh = 0; mh < 2; ++mh) {
                u32x4 gq[2][2], yo[2][2];
#pragma unroll
                for (int mm = 0; mm < 2; ++mm)
#pragma unroll
                    for (int bj = 0; bj < 2; ++bj) { const size_t row = (size_t)(row0 + ai * HALF + (2 * mh + mm) * 16);
                        gq[mm][bj] = *(const u32x4*)(GATE + row * 3072 + BR * 1024 + col0 + bj * HALF);
                        if (BR > 0) yo[mm][bj] = *(const u32x4*)(Y + row * 1024 + col0 + bj * HALF); }
#pragma unroll
                for (int mm = 0; mm < 2; ++mm)
#pragma unroll
                    for (int bj = 0; bj < 2; ++bj) { const int m = 2 * mh + mm; const size_t row = (size_t)(row0 + ai * HALF + m * 16);
                        const f32x4 a0 = acc[ai][bj][m][0], a1 = acc[ai][bj][m][1]; const u32x4 g4 = gq[mm][bj];
                        f32x4 v0, v1;
                        v0[0] = bflo(g4.x) * a0[0]; v0[1] = bfhi(g4.x) * a0[1]; v0[2] = bflo(g4.y) * a0[2]; v0[3] = bfhi(g4.y) * a0[3];
                        v1[0] = bflo(g4.z) * a1[0]; v1[1] = bfhi(g4.z) * a1[1]; v1[2] = bflo(g4.w) * a1[2]; v1[3] = bfhi(g4.w) * a1[3];
                        if (BR > 0) { const u32x4 y4 = yo[mm][bj];
                            v0[0] += bflo(y4.x); v0[1] += bfhi(y4.x); v0[2] += bflo(y4.y); v0[3] += bfhi(y4.y); v1[0] += bflo(y4.z); v1[1] += bfhi(y4.z); v1[2] += bflo(y4.w); v1[3] += bfhi(y4.w); }
                        *(u32x4*)(Y + row * 1024 + col0 + bj * HALF) = pack8(v0, v1); }
                asm volatile("" ::: "memory"); __builtin_amdgcn_sched_barrier(0);
            }
    }
};
struct EpiOutNorm {
    float* O; const float* X; const float* PW; float* rowss; unsigned* cnt;
    __device__ __forceinline__ void operator()(AccRef acc, const Unit& u, int wr, int wc, int fr, int fq) const {
        int tid = threadIdx.x; asm volatile("" : "+v"(tid)); fr = tid & 15; fq = (tid >> 4) & 3;
        const int row0 = u.pm * BM + wr * 64 + fr, col0 = u.pn * BM + wc * 32 + 8 * fq;
#pragma unroll
        for (int ai = 0; ai < 2; ++ai)
#pragma unroll
            for (int m = 0; m < 4; ++m) { const int row = row0 + ai * HALF + m * 16; float ss = 0.f;
#pragma unroll
                for (int bj = 0; bj < 2; ++bj) { const f32x4 a0 = acc[ai][bj][m][0], a1 = acc[ai][bj][m][1];
                    ss += (a0[0] * a0[0] + a0[1] * a0[1]) + (a0[2] * a0[2] + a0[3] * a0[3]) + (a1[0] * a1[0] + a1[1] * a1[1]) + (a1[2] * a1[2] + a1[3] * a1[3]); }
                ss += __shfl_xor(ss, 16); ss += __shfl_xor(ss, 32);
                if (fq == 0) atomicAdd(rowss + row, ss); }
        asm volatile("s_waitcnt vmcnt(0)" ::: "memory");
        __syncthreads();
        if (threadIdx.x == 0) {
            __hip_atomic_fetch_add(cnt + u.pm * 16, 1u, __ATOMIC_RELAXED, __HIP_MEMORY_SCOPE_AGENT);
            unsigned sp = 0;
            while (__hip_atomic_load(cnt + u.pm * 16, __ATOMIC_RELAXED, __HIP_MEMORY_SCOPE_AGENT) < 4u) { __builtin_amdgcn_s_sleep(1); if (++sp > (1u << 20)) break; }
        }
        __syncthreads();
#pragma unroll
        for (int ai = 0; ai < 2; ++ai)
#pragma unroll
            for (int m = 0; m < 4; ++m) { const int row = row0 + ai * HALF + m * 16;
                const float rs = 1.0f / sqrtf(__hip_atomic_load(rowss + row, __ATOMIC_RELAXED, __HIP_MEMORY_SCOPE_AGENT) * (1.f / 1024.f) + EPS);
                f32x4 xv[2][2];
#pragma unroll
                for (int bj = 0; bj < 2; ++bj) { const size_t off = (size_t)row * 1024 + col0 + bj * HALF; xv[bj][0] = *(const f32x4*)(X + off); xv[bj][1] = *(const f32x4*)(X + off + 4); }
#pragma unroll
                for (int bj = 0; bj < 2; ++bj) { const size_t off = (size_t)row * 1024 + col0 + bj * HALF;
                    const f32x4 w0 = *(const f32x4*)(PW + col0 + bj * HALF), w1 = *(const f32x4*)(PW + col0 + bj * HALF + 4);
                    *(f32x4*)(O + off) = xv[bj][0] + acc[ai][bj][m][0] * rs * w0; *(f32x4*)(O + off + 4) = xv[bj][1] + acc[ai][bj][m][1] * rs * w1; }
                if (m & 1) { asm volatile("" ::: "memory"); __builtin_amdgcn_sched_barrier(0); } }
    }
};
}

#define XB_TMO      128
#define XB_XCNT(j)  (256  + 64 * (j))
#define XB_XSUB(j)  (1280 + 64 * (j))
#define XB_XGEN(j)  (2304 + 64 * (j))
#define XB_TOP      3328
#define XB_TOPGEN   3392
#define XCD_BAR_WORDS 3456
#define XB_SPIN_CAP (1u << 18)

__device__ __forceinline__ unsigned xb_ld(unsigned* p)              { return __hip_atomic_load(p, __ATOMIC_RELAXED, __HIP_MEMORY_SCOPE_AGENT); }
__device__ __forceinline__ unsigned xb_add(unsigned* p, unsigned v) { return __hip_atomic_fetch_add(p, v, __ATOMIC_RELAXED, __HIP_MEMORY_SCOPE_AGENT); }
__device__ __forceinline__ unsigned xb_xcc_id() { return (unsigned)__builtin_amdgcn_s_getreg((3 << 11) | 20) & 0xFu; }
#define XB_SPIN(cond, bar) do { unsigned _sp = 0; while (cond) { __builtin_amdgcn_s_sleep(1); \
    if ((++_sp & 255u) == 0u) { if (xb_ld(&(bar)[XB_TMO])) break; if (_sp > XB_SPIN_CAP) { atomicAdd(&(bar)[XB_TMO], 1u); break; } } } } while (0)

struct XcdBarrier {
    unsigned* bar; unsigned x;
    volatile LAS unsigned* st;
};

__device__ __forceinline__ XcdBarrier xcd_barrier_post(unsigned* bar, volatile LAS unsigned* st) {
    XcdBarrier b; b.bar = bar; b.x = xb_xcc_id(); b.st = st;
    if (threadIdx.x == 0) (void)xb_add(&bar[XB_XCNT(b.x)], 1u);
    return b;
}
__device__ __forceinline__ void xcd_barrier_complete(unsigned* bar, unsigned x, unsigned& nloc, unsigned& nx) {
    const unsigned G = gridDim.x * gridDim.y * gridDim.z;
    unsigned sum, cnt, mine, sp = 0u;
    for (;;) {
        sum = 0u; cnt = 0u; mine = 0u;
#pragma unroll
        for (unsigned j = 0; j < 16; ++j) { const unsigned c = xb_ld(&bar[XB_XCNT(j)]); sum += c; cnt += (c > 0u) ? 1u : 0u; mine = (j == x) ? c : mine; }
        if (sum == G) break;
        __builtin_amdgcn_s_sleep(1);
        if ((++sp & 255u) == 0u) { if (xb_ld(&bar[XB_TMO])) break; if (sp > XB_SPIN_CAP) { atomicAdd(&bar[XB_TMO], 1u); break; } }
    }
    nloc = mine > 0u ? mine : 1u; nx = cnt > 0u ? cnt : 1u;
}

__device__ __forceinline__ void xcd_barrier(const XcdBarrier& b) {
    asm volatile("s_waitcnt vmcnt(0)" ::: "memory");
    __syncthreads();
    if (threadIdx.x == 0) {
        unsigned* bar = b.bar;
        __builtin_amdgcn_s_waitcnt(0);
        unsigned nloc = b.st[0], nx = b.st[1];
        if (nloc == 0u) { xcd_barrier_complete(bar, b.x, nloc, nx); b.st[0] = nloc; b.st[1] = nx; }
        const unsigned old = xb_add(&bar[XB_XSUB(b.x)], 1u);
        const unsigned gen = old / nloc;
        if (old + 1u == (gen + 1u) * nloc) {
            __builtin_amdgcn_fence(__ATOMIC_RELEASE, "agent");
            asm volatile("s_waitcnt vmcnt(0)" ::: "memory");
            const unsigned og = xb_add(&bar[XB_TOP], 1u);
            const unsigned tg = og / nx;
            if (og + 1u == (tg + 1u) * nx) xb_add(&bar[XB_TOPGEN], 1u);
            else XB_SPIN(xb_ld(&bar[XB_TOPGEN]) == tg, bar);
            __builtin_amdgcn_fence(__ATOMIC_ACQUIRE, "agent");
            xb_add(&bar[XB_XGEN(b.x)], 1u);
            asm volatile("s_waitcnt vmcnt(0)" ::: "memory");
        } else {
            XB_SPIN(xb_ld(&bar[XB_XGEN(b.x)]) == gen, bar);
            __builtin_amdgcn_fence(__ATOMIC_ACQUIRE, "agent");
            asm volatile("s_waitcnt vmcnt(0)" ::: "memory");
        }
    }
    __syncthreads();
}


struct Args {
    const float *x, *mem, *pre_w, *mem_w, *w_in, *conv_w, *a_log, *dt_bias, *dn_w, *mix_w, *pool_scale, *w_kv, *w_pp, *w_pd, *w_pm, *w_out, *post_w;
    float* out; unsigned char* ws; int ph_lo, ph_hi;
};

__device__ __forceinline__ float wave_sum(float v) {
    v += __builtin_bit_cast(float, __builtin_amdgcn_update_dpp(0, __builtin_bit_cast(int, v), 0xB1, 0xF, 0xF, false));
    v += __builtin_bit_cast(float, __builtin_amdgcn_update_dpp(0, __builtin_bit_cast(int, v), 0x4E, 0xF, 0xF, false));
    v += __builtin_bit_cast(float, __builtin_amdgcn_update_dpp(0, __builtin_bit_cast(int, v), 0x124, 0xF, 0xF, false));
    v += __builtin_bit_cast(float, __builtin_amdgcn_update_dpp(0, __builtin_bit_cast(int, v), 0x128, 0xF, 0xF, false));
    const int vi = __builtin_bit_cast(int, v);
    const float s0 = __builtin_bit_cast(float, __builtin_amdgcn_readlane(vi, 0)), s1 = __builtin_bit_cast(float, __builtin_amdgcn_readlane(vi, 16));
    const float s2 = __builtin_bit_cast(float, __builtin_amdgcn_readlane(vi, 32)), s3 = __builtin_bit_cast(float, __builtin_amdgcn_readlane(vi, 48));
    return (s0 + s1) + (s2 + s3);
}

__device__ __forceinline__ void p0_transpose_item(const float* W, int ldw, int K, bf16_t* WT, LAS float* scr, int kb, int nb, int lane) {
    const int k0 = 64 * kb, n0 = 32 * nb;
    float tv[32];
#pragma unroll
    for (int i = 0; i < 32; ++i) tv[i] = W[(size_t)(k0 + 2 * i + (lane >> 5)) * ldw + n0 + (lane & 31)];
#pragma unroll
    for (int i = 0; i < 32; ++i) scr[(2 * i + (lane >> 5)) * 33 + (lane & 31)] = tv[i];
    LDS_WAIT();
    const int c = lane & 7;
#pragma unroll
    for (int j = 0; j < 4; ++j) { const int n = (lane >> 3) + 8 * j; const LAS float* s = scr + (8 * c) * 33 + n;
        u32x4 o; o.x = pk2(s[0 * 33], s[1 * 33]); o.y = pk2(s[2 * 33], s[3 * 33]); o.z = pk2(s[4 * 33], s[5 * 33]); o.w = pk2(s[6 * 33], s[7 * 33]);
        *(u32x4*)(WT + (size_t)(n0 + n) * K + k0 + 8 * c) = o; }
    LDS_WAIT();
}

__device__ __forceinline__ void p0_prologue(const Args& a, LAS unsigned char* lds) {
    int tid_ = threadIdx.x; asm volatile("" : "+v"(tid_));
    const int tid = tid_, lane = tid & 63, wave = tid >> 6, G = gridDim.x;
    unsigned char* ws = a.ws;
    LAS float* W16 = (LAS float*)lds;
    LAS float* scr = (LAS float*)(lds + 65536 + wave * 8448);
    for (int idx = tid; idx < 4096; idx += 512) { const int i = idx >> 2, q = idx & 3; const int p = ((i >> 8) * 4 + (i & 3)) * 64 + ((i >> 2) & 63);
        *(LAS f32x4*)(W16 + (q * 1024 + p) * 4) = *(const f32x4*)(a.w_in + (size_t)i * INW + 4096 + 4 * q); }
    for (int i = blockIdx.x * 512 + tid; i < M; i += G * 512) ((float*)(ws + WS_ROWSS))[i] = 0.f;
    for (int i = blockIdx.x * 512 + tid; i < M * 8; i += G * 512) ((float*)(ws + WS_SUMSQ))[i] = 0.f;
    __syncthreads();
    const int gw = blockIdx.x * 8 + wave, NGW = G * 8;
    bf16_t* WT = (bf16_t*)(ws + WS_WT);
#define SEG(src, ldw, Kk, Nseg, dst) { const int ni = ((Kk) / 64) * ((Nseg) / 32); if (r < ni) { const int nblk = (Nseg) / 32; p0_transpose_item((src), (ldw), (Kk), (dst), scr, r / nblk, r % nblk, lane); continue; } r -= ni; }
    constexpr int NITEMS = 16 * 128 + 512 + 32;
    for (int it = gw; it < NITEMS; it += NGW) {
        int r = it;
        SEG(a.w_in + 0, INW, 1024, 512, WT)
        SEG(a.w_in + 5136, INW, 1024, 512, WT + (size_t)512 * 1024)
        SEG(a.w_in + 1024, INW, 1024, 3072, WT + (size_t)1024 * 1024)
        SEG(a.w_kv, 1024, 1024, 1024, (bf16_t*)(ws + WS_WKV))
        SEG(a.mix_w + 0 * 16384, 128, 128, 128, (bf16_t*)(ws + WS_WMIX) + 0 * 16384)
        SEG(a.mix_w + 1 * 16384, 128, 128, 128, (bf16_t*)(ws + WS_WMIX) + 1 * 16384)
        SEG(a.mix_w + 2 * 16384, 128, 128, 128, (bf16_t*)(ws + WS_WMIX) + 2 * 16384)
        SEG(a.mix_w + 3 * 16384, 128, 128, 128, (bf16_t*)(ws + WS_WMIX) + 3 * 16384)
    }
    f32x4 nwx[4], nwm[4];
#pragma unroll
    for (int j = 0; j < 4; ++j) { nwx[j] = ((const f32x4*)a.pre_w)[lane + 64 * j]; nwm[j] = ((const f32x4*)a.mem_w)[lane + 64 * j]; }
    f32x4 vnx[4];
    {   const int m = gw; const float* src = (m >= M) ? a.mem + (size_t)(m - M) * 1024 : a.x + (size_t)m * 1024;
#pragma unroll
        for (int j = 0; j < 4; ++j) vnx[j] = ((const f32x4*)src)[lane + 64 * j]; }
    for (int m = gw; m < M + NB * MEML; m += NGW) {
        const bool is_mem = m >= M;
        bf16_t* dst = is_mem ? (bf16_t*)(ws + WS_MEMN) + (size_t)(m - M) * 1024 : (bf16_t*)(ws + WS_H) + (size_t)m * 1024;
        f32x4 v[4]; float s = 0.f;
#pragma unroll
        for (int j = 0; j < 4; ++j) { v[j] = vnx[j]; s += (v[j].x * v[j].x + v[j].y * v[j].y) + (v[j].z * v[j].z + v[j].w * v[j].w); }
        {   const int m2 = (m + NGW < M + NB * MEML) ? m + NGW : m; const float* src = (m2 >= M) ? a.mem + (size_t)(m2 - M) * 1024 : a.x + (size_t)m2 * 1024;
#pragma unroll
            for (int j = 0; j < 4; ++j) vnx[j] = ((const f32x4*)src)[lane + 64 * j]; }
        const float rstd = 1.0f / sqrtf(wave_sum(s) * (1.f / 1024.f) + EPS);
#pragma unroll
        for (int j = 0; j < 4; ++j) { const f32x4 wv = is_mem ? nwm[j] : nwx[j]; v[j] = v[j] * rstd * wv;
            u32x2 o; o.x = pk2(v[j].x, v[j].y); o.y = pk2(v[j].z, v[j].w); ((u32x2*)dst)[lane + 64 * j] = o; }
        if (!is_mem) {
            f32x4 acc[4];
#pragma unroll
            for (int q = 0; q < 4; ++q) acc[q] = (f32x4){0.f, 0.f, 0.f, 0.f};
#pragma unroll
            for (int j = 0; j < 4; ++j)
#pragma unroll
                for (int e = 0; e < 4; ++e) { const float xv = v[j][e];
#pragma unroll
                    for (int q = 0; q < 4; ++q) { const f32x4 wv = *(const LAS f32x4*)(W16 + (q * 1024 + (j * 4 + e) * 64 + lane) * 4); acc[q] += xv * wv; } }
            float val = 0.f;
#pragma unroll
            for (int q = 0; q < 4; ++q)
#pragma unroll
                for (int e = 0; e < 4; ++e) { const float t = wave_sum(acc[q][e]); if (lane == q * 4 + e) val = t; }
            if (lane < 8) { const float z = val + a.dt_bias[lane]; const float sp = z > 20.f ? z : log1pf(expf(z));
                ((float*)(ws + WS_G))[(size_t)m * 8 + lane] = -expf(a.a_log[lane]) * sp; }
            else if (lane < 16) ((float*)(ws + WS_BETA))[(size_t)m * 8 + lane - 8] = 1.f / (1.f + expf(-val));
        }
    }
}

__device__ __forceinline__ void late_transposes(const Args& a, LAS unsigned char* lds, int c, int GG) {
    int tid_ = threadIdx.x; asm volatile("" : "+v"(tid_));
    const int tid = tid_, lane = tid & 63, wave = tid >> 6;
    unsigned char* ws = a.ws; bf16_t* WT = (bf16_t*)(ws + WS_WT);
    LAS float* scr = (LAS float*)(lds + wave * 8448);
    __syncthreads();
    const int gw = c * 8 + wave, NGW = GG * 8;
    constexpr int NITEMS = 16 * 160 + 256 + 512 + 256 + 512;
    for (int it = gw; it < NITEMS; it += NGW) {
        int r = it;
        SEG(a.w_in + 512, INW, 1024, 512, WT + (size_t)4096 * 1024)
        SEG(a.w_in + 4112, INW, 1024, 1024, WT + (size_t)4608 * 1024)
        SEG(a.w_in + 5648, INW, 1024, 512, WT + (size_t)5632 * 1024)
        SEG(a.w_in + 6160, INW, 1024, 3072, WT + (size_t)6144 * 1024)
        SEG(a.w_pp, 1024, 512, 1024, (bf16_t*)(ws + WS_WP))
        SEG(a.w_pd, 1024, 1024, 1024, (bf16_t*)(ws + WS_WD))
        SEG(a.w_pm, 1024, 512, 1024, (bf16_t*)(ws + WS_WM))
        SEG(a.w_out, 1024, 1024, 1024, (bf16_t*)(ws + WS_WOUT))
    }
    __syncthreads();
}
#undef SEG

__device__ __forceinline__ void chunk_load_raw(const Args& a, int item, u32x4 (&raw)[11], int tid) {
    const int n = item & 31, h = (item >> 5) & 7, b = item >> 8; const int r0 = b * SEQ + 64 * n, gci = b * 32 + n;
    const int ten = tid >> 7, cgp = tid & 15, rg = (tid >> 4) & 7;
    if (tid < 384) {
        const bf16_t* src = (const bf16_t*)(a.ws + WS_QKV) + (size_t)ten * M * 1024 + h * 128 + cgp * 8;
#pragma unroll
        for (int i = 0; i < 11; ++i) { const int rr = 8 * rg - 3 + i;
            if (rr >= 0) raw[i] = *(const u32x4*)(src + (size_t)(r0 + rr) * 1024);
            else if (n > 0) raw[i] = *(const u32x4*)((const bf16_t*)(a.ws + WS_HALO) + ((size_t)(gci - 1) * 3 + (rr + 3)) * 3072 + ten * 1024 + h * 128 + cgp * 8);
            else raw[i] = (u32x4){0u, 0u, 0u, 0u}; }
    }
}
__device__ __forceinline__ void chunk_prep_item(const Args& a, LAS unsigned char* lds, int item, u32x4 (&raw)[11], int item_next, float& gpre, float& bpre, int set, int stage, int nvalid) {
    int tid_ = threadIdx.x; asm volatile("" : "+v"(tid_));
    const int tid = tid_, lane = tid & 63, wid = tid >> 6, r16 = lane & 15, qp = lane >> 4;
    const int n = item & 31, h = (item >> 5) & 7, b = item >> 8;
    const int r0 = b * SEQ + 64 * n, gci = b * 32 + n;
    unsigned char* ws = a.ws;
    bf16_t* QKV = (bf16_t*)(ws + WS_QKV);
    LAS bf16_t* Kn = (LAS bf16_t*)(lds);
    LAS bf16_t* Qn = (LAS bf16_t*)(lds + 17408);
    const int sset = (stage == 1) ? (wid >> 2) : set;
    LAS bf16_t* Tb = (LAS bf16_t*)(lds + sset * 9216);
    LAS bf16_t* VbT = (LAS bf16_t*)(lds + 34816 + sset * 36864);
    LAS bf16_t* KbgT = (LAS bf16_t*)(lds + 53248 + sset * 36864);
    LAS float* Ap = (LAS float*)(lds + 108544 + sset * 17408);
    LAS float* gcs = (LAS float*)(lds + 143360 + sset * 512);
    LAS float* bts = gcs + 64;
    __syncthreads();
    if (stage == 0) {
    if (wid == 0) {
        float g = gpre;
        const float bt = bpre;
        if (item_next >= 0) { const int n2 = item_next & 31, h2 = (item_next >> 5) & 7, b2 = item_next >> 8; const int r2 = b2 * SEQ + 64 * n2;
            gpre = ((const float*)(ws + WS_G))[(size_t)(r2 + lane) * 8 + h2]; bpre = ((const float*)(ws + WS_BETA))[(size_t)(r2 + lane) * 8 + h2]; }
#pragma unroll
        for (int o = 1; o < 64; o <<= 1) { const float t = __shfl_up(g, o); if (lane >= o) g += t; }
        gcs[lane] = g; bts[lane] = bt;
        if (lane == 63) ((float*)(ws + WS_GL))[item] = __expf(g);
    }
    __syncthreads();
    u32x4 outA[8];
    const int ten = tid >> 7, cgp = tid & 15, rg = (tid >> 4) & 7;
    if (tid < 384) {
        f32x4 cw[4][2];
#pragma unroll
        for (int j = 0; j < 4; ++j) { const float* cp = a.conv_w + (size_t)j * 3072 + ten * 1024 + h * 128 + cgp * 8; cw[j][0] = *(const f32x4*)cp; cw[j][1] = *(const f32x4*)(cp + 4); }
        float y[8][8];
#pragma unroll
        for (int i = 0; i < 8; ++i) {
#pragma unroll
            for (int e = 0; e < 8; ++e) y[i][e] = 0.f;
#pragma unroll
            for (int j = 0; j < 4; ++j) { const u32x4 rv = raw[i + j];
                y[i][0] += cw[j][0][0] * bflo(rv.x); y[i][1] += cw[j][0][1] * bfhi(rv.x); y[i][2] += cw[j][0][2] * bflo(rv.y); y[i][3] += cw[j][0][3] * bfhi(rv.y);
                y[i][4] += cw[j][1][0] * bflo(rv.z); y[i][5] += cw[j][1][1] * bfhi(rv.z); y[i][6] += cw[j][1][2] * bflo(rv.w); y[i][7] += cw[j][1][3] * bfhi(rv.w); }
#pragma unroll
            for (int e = 0; e < 8; ++e) y[i][e] = silu_f(y[i][e]);
        }
        if (item_next >= 0) chunk_load_raw(a, item_next, raw, tid);
        const float gl = gcs[63];
        if (ten < 2) {
#pragma unroll
            for (int i = 0; i < 8; ++i) { float ss = 0.f;
#pragma unroll
                for (int e = 0; e < 8; ++e) ss += y[i][e] * y[i][e];
                ss += __shfl_xor(ss, 1); ss += __shfl_xor(ss, 2); ss += __shfl_xor(ss, 4); ss += __shfl_xor(ss, 8);
                const float sc = (1.0f / sqrtf(ss + EPS)) * (ten == 0 ? 0.08838834764831845f : 1.f);
#pragma unroll
                for (int e = 0; e < 8; ++e) y[i][e] *= sc; }
        }
        if (ten == 0) {
#pragma unroll
            for (int i = 0; i < 8; ++i) { const int row = 8 * rg + i; const float eg = __expf(gcs[row]);
                u32x4 w; w.x = pk2(y[i][0], y[i][1]); w.y = pk2(y[i][2], y[i][3]); w.z = pk2(y[i][4], y[i][5]); w.w = pk2(y[i][6], y[i][7]);
                *(LAS u32x4*)(Qn + row * 136 + cgp * 8) = w;
                outA[i].x = pk2(y[i][0] * eg, y[i][1] * eg); outA[i].y = pk2(y[i][2] * eg, y[i][3] * eg); outA[i].z = pk2(y[i][4] * eg, y[i][5] * eg); outA[i].w = pk2(y[i][6] * eg, y[i][7] * eg); }
        } else if (ten == 1) {
            float f1[8], f2[8];
#pragma unroll
            for (int i = 0; i < 8; ++i) { const int row = 8 * rg + i; const float gc = gcs[row]; f1[i] = bts[row] * __expf(gc); f2[i] = __expf(gl - gc);
                u32x4 w; w.x = pk2(y[i][0], y[i][1]); w.y = pk2(y[i][2], y[i][3]); w.z = pk2(y[i][4], y[i][5]); w.w = pk2(y[i][6], y[i][7]);
                *(LAS u32x4*)(Kn + row * 136 + cgp * 8) = w; }
#pragma unroll
            for (int e = 0; e < 8; ++e) { u32x4 w;
                w.x = pk2(y[0][e] * f1[0], y[1][e] * f1[1]); w.y = pk2(y[2][e] * f1[2], y[3][e] * f1[3]); w.z = pk2(y[4][e] * f1[4], y[5][e] * f1[5]); w.w = pk2(y[6][e] * f1[6], y[7][e] * f1[7]);
                *(LAS u32x4*)(KbgT + (cgp * 8 + e) * 72 + 8 * rg) = w;
                outA[e].x = pk2(y[0][e] * f2[0], y[1][e] * f2[1]); outA[e].y = pk2(y[2][e] * f2[2], y[3][e] * f2[3]); outA[e].z = pk2(y[4][e] * f2[4], y[5][e] * f2[5]); outA[e].w = pk2(y[6][e] * f2[6], y[7][e] * f2[7]); }
        } else {
            float f1[8];
#pragma unroll
            for (int i = 0; i < 8; ++i) f1[i] = bts[8 * rg + i];
#pragma unroll
            for (int e = 0; e < 8; ++e) { u32x4 w;
                w.x = pk2(y[0][e] * f1[0], y[1][e] * f1[1]); w.y = pk2(y[2][e] * f1[2], y[3][e] * f1[3]); w.z = pk2(y[4][e] * f1[4], y[5][e] * f1[5]); w.w = pk2(y[6][e] * f1[6], y[7][e] * f1[7]);
                *(LAS u32x4*)(VbT + (cgp * 8 + e) * 72 + 8 * rg) = w; }
        }
    }
    __syncthreads();
    if (tid < 128) {
#pragma unroll
        for (int i = 0; i < 8; ++i) *(u32x4*)(QKV + (size_t)(r0 + 8 * rg + i) * 1024 + h * 128 + cgp * 8) = outA[i];
    } else if (tid < 256) {
#pragma unroll
        for (int e = 0; e < 8; ++e) { const int k = cgp * 8 + e;
            *(u32x4*)((unsigned char*)(QKV + (size_t)2 * M * 1024 + (size_t)(r0 + (k >> 1)) * 1024 + h * 128) + (k & 1) * 128 + 16 * rg) = outA[e]; }
    }
    {
        const int mat = wid >> 2, ti = wid & 3;
        const LAS bf16_t* Bm = mat ? Qn : Kn;
        f32x4 c4[4];
#pragma unroll
        for (int tj = 0; tj < 4; ++tj) c4[tj] = (f32x4){0.f, 0.f, 0.f, 0.f};
#pragma unroll
        for (int ks = 0; ks < 4; ++ks) { const bf16x8 af = *(const LAS bf16x8*)(Kn + (ti * 16 + r16) * 136 + ks * 32 + 8 * qp);
#pragma unroll
            for (int tj = 0; tj < 4; ++tj) { const bf16x8 bf = *(const LAS bf16x8*)(Bm + (tj * 16 + r16) * 136 + ks * 32 + 8 * qp); c4[tj] = MFMA16(af, bf, c4[tj]); } }
        const int j0 = ti * 16 + 4 * qp;
        const f32x4 gj = *(const LAS f32x4*)(gcs + j0);
#pragma unroll
        for (int tj = 0; tj < 4; ++tj) { const int i = tj * 16 + r16; const float gi = gcs[i]; f32x4 v;
#pragma unroll
            for (int e = 0; e < 4; ++e) { const int j = j0 + e; const float d = __expf(fminf(gi - gj[e], 0.f)); const bool keep = mat ? (j <= i) : (j < i); v[e] = keep ? c4[tj][e] * d : 0.f; }
            if (mat == 0) { v = v * bts[i];
#pragma unroll
                for (int e = 0; e < 4; ++e) Ap[i * 68 + e * 16 + ti * 4 + qp] = v[e]; }
            else { u32x2 o; o.x = pk2(v[0], v[1]); o.y = pk2(v[2], v[3]); *(u32x2*)((bf16_t*)(ws + WS_AQK) + (size_t)item * 4096 + i * 64 + j0) = o; } }
    }
    }
    if (stage == 1 && (wid >> 2) < nvalid) {
        const int ph = lane & 3, c = 16 * (wid & 3) + (lane >> 2);
        float t[16];
#pragma unroll
        for (int m = 0; m < 16; ++m) t[m] = 0.f;
        f32x4 cf[3][4];
#define LOADROW(ii, slot) do { _Pragma("unroll") for (int m4 = 0; m4 < 4; ++m4) if (m4 * 16 < (ii) && (ii) < 64) cf[slot][m4] = *(const LAS f32x4*)(Ap + (ii) * 68 + ph * 16 + 4 * m4); } while (0)
        LOADROW(0, 0); LOADROW(1, 1); LOADROW(2, 2);
#pragma unroll
        for (int i = 0; i < 64; ++i) {
            float acc0 = 0.f, acc1 = 0.f;
#pragma unroll
            for (int m4 = 0; m4 * 16 < i; ++m4) { const f32x4 av = cf[i % 3][m4];
                acc0 += av[0] * t[4 * m4];
                if ((4 * m4 + 1) * 4 < i) acc1 += av[1] * t[4 * m4 + 1];
                if ((4 * m4 + 2) * 4 < i) acc0 += av[2] * t[4 * m4 + 2];
                if ((4 * m4 + 3) * 4 < i) acc1 += av[3] * t[4 * m4 + 3]; }
            __builtin_amdgcn_sched_barrier(0);
            LOADROW(i + 3, i % 3);
            __builtin_amdgcn_sched_barrier(0);
            float acc = acc0 + acc1;
            acc += __builtin_bit_cast(float, __builtin_amdgcn_update_dpp(0, __builtin_bit_cast(int, acc), 0xB1, 0xF, 0xF, false));
            acc += __builtin_bit_cast(float, __builtin_amdgcn_update_dpp(0, __builtin_bit_cast(int, acc), 0x4E, 0xF, 0xF, false));
            const float val = ((c == i) ? 1.f : 0.f) - acc;
            t[i >> 2] = (ph == (i & 3)) ? val : t[i >> 2];
        }
#undef LOADROW
#pragma unroll
        for (int m = 0; m < 16; ++m) Tb[(4 * m + ph) * 72 + c] = (bf16_t)f2bf(t[m]);
    }
    if (stage == 2) {
        f32x4 cu[4], cwv[4];
#pragma unroll
        for (int ct = 0; ct < 4; ++ct) { cu[ct] = (f32x4){0.f, 0.f, 0.f, 0.f}; cwv[ct] = (f32x4){0.f, 0.f, 0.f, 0.f}; }
#pragma unroll
        for (int ks = 0; ks < 2; ++ks) {
            const bf16x8 vb = *(const LAS bf16x8*)(VbT + (16 * wid + r16) * 72 + ks * 32 + 8 * qp);
            const bf16x8 kb = *(const LAS bf16x8*)(KbgT + (16 * wid + r16) * 72 + ks * 32 + 8 * qp);
#pragma unroll
            for (int ct = 0; ct < 4; ++ct) { const bf16x8 tf = *(const LAS bf16x8*)(Tb + (16 * ct + r16) * 72 + ks * 32 + 8 * qp);
                cu[ct] = MFMA16(tf, vb, cu[ct]); cwv[ct] = MFMA16(kb, tf, cwv[ct]); }
        }
#pragma unroll
        for (int ct = 0; ct < 4; ++ct) {
            u32x2 o; o.x = pk2(cu[ct][0], cu[ct][1]); o.y = pk2(cu[ct][2], cu[ct][3]);
            ((u32x2*)(ws + WS_U))[(((size_t)item * 8 + wid) * 4 + ct) * 64 + lane] = o;
            u32x2 w2; w2.x = pk2(-cwv[ct][0], -cwv[ct][1]); w2.y = pk2(-cwv[ct][2], -cwv[ct][3]);
            *(u32x2*)(QKV + (size_t)M * 1024 + (size_t)(r0 + 16 * ct + r16) * 1024 + h * 128 + 16 * wid + 4 * qp) = w2;
        }
    }
}

__device__ __forceinline__ bf16x8 ldA_perm(const LAS bf16_t* p) {
    const u32x2 lo = *(const LAS u32x2*)p, hi = *(const LAS u32x2*)(p + 16);
    u32x4 v; v.x = lo.x; v.y = lo.y; v.z = hi.x; v.w = hi.y; return __builtin_bit_cast(bf16x8, v);
}
__device__ __forceinline__ bf16x8 packB(f32x4 t0, f32x4 t1) {
    u32x4 v; v.x = pk2(t0[0], t0[1]); v.y = pk2(t0[2], t0[3]); v.z = pk2(t1[0], t1[1]); v.w = pk2(t1[2], t1[3]); return __builtin_bit_cast(bf16x8, v);
}
constexpr int SC_W = 0, SC_QG = 18432, SC_AQK = 36864, SC_KDT = 47104, SC_BUF = 67584, SC_RED = 2 * SC_BUF, SC_RSTD = SC_RED + 2048;

__device__ __forceinline__ void scan_load(const Args& a, int bh, int n, u32x4 (&stg)[7]) {
    const int tid = threadIdx.x, b = bh >> 3, h = bh & 7; const int r0 = b * SEQ + 64 * n; const int item = bh * 32 + n;
    const bf16_t* QKV = (const bf16_t*)(a.ws + WS_QKV);
    const int c = tid >> 4, k8 = tid & 15;
#pragma unroll
    for (int i = 0; i < 2; ++i) {
        stg[i] = *(const u32x4*)(QKV + (size_t)M * 1024 + (size_t)(r0 + c + 32 * i) * 1024 + h * 128 + k8 * 8);
        stg[2 + i] = *(const u32x4*)(QKV + (size_t)(r0 + c + 32 * i) * 1024 + h * 128 + k8 * 8);
        stg[4 + i] = *(const u32x4*)(QKV + (size_t)2 * M * 1024 + (size_t)(r0 + c + 32 * i) * 1024 + h * 128 + k8 * 8);
    }
    stg[6] = *(const u32x4*)((const bf16_t*)(a.ws + WS_AQK) + (size_t)item * 4096 + tid * 8);
}
__device__ __forceinline__ void st_perm(LAS unsigned char* rowp  , int a4  , u32x4 v) {
    const int p0 = (a4 & 1) * 16 + (a4 >> 1) * 4;
    u32x2 lo; lo.x = v.x; lo.y = v.y; u32x2 hi; hi.x = v.z; hi.y = v.w;
    *(LAS u32x2*)(rowp + p0 * 2) = lo; *(LAS u32x2*)(rowp + (p0 + 8) * 2) = hi;
}
__device__ __forceinline__ void scan_store(LAS unsigned char* buf, const u32x4 (&stg)[7]) {
    const int tid = threadIdx.x; const int c = tid >> 4, k8 = tid & 15;
#pragma unroll
    for (int i = 0; i < 2; ++i) {
        st_perm(buf + SC_W + ((c + 32 * i) * 144 + (k8 >> 2) * 32) * 2, k8 & 3, stg[i]);
        st_perm(buf + SC_QG + ((c + 32 * i) * 144 + (k8 >> 2) * 32) * 2, k8 & 3, stg[2 + i]);
        const int line = c + 32 * i, k = line * 2 + (k8 >> 3), c8 = k8 & 7;
        st_perm(buf + SC_KDT + (k * 80 + (c8 >> 2) * 32) * 2, c8 & 3, stg[4 + i]);
    }
    { const int cc = tid >> 3, j8 = tid & 7; st_perm(buf + SC_AQK + (cc * 80 + (j8 >> 2) * 32) * 2, j8 & 3, stg[6]); }
}
__device__ __forceinline__ float dpp_add16(float v) {
    v += __builtin_bit_cast(float, __builtin_amdgcn_update_dpp(0, __builtin_bit_cast(int, v), 0xB1, 0xF, 0xF, false));
    v += __builtin_bit_cast(float, __builtin_amdgcn_update_dpp(0, __builtin_bit_cast(int, v), 0x4E, 0xF, 0xF, false));
    v += __builtin_bit_cast(float, __builtin_amdgcn_update_dpp(0, __builtin_bit_cast(int, v), 0x124, 0xF, 0xF, false));
    v += __builtin_bit_cast(float, __builtin_amdgcn_update_dpp(0, __builtin_bit_cast(int, v), 0x128, 0xF, 0xF, false));
    return v;
}
#define LDA128(p) (*(const LAS bf16x8*)(p))

struct ScanSet { u32x4 stg[7]; u32x2 u[4]; float gl; };
__device__ __forceinline__ void scan_load_set(const Args& a, int bh, int n, ScanSet& t, int lane, int wid) {
    scan_load(a, bh, n, t.stg);
#pragma unroll
    for (int ct = 0; ct < 4; ++ct) t.u[ct] = ((const u32x2*)(a.ws + WS_U))[(((size_t)(bh * 32 + n) * 8 + wid) * 4 + ct) * 64 + lane];
    t.gl = ((const float*)(a.ws + WS_GL))[bh * 32 + n];
}
__device__ __forceinline__ void scan_step(const Args& a, LAS unsigned char* lds, int bh, int n, f32x4 (&S)[8], ScanSet& T, float dnw, int lane, int wid, int r16, int qp, bool accum) {
    const int tid = threadIdx.x, b = bh >> 3, h = bh & 7;
    bf16_t* Y = (bf16_t*)a.out;
    LAS unsigned char* buf = lds + (n & 1) * SC_BUF;
    const float gl = T.gl;
    f32x4 vn[4], o[4];
#pragma unroll
    for (int ct = 0; ct < 4; ++ct) { const u32x2 uu = T.u[ct];
        vn[ct] = (f32x4){bflo(uu.x), bfhi(uu.x), bflo(uu.y), bfhi(uu.y)}; o[ct] = (f32x4){0.f, 0.f, 0.f, 0.f}; }
    __builtin_amdgcn_sched_barrier(0);
    if (n + 1 < 32) scan_load_set(a, bh, n + 1, T, lane, wid);
    __builtin_amdgcn_sched_barrier(0);
    bf16x8 sb[4];
#pragma unroll
    for (int s = 0; s < 4; ++s) sb[s] = packB(S[2 * s], S[2 * s + 1]);
    const LAS bf16_t* Wb = (const LAS bf16_t*)(buf + SC_W); const LAS bf16_t* QGb = (const LAS bf16_t*)(buf + SC_QG);
    const LAS bf16_t* AQb = (const LAS bf16_t*)(buf + SC_AQK); const LAS bf16_t* KDb = (const LAS bf16_t*)(buf + SC_KDT);
    bf16x8 fa[8], fb[8];
#define SB() __builtin_amdgcn_sched_barrier(0)
#define LD_VO2(f, ca, cb, sh) do { _Pragma("unroll") for (int s_ = 0; s_ < 2; ++s_) { \
        f[4 * s_ + 0] = LDA128(Wb + (16 * (ca) + r16) * 144 + 32 * ((sh) + s_) + 8 * qp); f[4 * s_ + 1] = LDA128(Wb + (16 * (cb) + r16) * 144 + 32 * ((sh) + s_) + 8 * qp); \
        f[4 * s_ + 2] = LDA128(QGb + (16 * (ca) + r16) * 144 + 32 * ((sh) + s_) + 8 * qp); f[4 * s_ + 3] = LDA128(QGb + (16 * (cb) + r16) * 144 + 32 * ((sh) + s_) + 8 * qp); } } while (0)
#define MM_VO2(f, ca, cb, sh) do { _Pragma("unroll") for (int s_ = 0; s_ < 2; ++s_) { \
        vn[ca] = MFMA16(f[4 * s_ + 0], sb[(sh) + s_], vn[ca]); vn[cb] = MFMA16(f[4 * s_ + 1], sb[(sh) + s_], vn[cb]); \
        o[ca] = MFMA16(f[4 * s_ + 2], sb[(sh) + s_], o[ca]); o[cb] = MFMA16(f[4 * s_ + 3], sb[(sh) + s_], o[cb]); } } while (0)
#define LD_AQ(f) do { _Pragma("unroll") for (int c_ = 0; c_ < 4; ++c_) { f[c_] = LDA128(AQb + (16 * c_ + r16) * 80 + 8 * qp); f[4 + c_] = LDA128(AQb + (16 * c_ + r16) * 80 + 32 + 8 * qp); } } while (0)
#define MM_AQ(f) do { _Pragma("unroll") for (int c_ = 0; c_ < 4; ++c_) o[c_] = MFMA16(f[c_], vb[0], o[c_]); _Pragma("unroll") for (int c_ = 0; c_ < 4; ++c_) o[c_] = MFMA16(f[4 + c_], vb[1], o[c_]); } while (0)
#define LD_KD(f, k0) do { _Pragma("unroll") for (int c_ = 0; c_ < 4; ++c_) { f[c_] = LDA128(KDb + (16 * ((k0) + c_) + r16) * 80 + 8 * qp); f[4 + c_] = LDA128(KDb + (16 * ((k0) + c_) + r16) * 80 + 32 + 8 * qp); } } while (0)
#define MM_KD(f, k0) do { _Pragma("unroll") for (int c_ = 0; c_ < 4; ++c_) S[(k0) + c_] = MFMA16(f[c_], vb[0], S[(k0) + c_] * gl); _Pragma("unroll") for (int c_ = 0; c_ < 4; ++c_) S[(k0) + c_] = MFMA16(f[4 + c_], vb[1], S[(k0) + c_]); } while (0)
    LD_VO2(fa, 0, 1, 0); LD_VO2(fb, 0, 1, 2); SB();
    MM_VO2(fa, 0, 1, 0); SB(); LD_VO2(fa, 2, 3, 0); SB();
    MM_VO2(fb, 0, 1, 2); SB(); LD_VO2(fb, 2, 3, 2); SB();
    MM_VO2(fa, 2, 3, 0); SB(); LD_AQ(fa); SB();
    MM_VO2(fb, 2, 3, 2); SB(); LD_KD(fb, 0); SB();
    bf16x8 vb[2];
#pragma unroll
    for (int s = 0; s < 2; ++s) vb[s] = packB(vn[2 * s], vn[2 * s + 1]);
    MM_AQ(fa); SB(); LD_KD(fa, 4); SB();
    MM_KD(fb, 0); SB();
    MM_KD(fa, 4); SB();
#undef SB
#undef LD_VO2
#undef MM_VO2
#undef LD_AQ
#undef MM_AQ
#undef LD_KD
#undef MM_KD
    {
        float v16[16];
#pragma unroll
        for (int ct = 0; ct < 4; ++ct)
#pragma unroll
            for (int e = 0; e < 4; ++e) v16[4 * ct + e] = o[ct][e] * o[ct][e];
#define DPPF(x, ctrl) __builtin_bit_cast(float, __builtin_amdgcn_update_dpp(0, __builtin_bit_cast(int, (x)), (ctrl), 0xF, 0xF, false))
        float w8[8], w4[4], w2[2];
        const bool b3 = r16 & 8, b2 = r16 & 4, b1 = r16 & 2, b0 = r16 & 1;
#pragma unroll
        for (int j = 0; j < 8; ++j) { const float keep = b3 ? v16[j + 8] : v16[j], send = b3 ? v16[j] : v16[j + 8]; w8[j] = keep + DPPF(send, 0x128); }
#pragma unroll
        for (int j = 0; j < 4; ++j) { const float keep = b2 ? w8[j + 4] : w8[j], send = b2 ? w8[j] : w8[j + 4]; w4[j] = keep + DPPF(send, 0x141); }
#pragma unroll
        for (int j = 0; j < 2; ++j) { const float keep = b1 ? w4[j + 2] : w4[j], send = b1 ? w4[j] : w4[j + 2]; w2[j] = keep + DPPF(send, 0x1B); }
        const float keep = b0 ? w2[1] : w2[0], send = b0 ? w2[0] : w2[1];
        const float tot = keep + DPPF(send, 0xB1);
#undef DPPF
        if (accum) atomicAdd((float*)(a.ws + WS_SUMSQ) + (size_t)(b * SEQ + 64 * n + 16 * (r16 >> 2) + 4 * qp + (r16 & 3)) * 8 + h, tot);
    }
    if (n + 1 < 32) scan_store(lds + ((n + 1) & 1) * SC_BUF, T.stg);
    const int rowb = b * SEQ + 64 * n;
#pragma unroll
    for (int ct = 0; ct < 4; ++ct)
#pragma unroll
        for (int e = 0; e < 4; ++e) Y[(size_t)(rowb + 16 * ct + 4 * qp + e) * 2048 + 512 + h * 128 + 16 * wid + r16] = (bf16_t)f2bf(o[ct][e] * dnw);
    __syncthreads();
}

__device__ __forceinline__ void scan_bh(const Args& a, LAS unsigned char* lds, int bh, bool accum = true) {
    int tid_ = threadIdx.x; asm volatile("" : "+v"(tid_));
    const int tid = tid_, lane = tid & 63, wid = tid >> 6, r16 = lane & 15, qp = lane >> 4;
    const float dnw = a.dn_w[16 * wid + r16];
    f32x4 S[8];
#pragma unroll
    for (int kt = 0; kt < 8; ++kt) S[kt] = (f32x4){0.f, 0.f, 0.f, 0.f};
    ScanSet T;
    __syncthreads();
    scan_load_set(a, bh, 0, T, lane, wid);
    scan_store(lds, T.stg);
    __syncthreads();
#pragma unroll 1
    for (int n = 0; n < 32; ++n) scan_step(a, lds, bh, n, S, T, dnw, lane, wid, r16, qp, accum);
}

__device__ __forceinline__ void attn_item(const Args& a, LAS unsigned char* lds, int item) {
    int tid_ = threadIdx.x; asm volatile("" : "+v"(tid_));
    const int tid = tid_, lane = tid & 63, wid = tid >> 6, r16 = lane & 15, qp = lane >> 4;
    const int qt = item & 15, head = (item >> 4) & 3, b = item >> 6;
    LAS bf16_t* Ks = (LAS bf16_t*)lds;
    LAS bf16_t* Vt = (LAS bf16_t*)(lds + 69632);
    const bf16_t* KM = (const bf16_t*)(a.ws + WS_KMEM); const bf16_t* VM = (const bf16_t*)(a.ws + WS_VMEMT); const bf16_t* QM = (const bf16_t*)(a.ws + WS_QM);
    __syncthreads();
#pragma unroll
    for (int i = 0; i < 8; ++i) { const int p = tid + 512 * i;
        { const int key = p >> 4, d8 = p & 15; *(LAS u32x4*)(Ks + key * 136 + d8 * 8) = *(const u32x4*)(KM + (size_t)(b * 256 + key) * 512 + head * 128 + d8 * 8); }
        { const int d = p >> 5, k8 = p & 31; *(LAS u32x4*)(Vt + d * 264 + k8 * 8) = *(const u32x4*)(VM + (size_t)(head * 128 + d) * 2048 + b * 256 + k8 * 8); } }
    const int qrow = b * SEQ + qt * 128 + 16 * wid + r16;
    bf16x8 qf[4];
#pragma unroll
    for (int s = 0; s < 4; ++s) qf[s] = *(const bf16x8*)(QM + (size_t)qrow * 512 + head * 128 + 32 * s + 8 * qp);
    __syncthreads();
    f32x4 sc[16];
#pragma unroll
    for (int kt = 0; kt < 16; ++kt) { sc[kt] = (f32x4){0.f, 0.f, 0.f, 0.f};
#pragma unroll
        for (int s = 0; s < 4; ++s) sc[kt] = MFMA16(*(const LAS bf16x8*)(Ks + (16 * kt + r16) * 136 + 32 * s + 8 * qp), qf[s], sc[kt]); }
    float mx = -3.0e38f;
#pragma unroll
    for (int kt = 0; kt < 16; ++kt) mx = fmaxf(fmaxf(fmaxf(sc[kt][0], sc[kt][1]), fmaxf(sc[kt][2], sc[kt][3])), mx);
    mx = fmaxf(mx, __shfl_xor(mx, 16)); mx = fmaxf(mx, __shfl_xor(mx, 32));
    const float scl = 0.08838834764831845f; float sum = 0.f;
#pragma unroll
    for (int kt = 0; kt < 16; ++kt)
#pragma unroll
        for (int e = 0; e < 4; ++e) { const float p = __expf((sc[kt][e] - mx) * scl); sc[kt][e] = p; sum += p; }
    sum += __shfl_xor(sum, 16); sum += __shfl_xor(sum, 32);
    f32x4 o[8];
#pragma unroll
    for (int dt = 0; dt < 8; ++dt) o[dt] = (f32x4){0.f, 0.f, 0.f, 0.f};
#pragma unroll
    for (int s = 0; s < 8; ++s) { const bf16x8 pb = packB(sc[2 * s], sc[2 * s + 1]);
#pragma unroll
        for (int dt = 0; dt < 8; ++dt) o[dt] = MFMA16(ldA_perm(Vt + (16 * dt + r16) * 264 + 32 * s + 4 * qp), pb, o[dt]); }
    const float inv = 1.f / sum;
    bf16_t* Y = (bf16_t*)a.out;
#pragma unroll
    for (int dt = 0; dt < 8; ++dt) { u32x2 w; w.x = pk2(o[dt][0] * inv, o[dt][1] * inv); w.y = pk2(o[dt][2] * inv, o[dt][3] * inv);
        *(u32x2*)(Y + (size_t)qrow * 2048 + 1536 + head * 128 + 16 * dt + 4 * qp) = w; }
}

__device__ __forceinline__ void pool_item(const Args& a, LAS unsigned char* lds, int item) {
    int tid_ = threadIdx.x; asm volatile("" : "+v"(tid_));
    const int tid = tid_, lane = tid & 63, wid = tid >> 6, r16 = lane & 15, qp = lane >> 4;
    const int g = item & 3, tt = (item >> 2) & 31, b = item >> 7;
    LAS bf16_t* Xs = (LAS bf16_t*)lds;
    LAS bf16_t* Ps = (LAS bf16_t*)(lds + 20480);
    const bf16_t* XA = (const bf16_t*)(a.ws + WS_XA);
    const int t0 = tt * 64;
    __syncthreads();
    for (int p = tid; p < 1280; p += 512) { const int row = p >> 4, c8 = p & 15; const int t = t0 - 16 + row; u32x4 v = (u32x4){0u, 0u, 0u, 0u};
        if (t >= 0) v = *(const u32x4*)(XA + (size_t)(b * SEQ + t) * 512 + g * 128 + c8 * 8);
        *(LAS u32x4*)(Xs + row * 128 + c8 * 8) = v; }
    __syncthreads();
    {
        const int c = tid & 127, rgp = tid >> 7, w = 2 << g; float sum = 0.f;
        for (int j = 1; j < w; ++j) sum += bflo((unsigned)Xs[(16 + 16 * rgp - j) * 128 + c]);
        const float invw = 1.f / (float)w;
#pragma unroll 4
        for (int i = 0; i < 16; ++i) { const int row = 16 * rgp + i; const float xv = bflo((unsigned)Xs[(16 + row) * 128 + c]); sum += xv;
            const int t = t0 + row; const float mean = (t + 1 >= w) ? sum * invw : sum / (float)(t + 1);
            Ps[row * 136 + c] = (bf16_t)f2bf(mean - xv);
            sum -= bflo((unsigned)Xs[(16 + row - (w - 1)) * 128 + c]); }
    }
    __syncthreads();
    const bf16_t* WX = (const bf16_t*)(a.ws + WS_WMIX) + g * 16384;
    f32x4 acc[4];
#pragma unroll
    for (int t4 = 0; t4 < 4; ++t4) acc[t4] = (f32x4){0.f, 0.f, 0.f, 0.f};
#pragma unroll
    for (int s = 0; s < 4; ++s) { const bf16x8 af = *(const bf16x8*)(WX + (16 * wid + r16) * 128 + 32 * s + 8 * qp);
#pragma unroll
        for (int t4 = 0; t4 < 4; ++t4) acc[t4] = MFMA16(af, *(const LAS bf16x8*)(Ps + (16 * t4 + r16) * 136 + 32 * s + 8 * qp), acc[t4]); }
    const f32x4 psc = *(const f32x4*)(a.pool_scale + g * 128 + 16 * wid + 4 * qp);
    bf16_t* Y = (bf16_t*)a.out;
#pragma unroll
    for (int t4 = 0; t4 < 4; ++t4) { u32x2 w2; w2.x = pk2(acc[t4][0] * psc[0], acc[t4][1] * psc[1]); w2.y = pk2(acc[t4][2] * psc[2], acc[t4][3] * psc[3]);
        *(u32x2*)(Y + (size_t)(b * SEQ + t0 + 16 * t4 + r16) * 2048 + g * 128 + 16 * wid + 4 * qp) = w2; }
}

#ifndef REP_P0
#define REP_P0 1
#endif
#ifndef REP_P1
#define REP_P1 1
#endif
#ifndef REP_P3
#define REP_P3 1
#endif
#ifndef REP_P5
#define REP_P5 1
#endif
#define P0_BODY if (IN(0)) p0_prologue(a, lds);
#define P1_BODY \
    if (IN(1)) { \
        {   pg8::Gemm g{(const bf16_t*)(ws + WS_H), (const bf16_t*)(ws + WS_WT), 1024, 1024, 1024}; pg8::StaticOrder S; S.init(M, 4096, G, bx); \
            pg8::EpiStage1 E{(bf16_t*)(ws + WS_XA), (bf16_t*)(ws + WS_QM), (bf16_t*)(ws + WS_QKV), (bf16_t*)(ws + WS_HALO)}; \
            pg8::gemm_phase(lds, g, S, E); } \
    }
#ifndef REP_SCAN
#define REP_SCAN 1
#endif
#ifndef REP_ATTN
#define REP_ATTN 1
#endif
#ifndef REP_POOL
#define REP_POOL 1
#endif
#define P3_BODY \
    if (IN(3)) { \
        unsigned* kvcnt = (unsigned*)(ws + WS_CTL) + 8192; \
        if (G >= 128) { \
            if (bx < 64) { for (int rep = 0; rep < REP_SCAN; ++rep) scan_bh(a, lds, bx, rep == 0); } \
            else { const int c = bx - 64, GG = G - 64; \
                if (c < 32) { \
                    pg8::OneUnit S1; \
                    if (c < 16) { S1.u.pm = c >> 1; S1.u.pn = c & 1; pg8::Gemm g{(const bf16_t*)(ws + WS_MEMN), (const bf16_t*)(ws + WS_WKV), 1024, 1024, 1024}; pg8::EpiPlain E{(bf16_t*)(ws + WS_KMEM), 512}; pg8::gemm_phase(lds, g, S1, E); } \
                    else { S1.u.pm = (c - 16) >> 3; S1.u.pn = (c - 16) & 7; pg8::Gemm g{(const bf16_t*)(ws + WS_WKV) + (size_t)512 * 1024, (const bf16_t*)(ws + WS_MEMN), 1024, 1024, 1024}; pg8::EpiPlain E{(bf16_t*)(ws + WS_VMEMT), 2048}; pg8::gemm_phase(lds, g, S1, E); } \
                    asm volatile("s_waitcnt vmcnt(0)" ::: "memory"); __syncthreads(); \
                    if (tid == 0) { __builtin_amdgcn_fence(__ATOMIC_RELEASE, "agent"); asm volatile("s_waitcnt vmcnt(0)" ::: "memory"); __hip_atomic_fetch_add(kvcnt, 1u, __ATOMIC_RELAXED, __HIP_MEMORY_SCOPE_AGENT); } \
                } \
                bool kv_ok = false; \
                for (int it = c; it < 1024 * REP_POOL + 512 * REP_ATTN; it += GG) { \
                    if (it < 1024 * REP_POOL) pool_item(a, lds, it & 1023); \
                    else { \
                        if (!kv_ok) { if (tid == 0) { unsigned sp = 0; while (__hip_atomic_load(kvcnt, __ATOMIC_RELAXED, __HIP_MEMORY_SCOPE_AGENT) < 32u) { __builtin_amdgcn_s_sleep(2); if (++sp > (1u << 20)) break; } \
                                __builtin_amdgcn_fence(__ATOMIC_ACQUIRE, "agent"); asm volatile("s_waitcnt vmcnt(0)" ::: "memory"); } __syncthreads(); kv_ok = true; } \
                        attn_item(a, lds, (it - 1024 * REP_POOL) & 511); } } \
                late_transposes(a, lds, c, GG); } \
        } else { \
            for (int it = bx; it < 32; it += G) { pg8::OneUnit S1; \
                    if (it < 16) { S1.u.pm = it >> 1; S1.u.pn = it & 1; pg8::Gemm g{(const bf16_t*)(ws + WS_MEMN), (const bf16_t*)(ws + WS_WKV), 1024, 1024, 1024}; pg8::EpiPlain E{(bf16_t*)(ws + WS_KMEM), 512}; pg8::gemm_phase(lds, g, S1, E); } \
                    else { S1.u.pm = (it - 16) >> 3; S1.u.pn = (it - 16) & 7; pg8::Gemm g{(const bf16_t*)(ws + WS_WKV) + (size_t)512 * 1024, (const bf16_t*)(ws + WS_MEMN), 1024, 1024, 1024}; pg8::EpiPlain E{(bf16_t*)(ws + WS_VMEMT), 2048}; pg8::gemm_phase(lds, g, S1, E); } } \
            xcd_barrier(xbar); \
            for (int it = bx; it < 64 + 512 + 1024; it += G) { if (it < 64) scan_bh(a, lds, it); else if (it < 576) attn_item(a, lds, it - 64); else pool_item(a, lds, it - 576); } \
            late_transposes(a, lds, bx, G); \
        } \
    }
#define P5_BODY \
    if (IN(5)) { \
        pg8::StaticOrder SO; SO.init(M, 1024, G, bx); \
        pg8::OneUnit S1; \
        if (SO.next(0, S1.u)) { \
            bf16_t* Y = (bf16_t*)(ws + WS_Y); const bf16_t* YC = (const bf16_t*)a.out; const bf16_t* GT = (const bf16_t*)(ws + WS_GATE); \
            {   pg8::Gemm g{YC, (const bf16_t*)(ws + WS_WP), 2048, 512, 512}; pg8::EpiProj<0> E{GT, Y}; pg8::gemm_phase(lds, g, S1, E); } \
            {   pg8::Gemm g{YC + 512, (const bf16_t*)(ws + WS_WD), 2048, 1024, 1024}; pg8::EpiProj<1> E{GT, Y}; pg8::gemm_phase(lds, g, S1, E); } \
            {   pg8::Gemm g{YC + 1536, (const bf16_t*)(ws + WS_WM), 2048, 512, 512}; pg8::EpiProj<2> E{GT, Y}; pg8::gemm_phase(lds, g, S1, E); } \
        } \
    }
__global__ void __launch_bounds__(512, 2) hybrid_fwd(Args a) {
    extern __shared__ __attribute__((aligned(16))) unsigned char lds_raw[];
    LAS unsigned char* lds = (LAS unsigned char*)lds_raw;
    const int G = gridDim.x, bx = blockIdx.x, tid = threadIdx.x;
    unsigned char* ws = a.ws;
    const int lo = a.ph_lo, hi = a.ph_hi;
    volatile LAS unsigned* xst = (volatile LAS unsigned*)(lds + LDS_BYTES - 16);
    if (tid < 4) xst[tid] = 0u;
    __syncthreads();
    XcdBarrier xbar; xbar.bar = (unsigned*)(ws + WS_CTL); xbar.x = 0; xbar.st = xst;
    if (hi - lo > 1) xbar = xcd_barrier_post((unsigned*)(ws + WS_CTL), xst);
    if (lo == 0x7fffffff) cg::this_grid().sync();
#define IN(k) (lo <= (k) && (k) < hi)
#define SEAM(k) do { if (IN(k) && IN((k) + 1)) xcd_barrier(xbar); } while (0)
    P0_BODY
#if REP_P0 > 1
    xcd_barrier(xbar);
    P0_BODY
#endif
    SEAM(0);
#ifndef REP_P12
#define REP_P12 1
#endif
    for (int rep12 = 0; rep12 < REP_P12; ++rep12) {
    if (rep12) xcd_barrier(xbar);
    P1_BODY
#if REP_P1 > 1
    xcd_barrier(xbar);
    P1_BODY
#endif
    SEAM(1);
#ifndef NO_P2
    if (IN(2)) { u32x4 raw[11]; float gpre = 0.f, bpre = 0.f; if (bx < 2048) { chunk_load_raw(a, bx, raw, tid); if (tid < 64) { const int n2 = bx & 31, h2 = (bx >> 5) & 7, b2 = bx >> 8; const int r2 = b2 * SEQ + 64 * n2; gpre = ((const float*)(ws + WS_G))[(size_t)(r2 + tid) * 8 + h2]; bpre = ((const float*)(ws + WS_BETA))[(size_t)(r2 + tid) * 8 + h2]; } }
#pragma unroll 1
        for (int it0 = bx; it0 < 2048; it0 += 2 * G) {
            const int it1 = it0 + G; const int nvalid = (it1 < 2048) ? 2 : 1;
#pragma unroll 1
            for (int ms = 0; ms < 5; ++ms) {
                const int st = (ms < 2) ? 0 : (ms == 2 ? 1 : 2); const int st_set = (ms == 1 || ms == 4) ? 1 : 0;
                if (st != 1 && st_set == 1 && nvalid < 2) continue;
                const int itc = st_set ? it1 : it0;
                chunk_prep_item(a, lds, itc, raw, (itc + G < 2048) ? itc + G : -1, gpre, bpre, st_set, st, nvalid);
            }
        } }
#endif
    }
    SEAM(2);
    P3_BODY
#if REP_P3 > 1
    xcd_barrier(xbar);
    P3_BODY
#endif
    SEAM(3);
    if (IN(4)) {
        {   pg8::Gemm g{(const bf16_t*)(ws + WS_H), (const bf16_t*)(ws + WS_WT) + (size_t)4096 * 1024, 1024, 1024, 1024}; pg8::StaticOrder S; S.init(M, 2048, G, bx);
            pg8::EpiZ E{(bf16_t*)a.out, (const float*)(ws + WS_SUMSQ)}; pg8::gemm_phase(lds, g, S, E); }
        {   pg8::Gemm g{(const bf16_t*)(ws + WS_H), (const bf16_t*)(ws + WS_WT) + (size_t)6144 * 1024, 1024, 1024, 1024}; pg8::StaticOrder S; S.init(M, 3072, G, bx);
            pg8::EpiGate E{(bf16_t*)(ws + WS_GATE)}; pg8::gemm_phase(lds, g, S, E); }
    }
    SEAM(4);
    P5_BODY
#if REP_P5 > 1
    xcd_barrier(xbar);
    P5_BODY
#endif
    SEAM(5);
    if (IN(6)) {
        pg8::Gemm g{(const bf16_t*)(ws + WS_Y), (const bf16_t*)(ws + WS_WOUT), 1024, 1024, 1024}; pg8::StaticOrder S; S.init(M, 1024, G, bx);
        pg8::EpiOutNorm E{a.out, a.x, a.post_w, (float*)(ws + WS_ROWSS), (unsigned*)(ws + WS_CTL) + 4096};
        pg8::gemm_phase(lds, g, S, E);
    }
#undef IN
#undef SEAM
}

extern "C" void kernel_launch(void* const* d_in, const int* in_sizes, int n_in, void* d_out, int out_size, void* d_ws, size_t ws_size, hipStream_t stream) {
    static int grid = 0;
    if (grid == 0) {
        if (n_in != 17 || out_size != M * DM || ws_size < WS_END) { fprintf(stderr, "kernel_launch: unexpected shapes (n_in %d out %d ws %zu)\n", n_in, out_size, ws_size); grid = -1; return; }
        int dev = 0, cus = 0, per_cu = 0;
        hipGetDevice(&dev); hipDeviceGetAttribute(&cus, hipDeviceAttributeMultiprocessorCount, dev);
        if (hipFuncSetAttribute((const void*)hybrid_fwd, hipFuncAttributeMaxDynamicSharedMemorySize, LDS_BYTES) != hipSuccess) { fprintf(stderr, "kernel_launch: hipFuncSetAttribute failed\n"); grid = -1; return; }
        if (hipOccupancyMaxActiveBlocksPerMultiprocessor(&per_cu, (const void*)hybrid_fwd, 512, LDS_BYTES) != hipSuccess || per_cu < 1) { fprintf(stderr, "kernel_launch: occupancy query gives %d\n", per_cu); per_cu = 1; }
        (void)hipGetLastError();
        grid = cus * 1;
        if (grid > 256) grid = 256;
    }
    if (grid < 0) return;
    Args a{};
    a.x = (const float*)d_in[0]; a.mem = (const float*)d_in[1]; a.pre_w = (const float*)d_in[2]; a.mem_w = (const float*)d_in[3]; a.w_in = (const float*)d_in[4];
    a.conv_w = (const float*)d_in[5]; a.a_log = (const float*)d_in[6]; a.dt_bias = (const float*)d_in[7]; a.dn_w = (const float*)d_in[8]; a.mix_w = (const float*)d_in[9];
    a.pool_scale = (const float*)d_in[10]; a.w_kv = (const float*)d_in[11]; a.w_pp = (const float*)d_in[12]; a.w_pd = (const float*)d_in[13]; a.w_pm = (const float*)d_in[14];
    a.w_out = (const float*)d_in[15]; a.post_w = (const float*)d_in[16];
    a.out = (float*)d_out; a.ws = (unsigned char*)d_ws;
#if MK_PER_PHASE
    for (int p = 0; p < 7; ++p) { a.ph_lo = p; a.ph_hi = p + 1; hipLaunchKernelGGL(hybrid_fwd, dim3(grid), dim3(512), LDS_BYTES, stream, a); }
#else
    a.ph_lo = 0; a.ph_hi = 7;
    if (hipMemsetAsync((char*)d_ws + WS_CTL, 0, 65536, stream) != hipSuccess) { fprintf(stderr, "kernel_launch: memset of the barrier words failed\n"); return; }
    void* args[] = {&a};
    hipError_t e = hipLaunchCooperativeKernel((const void*)hybrid_fwd, dim3(grid), dim3(512), args, LDS_BYTES, stream);
    if (e != hipSuccess) fprintf(stderr, "kernel_launch: cooperative launch failed: %s (grid %d)\n", hipGetErrorString(e), grid);
#endif
}
```

```cpp
#include <hip/hip_runtime.h>
#include <hip/hip_cooperative_groups.h>
#include <cstdio>
#include <cstdint>
namespace cg = cooperative_groups;

#ifndef MK_PER_PHASE
#define MK_PER_PHASE 0
#endif

#define LAS __attribute__((address_space(3)))
typedef unsigned short bf16_t;
typedef short bf16x8 __attribute__((ext_vector_type(8)));
typedef float f32x4 __attribute__((ext_vector_type(4)));
typedef unsigned u32x4 __attribute__((ext_vector_type(4)));
typedef unsigned u32x2 __attribute__((ext_vector_type(2)));

constexpr int DM = 1024, NB = 8, SEQ = 2048, M = NB * SEQ, INW = 9232, MEML = 256;
constexpr float EPS = 1e-6f;
constexpr size_t MiB = 1u << 20;
constexpr size_t WS_WT = 0;
constexpr size_t WS_WKV = 18 * MiB;
constexpr size_t WS_WP = 20 * MiB;
constexpr size_t WS_WD = 21 * MiB;
constexpr size_t WS_WM = 23 * MiB;
constexpr size_t WS_WOUT = 24 * MiB;
constexpr size_t WS_WMIX = 26 * MiB;
constexpr size_t WS_G = 26 * MiB + 256 * 1024;
constexpr size_t WS_BETA = WS_G + 512 * 1024;
constexpr size_t WS_ROWSS = WS_BETA + 512 * 1024;
constexpr size_t WS_GL = WS_ROWSS + 64 * 1024;
constexpr size_t WS_SUMSQ = 27 * MiB + 384 * 1024;
constexpr size_t WS_H = 28 * MiB;
constexpr size_t WS_MEMN = 60 * MiB;
constexpr size_t WS_KMEM = 64 * MiB;
constexpr size_t WS_VMEMT = 66 * MiB;
constexpr size_t WS_XA = 68 * MiB;
constexpr size_t WS_QM = 84 * MiB;
constexpr size_t WS_QKV = 100 * MiB;
constexpr size_t WS_HALO = 196 * MiB;
constexpr size_t WS_U = 201 * MiB;
constexpr size_t WS_AQK = 233 * MiB;
constexpr size_t WS_CTL = 250 * MiB;
constexpr size_t WS_END = 251 * MiB;
constexpr size_t WS_Y = WS_XA;
constexpr size_t WS_GATE = WS_QKV;
constexpr int LDS_BYTES = 147456;

__device__ __forceinline__ unsigned f2bf(float f) { unsigned u = __float_as_uint(f); return (u + 0x7fffu + ((u >> 16) & 1u)) >> 16; }
typedef __bf16 bf16x2_t __attribute__((ext_vector_type(2)));
typedef float f32x2_t __attribute__((ext_vector_type(2)));
__device__ __forceinline__ unsigned pk2(float lo, float hi) { f32x2_t v = {lo, hi}; bf16x2_t b = __builtin_convertvector(v, bf16x2_t); return __builtin_bit_cast(unsigned, b); }
__device__ __forceinline__ float bflo(unsigned u) { return __uint_as_float(u << 16); }
__device__ __forceinline__ float bfhi(unsigned u) { return __uint_as_float(u & 0xffff0000u); }
__device__ __forceinline__ unsigned cvt_pk_bf16(float lo, float hi) { unsigned r; asm volatile("v_cvt_pk_bf16_f32 %0, %1, %2" : "=v"(r) : "v"(lo), "v"(hi)); return r; }
__device__ __forceinline__ float silu_f(float z) { return z * __builtin_amdgcn_rcpf(1.f + __expf(-z)); }
__device__ __forceinline__ float sigm_f(float z) { return __builtin_amdgcn_rcpf(1.f + __expf(-z)); }
#define LDS_WAIT() asm volatile("s_waitcnt lgkmcnt(0)" ::: "memory")
#define MFMA16(a, b, c) __builtin_amdgcn_mfma_f32_16x16x32_bf16((a), (b), (c), 0, 0, 0)

namespace pg8 {
constexpr int BM = 256, BK = 64, HALF = 128, HTB = HALF * BK * 2, STAGE_BYTES = 8 * HTB, NXCD = 8, WGM = 4;
__host__ __device__ __forceinline__ int lds_byte(int r, int c) { const int st = (r >> 4) * 2 + (c >> 5), rr = r & 15, cc = c & 31, ob = rr * 64 + cc * 2; return st * 1024 + (ob ^ (((ob >> 9) & 1) << 5)); }
__host__ __device__ __forceinline__ void stage_rc(int b, int& R, int& C) { const int st = b / 1024, sb = b % 1024, swz = sb ^ (((sb >> 9) & 1) << 5); R = (st >> 1) * 16 + swz / 64; C = (st & 1) * 32 + (swz % 64) / 2; }
__host__ __device__ __forceinline__ int perm32(int rho) { const int n = rho >> 4, i = rho & 15; return 8 * (i >> 2) + 4 * n + (i & 3); }
struct Unit { int pm, pn; };
struct Gemm { const bf16_t* A; const bf16_t* Bt; int lda, ldb, K; };
struct StaticOrder {
    int nM, nN, nwg, G, c;
    __device__ void init(int Mr, int Nc, int G_, int c_) { nM = Mr / BM; nN = Nc / BM; nwg = nM * nN; G = G_; c = c_; }
    __device__ bool next(int i, Unit& u) const {
        const long L = (long)i * G + c; if (L >= nwg) return false;
        int wgid = (int)L; { const int q = nwg / NXCD, r = nwg % NXCD, xcd = wgid % NXCD, off = wgid / NXCD; wgid = (xcd < r ? xcd * (q + 1) : r * (q + 1) + (xcd - r) * q) + off; }
        const int nig = WGM * nN, gid = wgid / nig, fm = gid * WGM, gsz = (nM - fm) < WGM ? (nM - fm) : WGM;
        u.pm = fm + ((wgid % nig) % gsz); u.pn = (wgid % nig) / gsz; return true;
    }
};
struct OneUnit {
    Unit u;
    __device__ bool next(int i, Unit& o) const { if (i) return false; o = u; return true; }
};

template <class Epi, class Sched>
__device__ __forceinline__ void gemm_phase(LAS unsigned char* lds, const Gemm g, const Sched& S, const Epi& E) {
    int tid_ = threadIdx.x; asm volatile("" : "+v"(tid_));
    const int tid = tid_, wid = __builtin_amdgcn_readfirstlane(tid >> 6), lane = tid & 63, wr = wid >> 2, wc = wid & 3, fr = lane & 15, fq = lane >> 4;
    const int K = g.K, nt = K / BK;
    unsigned voffA[2], voffB[2];
#pragma unroll
    for (int i = 0; i < 2; ++i) { int R, C; stage_rc(tid * 16 + i * 8192, R, C); const int Rb = (R & ~31) + perm32(R & 31);
        voffA[i] = (unsigned)(R * g.lda + C) * 2u; voffB[i] = (unsigned)(Rb * g.ldb + C) * 2u; }
    const size_t kstep = (size_t)(BK * 2);
    const size_t hstepA = (size_t)HALF * g.lda * 2, hstepB = (size_t)HALF * g.ldb * 2;
    const size_t tstepA = 2 * hstepA, tstepB = 2 * hstepB;
    const unsigned ldsw = (unsigned)wid * 1024u;
    const int aoff = lds_byte(wr * 64 + fr, fq * 8), boff = lds_byte(wc * 32 + fr, fq * 8);
#define PG8_SA(b, h) (((b) * 2 + (h)) * HTB)
#define PG8_SB(b, h) ((4 + (b) * 2 + (h)) * HTB)
#define PG8_STAGE(bufoff, gbase, voff) do { _Pragma("unroll") for (int _i = 0; _i < 2; ++_i) \
        __builtin_amdgcn_global_load_lds((const unsigned*)((const char*)(gbase) + (voff)[_i]), (LAS unsigned*)(lds + (bufoff) + ldsw + _i * 8192), 16, 0, 0); } while (0)
#define PG8_LDA(dst, b, h) do { _Pragma("unroll") for (int m = 0; m < 4; ++m) _Pragma("unroll") for (int k = 0; k < 2; ++k) dst[m][k] = *(const LAS bf16x8*)(lds + PG8_SA(b, h) + aoff + m * 2048 + k * 1024); } while (0)
#define PG8_LDB(dst, b, h) do { _Pragma("unroll") for (int n = 0; n < 2; ++n) _Pragma("unroll") for (int k = 0; k < 2; ++k) dst[n][k] = *(const LAS bf16x8*)(lds + PG8_SB(b, h) + boff + n * 2048 + k * 1024); } while (0)
#define PG8_MMA(ai, bj, At, Bt) do { __builtin_amdgcn_s_setprio(1); _Pragma("unroll") for (int m = 0; m < 4; ++m) _Pragma("unroll") for (int n = 0; n < 2; ++n) _Pragma("unroll") for (int k = 0; k < 2; ++k) \
        acc[ai][bj][m][n] = __builtin_amdgcn_mfma_f32_16x16x32_bf16(Bt[n][k], At[m][k], acc[ai][bj][m][n], 0, 0, 0); __builtin_amdgcn_s_setprio(0); } while (0)
#define PG8_WAIT_V(n) asm volatile("s_waitcnt vmcnt(" #n ")" ::: "memory")
#define PG8_WAIT_L(n) asm volatile("s_waitcnt lgkmcnt(" #n ")" ::: "memory")
#define PG8_BAR __builtin_amdgcn_s_barrier()
#define PG8_SCHED __builtin_amdgcn_sched_barrier(0)
    Unit cur, nxt; int ui = 0;
    if (!S.next(0, cur)) return;
    f32x4 acc[2][2][4][2];
#pragma unroll
    for (int a = 0; a < 2; ++a)
#pragma unroll
        for (int b = 0; b < 2; ++b)
#pragma unroll
            for (int m = 0; m < 4; ++m)
#pragma unroll
                for (int n = 0; n < 2; ++n) acc[a][b][m][n] = (f32x4){0.f, 0.f, 0.f, 0.f};
    bf16x8 At[4][2], B0[2][2], B1[2][2];
    const char* cA = (const char*)g.A + (size_t)cur.pm * tstepA; const char* cB = (const char*)g.Bt + (size_t)cur.pn * tstepB;
    {
        PG8_STAGE(PG8_SB(0, 0), cB, voffB); PG8_STAGE(PG8_SB(0, 1), cB + hstepB, voffB); PG8_STAGE(PG8_SA(0, 0), cA, voffA); PG8_STAGE(PG8_SA(0, 1), cA + hstepA, voffA);
        if (wr == 1) PG8_BAR;
        PG8_WAIT_V(2); PG8_BAR;
        PG8_STAGE(PG8_SB(1, 0), cB + kstep, voffB); PG8_STAGE(PG8_SA(1, 0), cA + kstep, voffA); PG8_STAGE(PG8_SB(1, 1), cB + hstepB + kstep, voffB);
        PG8_WAIT_V(6); PG8_BAR;
    }
    for (;;) {
        const bool has_next = S.next(ui + 1, nxt);
        const char* nA = has_next ? (const char*)g.A + (size_t)nxt.pm * tstepA : cA; const char* nB = has_next ? (const char*)g.Bt + (size_t)nxt.pn * tstepB : cB;
        for (int t = 0; t < nt; t += 2) {
            const bool last = (t == nt - 2);
            const char* a1 = cA + (size_t)(t + 1) * kstep;
            const char* a2 = last ? nA : cA + (size_t)(t + 2) * kstep; const char* b2 = last ? nB : cB + (size_t)(t + 2) * kstep;
            const char* a3 = a2 + kstep; const char* b3 = b2 + kstep;
            PG8_LDB(B0, 0, 0); PG8_LDB(B1, 0, 1); PG8_SCHED; PG8_LDA(At, 0, 0); PG8_STAGE(PG8_SA(1, 1), a1 + hstepA, voffA);
            PG8_WAIT_V(8); PG8_WAIT_L(0); PG8_BAR; PG8_MMA(0, 0, At, B0); PG8_MMA(0, 1, At, B1); PG8_BAR; PG8_SCHED;
            PG8_LDA(At, 0, 1); PG8_STAGE(PG8_SB(0, 0), b2, voffB); PG8_STAGE(PG8_SB(0, 1), b2 + hstepB, voffB); PG8_STAGE(PG8_SA(0, 0), a2, voffA);
            PG8_WAIT_V(8); PG8_WAIT_L(0); PG8_BAR; PG8_MMA(1, 0, At, B0); PG8_MMA(1, 1, At, B1); PG8_BAR; PG8_SCHED;
            PG8_LDB(B0, 1, 0); PG8_LDB(B1, 1, 1); PG8_SCHED; PG8_LDA(At, 1, 0); PG8_STAGE(PG8_SA(0, 1), a2 + hstepA, voffA);
            PG8_WAIT_V(8); PG8_WAIT_L(0); PG8_BAR; PG8_MMA(0, 0, At, B0); PG8_MMA(0, 1, At, B1); PG8_BAR; PG8_SCHED;
            PG8_LDA(At, 1, 1); PG8_STAGE(PG8_SB(1, 0), b3, voffB); PG8_STAGE(PG8_SB(1, 1), b3 + hstepB, voffB); PG8_STAGE(PG8_SA(1, 0), a3, voffA);
            PG8_WAIT_V(8); PG8_WAIT_L(0); PG8_BAR; PG8_MMA(1, 0, At, B0); PG8_MMA(1, 1, At, B1); PG8_BAR; PG8_SCHED;
        }
        if (wr == 0) PG8_BAR;
        E(acc, cur, wr, wc, fr, fq);
        if (!has_next) break;
#pragma unroll
        for (int a = 0; a < 2; ++a)
#pragma unroll
            for (int b = 0; b < 2; ++b)
#pragma unroll
                for (int m = 0; m < 4; ++m)
#pragma unroll
                    for (int n = 0; n < 2; ++n) acc[a][b][m][n] = (f32x4){0.f, 0.f, 0.f, 0.f};
        cur = nxt; cA = nA; cB = nB; ++ui;
        if (wr == 1) PG8_BAR;
    }
    PG8_WAIT_V(0);
    PG8_BAR;
#undef PG8_SA
#undef PG8_SB
#undef PG8_STAGE
#undef PG8_LDA
#undef PG8_LDB
#undef PG8_MMA
#undef PG8_WAIT_V
#undef PG8_WAIT_L
#undef PG8_BAR
#undef PG8_SCHED
}

typedef const f32x4 (&AccRef)[2][2][4][2];
__device__ __forceinline__ u32x4 pack8(f32x4 v0, f32x4 v1) { u32x4 w; w.x = pk2(v0[0], v0[1]); w.y = pk2(v0[2], v0[3]); w.z = pk2(v1[0], v1[1]); w.w = pk2(v1[2], v1[3]); return w; }

struct EpiPlain {
    bf16_t* O; int ldc;
    __device__ __forceinline__ void operator()(AccRef acc, const Unit& u, int wr, int wc, int fr, int fq) const {
        const int row0 = u.pm * BM + wr * 64 + fr, col0 = u.pn * BM + wc * 32 + 8 * fq;
#pragma unroll
        for (int ai = 0; ai < 2; ++ai)
#pragma unroll
            for (int m = 0; m < 4; ++m) { bf16_t* rowp = O + (size_t)(row0 + ai * HALF + m * 16) * ldc + col0;
#pragma unroll
                for (int bj = 0; bj < 2; ++bj) *(u32x4*)(rowp + bj * HALF) = pack8(acc[ai][bj][m][0], acc[ai][bj][m][1]); }
    }
};
struct EpiStage1 {
    bf16_t *xa, *qm, *qkv, *halo;
    __device__ __forceinline__ void operator()(AccRef acc, const Unit& u, int wr, int wc, int fr, int fq) const {
        const int pn = u.pn; bf16_t* base; int ldc, colt;
        if (pn < 2) { base = xa; ldc = 512; colt = pn * 256; }
        else if (pn < 4) { base = qm; ldc = 512; colt = (pn - 2) * 256; }
        else { const int t = (pn - 4) >> 2; base = qkv + (size_t)t * M * 1024; ldc = 1024; colt = ((pn - 4) & 3) * 256; }
        const int row0 = u.pm * BM + wr * 64 + fr, col0 = colt + wc * 32 + 8 * fq;
#pragma unroll
        for (int ai = 0; ai < 2; ++ai)
#pragma unroll
            for (int m = 0; m < 4; ++m) { const int row = row0 + ai * HALF + m * 16; bf16_t* rowp = base + (size_t)row * ldc + col0;
#pragma unroll
                for (int bj = 0; bj < 2; ++bj) { const u32x4 w = pack8(acc[ai][bj][m][0], acc[ai][bj][m][1]);
                    *(u32x4*)(rowp + bj * HALF) = w;
                    if (m == 3 && pn >= 4 && fr >= 13) *(u32x4*)(halo + ((size_t)(row >> 6) * 3 + (fr - 13)) * 3072 + (pn - 4) * 256 + bj * HALF + wc * 32 + 8 * fq) = w; } }
    }
};
struct EpiZ {
    bf16_t* Y; const float* SUMSQ;
    __device__ __forceinline__ void operator()(AccRef acc, const Unit& u, int wr, int wc, int fr, int fq) const {
        int tid = threadIdx.x; asm volatile("" : "+v"(tid)); fr = tid & 15; fq = (tid >> 4) & 3;
        const int row0 = u.pm * BM + wr * 64 + fr, col0 = u.pn * BM + wc * 32 + 8 * fq;
        const bool isdn = (col0 >= 512) && (col0 < 1536); const int hd = isdn ? ((col0 - 512) >> 7) : 0;
#pragma unroll
        for (int ai = 0; ai < 2; ++ai)
#pragma unroll
            for (int mh = 0; mh < 2; ++mh) {
                u32x4 o[2][2]; float sq[2][2];
#pragma unroll
                for (int mm = 0; mm < 2; ++mm)
#pragma unroll
                    for (int bj = 0; bj < 2; ++bj) { const size_t row = (size_t)(row0 + ai * HALF + (2 * mh + mm) * 16);
                        o[mm][bj] = *(const u32x4*)(Y + row * 2048 + col0 + bj * HALF); sq[mm][bj] = SUMSQ[row * 8 + (isdn ? hd + bj : 0)]; }
#pragma unroll
                for (int mm = 0; mm < 2; ++mm)
#pragma unroll
                    for (int bj = 0; bj < 2; ++bj) { const int m = 2 * mh + mm; const size_t row = (size_t)(row0 + ai * HALF + m * 16);
                        const f32x4 a0 = acc[ai][bj][m][0], a1 = acc[ai][bj][m][1]; const u32x4 ov = o[mm][bj];
                        const float fac = isdn ? (1.0f / sqrtf(sq[mm][bj] * (1.f / 128.f) + EPS)) : 1.f;
                        f32x4 v0, v1;
                        v0[0] = bflo(ov.x) * silu_f(a0[0]); v0[1] = bfhi(ov.x) * silu_f(a0[1]); v0[2] = bflo(ov.y) * silu_f(a0[2]); v0[3] = bfhi(ov.y) * silu_f(a0[3]);
                        v1[0] = bflo(ov.z) * silu_f(a1[0]); v1[1] = bfhi(ov.z) * silu_f(a1[1]); v1[2] = bflo(ov.w) * silu_f(a1[2]); v1[3] = bfhi(ov.w) * silu_f(a1[3]);
                        *(u32x4*)(Y + row * 2048 + col0 + bj * HALF) = pack8(v0 * fac, v1 * fac); }
                asm volatile("" ::: "memory"); __builtin_amdgcn_sched_barrier(0);
            }
    }
};
struct EpiGate {
    bf16_t* GATE;
    __device__ __forceinline__ void operator()(AccRef acc, const Unit& u, int wr, int wc, int fr, int fq) const {
        int tid = threadIdx.x; asm volatile("" : "+v"(tid)); fr = tid & 15; fq = (tid >> 4) & 3;
        const int row0 = u.pm * BM + wr * 64 + fr, col0 = u.pn * BM + wc * 32 + 8 * fq;
#pragma unroll
        for (int ai = 0; ai < 2; ++ai)
#pragma unroll
            for (int m = 0; m < 4; ++m) { bf16_t* rowp = GATE + (size_t)(row0 + ai * HALF + m * 16) * 3072 + col0;
#pragma unroll
                for (int bj = 0; bj < 2; ++bj) { const f32x4 a0 = acc[ai][bj][m][0], a1 = acc[ai][bj][m][1]; f32x4 v0, v1;
#pragma unroll
                    for (int e = 0; e < 4; ++e) { v0[e] = sigm_f(a0[e]); v1[e] = sigm_f(a1[e]); }
                    *(u32x4*)(rowp + bj * HALF) = pack8(v0, v1); } }
    }
};
template <int BR> struct EpiProj {
    const bf16_t* GATE; bf16_t* Y;
    __device__ __forceinline__ void operator()(AccRef acc, const Unit& u, int wr, int wc, int fr, int fq) const {
        int tid = threadIdx.x; asm volatile("" : "+v"(tid)); fr = tid & 15; fq = (tid >> 4) & 3;
        const int row0 = u.pm * BM + wr * 64 + fr, col0 = u.pn * BM + wc * 32 + 8 * fq;
#pragma unroll
        for (int ai = 0; ai < 2; ++ai)
#pragma unroll
            for (int mh = 0; mh < 2; ++mh) {
                u32x4 gq[2][2], yo[2][2];
#pragma unroll
                for (int mm = 0; mm < 2; ++mm)
#pragma unroll
                    for (int bj = 0; bj < 2; ++bj) { const size_t row = (size_t)(row0 + ai * HALF + (2 * mh + mm) * 16);
                        gq[mm][bj] = *(const u32x4*)(GATE + row * 3072 + BR * 1024 + col0 + bj * HALF);
                        if (BR > 0) yo[mm][bj] = *(const u32x4*)(Y + row * 1024 + col0 + bj * HALF); }
#pragma unroll
                for (int mm = 0; mm < 2; ++mm)
#pragma unroll
                    for (int bj = 0; bj < 2; ++bj) { const int m = 2 * mh + mm; const size_t row = (size_t)(row0 + ai * HALF + m * 16);
                        const f32x4 a0 = acc[ai][bj][m][0], a1 = acc[ai][bj][m][1]; const u32x4 g4 = gq[mm][bj];
                        f32x4 v0, v1;
                        v0[0] = bflo(g4.x) * a0[0]; v0[1] = bfhi(g4.x) * a0[1]; v0[2] = bflo(g4.y) * a0[2]; v0[3] = bfhi(g4.y) * a0[3];
                        v1[0] = bflo(g4.z) * a1[0]; v1[1] = bfhi(g4.z) * a1[1]; v1[2] = bflo(g4.w) * a1[2]; v1[3] = bfhi(g4.w) * a1[3];
                        if (BR > 0) { const u32x4 y4 = yo[mm][bj];
                            v0[0] += bflo(y4.x); v0[1] += bfhi(y4.x); v0[2] += bflo(y4.y); v0[3] += bfhi(y4.y); v1[0] += bflo(y4.z); v1[1] += bfhi(y4.z); v1[2] += bflo(y4.w); v1[3] += bfhi(y4.w); }
                        *(u32x4*)(Y + row * 1024 + col0 + bj * HALF) = pack8(v0, v1); }
                asm volatile("" ::: "memory"); __builtin_amdgcn_sched_barrier(0);
            }
    }
};
struct EpiOutNorm {
    float* O; const float* X; const float* PW; float* rowss; unsigned* cnt;
    __device__ __forceinline__ void operator()(AccRef acc, const Unit& u, int wr, int wc, int fr, int fq) const {
        int tid = threadIdx.x; asm volatile("" : "+v"(tid)); fr = tid & 15; fq = (tid >> 4) & 3;
        const int row0 = u.pm * BM + wr * 64 + fr, col0 = u.pn * BM + wc * 32 + 8 * fq;
#pragma unroll
        for (int ai = 0; ai < 2; ++ai)
#pragma unroll
            for (int m = 0; m < 4; ++m) { const int row = row0 + ai * HALF + m * 16; float ss = 0.f;
#pragma unroll
                for (int bj = 0; bj < 2; ++bj) { const f32x4 a0 = acc[ai][bj][m][0], a1 = acc[ai][bj][m][1];
                    ss += (a0[0] * a0[0] + a0[1] * a0[1]) + (a0[2] * a0[2] + a0[3] * a0[3]) + (a1[0] * a1[0] + a1[1] * a1[1]) + (a1[2] * a1[2] + a1[3] * a1[3]); }
                ss += __shfl_xor(ss, 16); ss += __shfl_xor(ss, 32);
                if (fq == 0) atomicAdd(rowss + row, ss); }
        asm volatile("s_waitcnt vmcnt(0)" ::: "memory");
        __syncthreads();
        if (threadIdx.x == 0) {
            __hip_atomic_fetch_add(cnt + u.pm * 16, 1u, __ATOMIC_RELAXED, __HIP_MEMORY_SCOPE_AGENT);
            unsigned sp = 0;
            while (__hip_atomic_load(cnt + u.pm * 16, __ATOMIC_RELAXED, __HIP_MEMORY_SCOPE_AGENT) < 4u) { __builtin_amdgcn_s_sleep(1); if (++sp > (1u << 20)) break; }
        }
        __syncthreads();
#pragma unroll
        for (int ai = 0; ai < 2; ++ai)
#pragma unroll
            for (int m = 0; m < 4; ++m) { const int row = row0 + ai * HALF + m * 16;
                const float rs = 1.0f / sqrtf(__hip_atomic_load(rowss + row, __ATOMIC_RELAXED, __HIP_MEMORY_SCOPE_AGENT) * (1.f / 1024.f) + EPS);
                f32x4 xv[2][2];
#pragma unroll
                for (int bj = 0; bj < 2; ++bj) { const size_t off = (size_t)row * 1024 + col0 + bj * HALF; xv[bj][0] = *(const f32x4*)(X + off); xv[bj][1] = *(const f32x4*)(X + off + 4); }
#pragma unroll
                for (int bj = 0; bj < 2; ++bj) { const size_t off = (size_t)row * 1024 + col0 + bj * HALF;
                    const f32x4 w0 = *(const f32x4*)(PW + col0 + bj * HALF), w1 = *(const f32x4*)(PW + col0 + bj * HALF + 4);
                    *(f32x4*)(O + off) = xv[bj][0] + acc[ai][bj][m][0] * rs * w0; *(f32x4*)(O + off + 4) = xv[bj][1] + acc[ai][bj][m][1] * rs * w1; }
                if (m & 1) { asm volatile("" ::: "memory"); __builtin_amdgcn_sched_barrier(0); } }
    }
};
}

#define XB_TMO      128
#define XB_XCNT(j)  (256  + 64 * (j))
#define XB_XSUB(j)  (1280 + 64 * (j))
#define XB_XGEN(j)  (2304 + 64 * (j))
#define XB_TOP      3328
#define XB_TOPGEN   3392
#define XCD_BAR_WORDS 3456
#define XB_SPIN_CAP (1u << 18)

__device__ __forceinline__ unsigned xb_ld(unsigned* p)              { return __hip_atomic_load(p, __ATOMIC_RELAXED, __HIP_MEMORY_SCOPE_AGENT); }
__device__ __forceinline__ unsigned xb_add(unsigned* p, unsigned v) { return __hip_atomic_fetch_add(p, v, __ATOMIC_RELAXED, __HIP_MEMORY_SCOPE_AGENT); }
__device__ __forceinline__ unsigned xb_xcc_id() { return (unsigned)__builtin_amdgcn_s_getreg((3 << 11) | 20) & 0xFu; }
#define XB_SPIN(cond, bar) do { unsigned _sp = 0; while (cond) { __builtin_amdgcn_s_sleep(1); \
    if ((++_sp & 255u) == 0u) { if (xb_ld(&(bar)[XB_TMO])) break; if (_sp > XB_SPIN_CAP) { atomicAdd(&(bar)[XB_TMO], 1u); break; } } } } while (0)

struct XcdBarrier {
    unsigned* bar; unsigned x;
    volatile LAS unsigned* st;
};

__device__ __forceinline__ XcdBarrier xcd_barrier_post(unsigned* bar, volatile LAS unsigned* st) {
    XcdBarrier b; b.bar = bar; b.x = xb_xcc_id(); b.st = st;
    if (threadIdx.x == 0) (void)xb_add(&bar[XB_XCNT(b.x)], 1u);
    return b;
}
__device__ __forceinline__ void xcd_barrier_complete(unsigned* bar, unsigned x, unsigned& nloc, unsigned& nx) {
    const unsigned G = gridDim.x * gridDim.y * gridDim.z;
    unsigned sum, cnt, mine, sp = 0u;
    for (;;) {
        sum = 0u; cnt = 0u; mine = 0u;
#pragma unroll
        for (unsigned j = 0; j < 16; ++j) { const unsigned c = xb_ld(&bar[XB_XCNT(j)]); sum += c; cnt += (c > 0u) ? 1u : 0u; mine = (j == x) ? c : mine; }
        if (sum == G) break;
        __builtin_amdgcn_s_sleep(1);
        if ((++sp & 255u) == 0u) { if (xb_ld(&bar[XB_TMO])) break; if (sp > XB_SPIN_CAP) { atomicAdd(&bar[XB_TMO], 1u); break; } }
    }
    nloc = mine > 0u ? mine : 1u; nx = cnt > 0u ? cnt : 1u;
}

__device__ __forceinline__ void xcd_barrier(const XcdBarrier& b) {
    asm volatile("s_waitcnt vmcnt(0)" ::: "memory");
    __syncthreads();
    if (threadIdx.x == 0) {
        unsigned* bar = b.bar;
        __builtin_amdgcn_s_waitcnt(0);
        unsigned nloc = b.st[0], nx = b.st[1];
        if (nloc == 0u) { xcd_barrier_complete(bar, b.x, nloc, nx); b.st[0] = nloc; b.st[1] = nx; }
        const unsigned old = xb_add(&bar[XB_XSUB(b.x)], 1u);
        const unsigned gen = old / nloc;
        if (old + 1u == (gen + 1u) * nloc) {
            __builtin_amdgcn_fence(__ATOMIC_RELEASE, "agent");
            asm volatile("s_waitcnt vmcnt(0)" ::: "memory");
            const unsigned og = xb_add(&bar[XB_TOP], 1u);
            const unsigned tg = og / nx;
            if (og + 1u == (tg + 1u) * nx) xb_add(&bar[XB_TOPGEN], 1u);
            else XB_SPIN(xb_ld(&bar[XB_TOPGEN]) == tg, bar);
            __builtin_amdgcn_fence(__ATOMIC_ACQUIRE, "agent");
            xb_add(&bar[XB_XGEN(b.x)], 1u);
            asm volatile("s_waitcnt vmcnt(0)" ::: "memory");
        } else {
            XB_SPIN(xb_ld(&bar[XB_XGEN(b.x)]) == gen, bar);
            __builtin_amdgcn_fence(__ATOMIC_ACQUIRE, "agent");
            asm volatile("s_waitcnt vmcnt(0)" ::: "memory");
        }
    }
    __syncthreads();
}


struct Args {
    const float *x, *mem, *pre_w, *mem_w, *w_in, *conv_w, *a_log, *dt_bias, *dn_w, *mix_w, *pool_scale, *w_kv, *w_pp, *w_pd, *w_pm, *w_out, *post_w;
    float* out; unsigned char* ws; int ph_lo, ph_hi;
};

__device__ __forceinline__ float wave_sum(float v) {
    v += __builtin_bit_cast(float, __builtin_amdgcn_update_dpp(0, __builtin_bit_cast(int, v), 0xB1, 0xF, 0xF, false));
    v += __builtin_bit_cast(float, __builtin_amdgcn_update_dpp(0, __builtin_bit_cast(int, v), 0x4E, 0xF, 0xF, false));
    v += __builtin_bit_cast(float, __builtin_amdgcn_update_dpp(0, __builtin_bit_cast(int, v), 0x124, 0xF, 0xF, false));
    v += __builtin_bit_cast(float, __builtin_amdgcn_update_dpp(0, __builtin_bit_cast(int, v), 0x128, 0xF, 0xF, false));
    const int vi = __builtin_bit_cast(int, v);
    const float s0 = __builtin_bit_cast(float, __builtin_amdgcn_readlane(vi, 0)), s1 = __builtin_bit_cast(float, __builtin_amdgcn_readlane(vi, 16));
    const float s2 = __builtin_bit_cast(float, __builtin_amdgcn_readlane(vi, 32)), s3 = __builtin_bit_cast(float, __builtin_amdgcn_readlane(vi, 48));
    return (s0 + s1) + (s2 + s3);
}

__device__ __forceinline__ void p0_transpose_item(const float* W, int ldw, int K, bf16_t* WT, LAS float* scr, int kb, int nb, int lane) {
    const int k0 = 64 * kb, n0 = 32 * nb;
    float tv[32];
#pragma unroll
    for (int i = 0; i < 32; ++i) tv[i] = W[(size_t)(k0 + 2 * i + (lane >> 5)) * ldw + n0 + (lane & 31)];
#pragma unroll
    for (int i = 0; i < 32; ++i) scr[(2 * i + (lane >> 5)) * 33 + (lane & 31)] = tv[i];
    LDS_WAIT();
    const int c = lane & 7;
#pragma unroll
    for (int j = 0; j < 4; ++j) { const int n = (lane >> 3) + 8 * j; const LAS float* s = scr + (8 * c) * 33 + n;
        u32x4 o; o.x = pk2(s[0 * 33], s[1 * 33]); o.y = pk2(s[2 * 33], s[3 * 33]); o.z = pk2(s[4 * 33], s[5 * 33]); o.w = pk2(s[6 * 33], s[7 * 33]);
        *(u32x4*)(WT + (size_t)(n0 + n) * K + k0 + 8 * c) = o; }
    LDS_WAIT();
}

__device__ __forceinline__ void p0_prologue(const Args& a, LAS unsigned char* lds) {
    int tid_ = threadIdx.x; asm volatile("" : "+v"(tid_));
    const int tid = tid_, lane = tid & 63, wave = tid >> 6, G = gridDim.x;
    unsigned char* ws = a.ws;
    LAS float* W16 = (LAS float*)lds;
    LAS float* scr = (LAS float*)(lds + 65536 + wave * 8448);
    for (int idx = tid; idx < 4096; idx += 512) { const int i = idx >> 2, q = idx & 3; const int p = ((i >> 8) * 4 + (i & 3)) * 64 + ((i >> 2) & 63);
        *(LAS f32x4*)(W16 + (q * 1024 + p) * 4) = *(const f32x4*)(a.w_in + (size_t)i * INW + 4096 + 4 * q); }
    for (int i = blockIdx.x * 512 + tid; i < M; i += G * 512) ((float*)(ws + WS_ROWSS))[i] = 0.f;
    for (int i = blockIdx.x * 512 + tid; i < M * 8; i += G * 512) ((float*)(ws + WS_SUMSQ))[i] = 0.f;
    __syncthreads();
    const int gw = blockIdx.x * 8 + wave, NGW = G * 8;
    bf16_t* WT = (bf16_t*)(ws + WS_WT);
#define SEG(src, ldw, Kk, Nseg, dst) { const int ni = ((Kk) / 64) * ((Nseg) / 32); if (r < ni) { const int nblk = (Nseg) / 32; p0_transpose_item((src), (ldw), (Kk), (dst), scr, r / nblk, r % nblk, lane); continue; } r -= ni; }
    constexpr int NITEMS = 16 * 128 + 512 + 32;
    for (int it = wave * G + (int)blockIdx.x; it < NITEMS; it += NGW) {
        int r = it;
        SEG(a.w_in + 0, INW, 1024, 512, WT)
        SEG(a.w_in + 5136, INW, 1024, 512, WT + (size_t)512 * 1024)
        SEG(a.w_in + 1024, INW, 1024, 3072, WT + (size_t)1024 * 1024)
        SEG(a.w_kv, 1024, 1024, 1024, (bf16_t*)(ws + WS_WKV))
        SEG(a.mix_w + 0 * 16384, 128, 128, 128, (bf16_t*)(ws + WS_WMIX) + 0 * 16384)
        SEG(a.mix_w + 1 * 16384, 128, 128, 128, (bf16_t*)(ws + WS_WMIX) + 1 * 16384)
        SEG(a.mix_w + 2 * 16384, 128, 128, 128, (bf16_t*)(ws + WS_WMIX) + 2 * 16384)
        SEG(a.mix_w + 3 * 16384, 128, 128, 128, (bf16_t*)(ws + WS_WMIX) + 3 * 16384)
    }
    const float dtb_l = a.dt_bias[lane & 7], alog_l = a.a_log[lane & 7];
    f32x4 nwx[4], nwm[4];
#pragma unroll
    for (int j = 0; j < 4; ++j) { nwx[j] = ((const f32x4*)a.pre_w)[lane + 64 * j]; nwm[j] = ((const f32x4*)a.mem_w)[lane + 64 * j]; }
    f32x4 vnx[4];
    {   const int m = gw; const float* src = (m >= M) ? a.mem + (size_t)(m - M) * 1024 : a.x + (size_t)m * 1024;
#pragma unroll
        for (int j = 0; j < 4; ++j) vnx[j] = ((const f32x4*)src)[lane + 64 * j]; }
    for (int m = gw; m < M + NB * MEML; m += NGW) {
        const bool is_mem = m >= M;
        bf16_t* dst = is_mem ? (bf16_t*)(ws + WS_MEMN) + (size_t)(m - M) * 1024 : (bf16_t*)(ws + WS_H) + (size_t)m * 1024;
        f32x4 v[4]; float s = 0.f;
#pragma unroll
        for (int j = 0; j < 4; ++j) { v[j] = vnx[j]; s += (v[j].x * v[j].x + v[j].y * v[j].y) + (v[j].z * v[j].z + v[j].w * v[j].w); }
        {   const int m2 = (m + NGW < M + NB * MEML) ? m + NGW : m; const float* src = (m2 >= M) ? a.mem + (size_t)(m2 - M) * 1024 : a.x + (size_t)m2 * 1024;
#pragma unroll
            for (int j = 0; j < 4; ++j) vnx[j] = ((const f32x4*)src)[lane + 64 * j]; }
        const float rstd = 1.0f / sqrtf(wave_sum(s) * (1.f / 1024.f) + EPS);
#pragma unroll
        for (int j = 0; j < 4; ++j) { const f32x4 wv = is_mem ? nwm[j] : nwx[j]; v[j] = v[j] * rstd * wv;
            u32x2 o; o.x = pk2(v[j].x, v[j].y); o.y = pk2(v[j].z, v[j].w); ((u32x2*)dst)[lane + 64 * j] = o; }
        if (!is_mem) {
            f32x4 acc[4];
#pragma unroll
            for (int q = 0; q < 4; ++q) acc[q] = (f32x4){0.f, 0.f, 0.f, 0.f};
#pragma unroll
            for (int j = 0; j < 4; ++j)
#pragma unroll
                for (int e = 0; e < 4; ++e) { const float xv = v[j][e];
#pragma unroll
                    for (int q = 0; q < 4; ++q) { const f32x4 wv = *(const LAS f32x4*)(W16 + (q * 1024 + (j * 4 + e) * 64 + lane) * 4); acc[q] += xv * wv; } }
            float val = 0.f;
#pragma unroll
            for (int q = 0; q < 4; ++q)
#pragma unroll
                for (int e = 0; e < 4; ++e) { const float t = wave_sum(acc[q][e]); if (lane == q * 4 + e) val = t; }
            if (lane < 8) { const float z = val + dtb_l; const float sp = z > 20.f ? z : log1pf(expf(z));
                ((float*)(ws + WS_G))[(size_t)m * 8 + lane] = -expf(alog_l) * sp; }
            else if (lane < 16) ((float*)(ws + WS_BETA))[(size_t)m * 8 + lane - 8] = 1.f / (1.f + expf(-val));
        }
    }
}

__device__ __forceinline__ void late_transposes(const Args& a, LAS unsigned char* lds, int c, int GG) {
    int tid_ = threadIdx.x; asm volatile("" : "+v"(tid_));
    const int tid = tid_, lane = tid & 63, wave = tid >> 6;
    unsigned char* ws = a.ws; bf16_t* WT = (bf16_t*)(ws + WS_WT);
    LAS float* scr = (LAS float*)(lds + wave * 8448);
    __syncthreads();
    const int gw = c * 8 + wave, NGW = GG * 8;
    constexpr int NITEMS = 16 * 160 + 256 + 512 + 256 + 512;
    for (int it = gw; it < NITEMS; it += NGW) {
        int r = it;
        SEG(a.w_in + 512, INW, 1024, 512, WT + (size_t)4096 * 1024)
        SEG(a.w_in + 4112, INW, 1024, 1024, WT + (size_t)4608 * 1024)
        SEG(a.w_in + 5648, INW, 1024, 512, WT + (size_t)5632 * 1024)
        SEG(a.w_in + 6160, INW, 1024, 3072, WT + (size_t)6144 * 1024)
        SEG(a.w_pp, 1024, 512, 1024, (bf16_t*)(ws + WS_WP))
        SEG(a.w_pd, 1024, 1024, 1024, (bf16_t*)(ws + WS_WD))
        SEG(a.w_pm, 1024, 512, 1024, (bf16_t*)(ws + WS_WM))
        SEG(a.w_out, 1024, 1024, 1024, (bf16_t*)(ws + WS_WOUT))
    }
    __syncthreads();
}
#undef SEG

__device__ __forceinline__ void chunk_load_raw(const Args& a, int item, u32x4 (&raw)[11], int tid) {
    const int n = item & 31, h = (item >> 5) & 7, b = item >> 8; const int r0 = b * SEQ + 64 * n, gci = b * 32 + n;
    const int ten = tid >> 7, cgp = tid & 15, rg = (tid >> 4) & 7;
    if (tid < 384) {
        const bf16_t* src = (const bf16_t*)(a.ws + WS_QKV) + (size_t)ten * M * 1024 + h * 128 + cgp * 8;
#pragma unroll
        for (int i = 0; i < 11; ++i) { const int rr = 8 * rg - 3 + i;
            if (rr >= 0) raw[i] = *(const u32x4*)(src + (size_t)(r0 + rr) * 1024);
            else if (n > 0) raw[i] = *(const u32x4*)((const bf16_t*)(a.ws + WS_HALO) + ((size_t)(gci - 1) * 3 + (rr + 3)) * 3072 + ten * 1024 + h * 128 + cgp * 8);
            else raw[i] = (u32x4){0u, 0u, 0u, 0u}; }
    }
}
__device__ __forceinline__ void chunk_prep_item(const Args& a, LAS unsigned char* lds, int item, u32x4 (&raw)[11], int item_next, float& gpre, float& bpre, int set, int stage, int nvalid) {
    int tid_ = threadIdx.x; asm volatile("" : "+v"(tid_));
    const int tid = tid_, lane = tid & 63, wid = tid >> 6, r16 = lane & 15, qp = lane >> 4;
    const int n = item & 31, h = (item >> 5) & 7, b = item >> 8;
    const int r0 = b * SEQ + 64 * n, gci = b * 32 + n;
    unsigned char* ws = a.ws;
    bf16_t* QKV = (bf16_t*)(ws + WS_QKV);
    LAS bf16_t* Kn = (LAS bf16_t*)(lds);
    LAS bf16_t* Qn = (LAS bf16_t*)(lds + 17408);
    const int sset = (stage == 1) ? (wid >> 2) : set;
    LAS bf16_t* Tb = (LAS bf16_t*)(lds + sset * 9216);
    LAS bf16_t* VbT = (LAS bf16_t*)(lds + 34816 + sset * 36864);
    LAS bf16_t* KbgT = (LAS bf16_t*)(lds + 53248 + sset * 36864);
    LAS float* Ap = (LAS float*)(lds + 108544 + sset * 17408);
    LAS float* gcs = (LAS float*)(lds + 143360 + sset * 512);
    LAS float* bts = gcs + 64;
    __syncthreads();
    if (stage == 0) {
    if (wid == 0) {
        float g = gpre;
        const float bt = bpre;
        if (item_next >= 0) { const int n2 = item_next & 31, h2 = (item_next >> 5) & 7, b2 = item_next >> 8; const int r2 = b2 * SEQ + 64 * n2;
            gpre = ((const float*)(ws + WS_G))[(size_t)(r2 + lane) * 8 + h2]; bpre = ((const float*)(ws + WS_BETA))[(size_t)(r2 + lane) * 8 + h2]; }
#pragma unroll
        for (int o = 1; o < 64; o <<= 1) { const float t = __shfl_up(g, o); if (lane >= o) g += t; }
        gcs[lane] = g; bts[lane] = bt;
        if (lane == 63) ((float*)(ws + WS_GL))[item] = __expf(g);
    }
    __syncthreads();
    u32x4 outA[8];
    const int ten = tid >> 7, cgp = tid & 15, rg = (tid >> 4) & 7;
    if (tid < 384) {
        f32x4 cw[4][2];
#pragma unroll
        for (int j = 0; j < 4; ++j) { const float* cp = a.conv_w + (size_t)j * 3072 + ten * 1024 + h * 128 + cgp * 8; cw[j][0] = *(const f32x4*)cp; cw[j][1] = *(const f32x4*)(cp + 4); }
        float y[8][8];
#pragma unroll
        for (int i = 0; i < 8; ++i) {
#pragma unroll
            for (int e = 0; e < 8; ++e) y[i][e] = 0.f;
#pragma unroll
            for (int j = 0; j < 4; ++j) { const u32x4 rv = raw[i + j];
                y[i][0] += cw[j][0][0] * bflo(rv.x); y[i][1] += cw[j][0][1] * bfhi(rv.x); y[i][2] += cw[j][0][2] * bflo(rv.y); y[i][3] += cw[j][0][3] * bfhi(rv.y);
                y[i][4] += cw[j][1][0] * bflo(rv.z); y[i][5] += cw[j][1][1] * bfhi(rv.z); y[i][6] += cw[j][1][2] * bflo(rv.w); y[i][7] += cw[j][1][3] * bfhi(rv.w); }
#pragma unroll
            for (int e = 0; e < 8; ++e) y[i][e] = silu_f(y[i][e]);
        }
        if (item_next >= 0) chunk_load_raw(a, item_next, raw, tid);
        const float gl = gcs[63];
        if (ten < 2) {
#pragma unroll
            for (int i = 0; i < 8; ++i) { float ss = 0.f;
#pragma unroll
                for (int e = 0; e < 8; ++e) ss += y[i][e] * y[i][e];
                ss += __shfl_xor(ss, 1); ss += __shfl_xor(ss, 2); ss += __shfl_xor(ss, 4); ss += __shfl_xor(ss, 8);
                const float sc = (1.0f / sqrtf(ss + EPS)) * (ten == 0 ? 0.08838834764831845f : 1.f);
#pragma unroll
                for (int e = 0; e < 8; ++e) y[i][e] *= sc; }
        }
        if (ten == 0) {
#pragma unroll
            for (int i = 0; i < 8; ++i) { const int row = 8 * rg + i; const float eg = __expf(gcs[row]);
                u32x4 w; w.x = pk2(y[i][0], y[i][1]); w.y = pk2(y[i][2], y[i][3]); w.z = pk2(y[i][4], y[i][5]); w.w = pk2(y[i][6], y[i][7]);
                *(LAS u32x4*)(Qn + row * 136 + cgp * 8) = w;
                outA[i].x = pk2(y[i][0] * eg, y[i][1] * eg); outA[i].y = pk2(y[i][2] * eg, y[i][3] * eg); outA[i].z = pk2(y[i][4] * eg, y[i][5] * eg); outA[i].w = pk2(y[i][6] * eg, y[i][7] * eg); }
        } else if (ten == 1) {
            float f1[8], f2[8];
#pragma unroll
            for (int i = 0; i < 8; ++i) { const int row = 8 * rg + i; const float gc = gcs[row]; f1[i] = bts[row] * __expf(gc); f2[i] = __expf(gl - gc);
                u32x4 w; w.x = pk2(y[i][0], y[i][1]); w.y = pk2(y[i][2], y[i][3]); w.z = pk2(y[i][4], y[i][5]); w.w = pk2(y[i][6], y[i][7]);
                *(LAS u32x4*)(Kn + row * 136 + cgp * 8) = w; }
#pragma unroll
            for (int e = 0; e < 8; ++e) { u32x4 w;
                w.x = pk2(y[0][e] * f1[0], y[1][e] * f1[1]); w.y = pk2(y[2][e] * f1[2], y[3][e] * f1[3]); w.z = pk2(y[4][e] * f1[4], y[5][e] * f1[5]); w.w = pk2(y[6][e] * f1[6], y[7][e] * f1[7]);
                *(LAS u32x4*)(KbgT + (cgp * 8 + e) * 72 + 8 * rg) = w;
                outA[e].x = pk2(y[0][e] * f2[0], y[1][e] * f2[1]); outA[e].y = pk2(y[2][e] * f2[2], y[3][e] * f2[3]); outA[e].z = pk2(y[4][e] * f2[4], y[5][e] * f2[5]); outA[e].w = pk2(y[6][e] * f2[6], y[7][e] * f2[7]); }
        } else {
            float f1[8];
#pragma unroll
            for (int i = 0; i < 8; ++i) f1[i] = bts[8 * rg + i];
#pragma unroll
            for (int e = 0; e < 8; ++e) { u32x4 w;
                w.x = pk2(y[0][e] * f1[0], y[1][e] * f1[1]); w.y = pk2(y[2][e] * f1[2], y[3][e] * f1[3]); w.z = pk2(y[4][e] * f1[4], y[5][e] * f1[5]); w.w = pk2(y[6][e] * f1[6], y[7][e] * f1[7]);
                *(LAS u32x4*)(VbT + (cgp * 8 + e) * 72 + 8 * rg) = w; }
        }
    }
    __syncthreads();
    if (tid < 128) {
#pragma unroll
        for (int i = 0; i < 8; ++i) *(u32x4*)(QKV + (size_t)(r0 + 8 * rg + i) * 1024 + h * 128 + cgp * 8) = outA[i];
    } else if (tid < 256) {
#pragma unroll
        for (int e = 0; e < 8; ++e) { const int k = cgp * 8 + e;
            *(u32x4*)((unsigned char*)(QKV + (size_t)2 * M * 1024 + (size_t)(r0 + (k >> 1)) * 1024 + h * 128) + (k & 1) * 128 + 16 * rg) = outA[e]; }
    }
    {
        const int mat = wid >> 2, ti = wid & 3;
        const LAS bf16_t* Bm = mat ? Qn : Kn;
        f32x4 c4[4];
#pragma unroll
        for (int tj = 0; tj < 4; ++tj) c4[tj] = (f32x4){0.f, 0.f, 0.f, 0.f};
#pragma unroll
        for (int ks = 0; ks < 4; ++ks) { const bf16x8 af = *(const LAS bf16x8*)(Kn + (ti * 16 + r16) * 136 + ks * 32 + 8 * qp);
#pragma unroll
            for (int tj = 0; tj < 4; ++tj) { const bf16x8 bf = *(const LAS bf16x8*)(Bm + (tj * 16 + r16) * 136 + ks * 32 + 8 * qp); c4[tj] = MFMA16(af, bf, c4[tj]); } }
        const int j0 = ti * 16 + 4 * qp;
        const f32x4 gj = *(const LAS f32x4*)(gcs + j0);
#pragma unroll
        for (int tj = 0; tj < 4; ++tj) { const int i = tj * 16 + r16; const float gi = gcs[i]; f32x4 v;
#pragma unroll
            for (int e = 0; e < 4; ++e) { const int j = j0 + e; const float d = __expf(fminf(gi - gj[e], 0.f)); const bool keep = mat ? (j <= i) : (j < i); v[e] = keep ? c4[tj][e] * d : 0.f; }
            if (mat == 0) { v = v * bts[i];
#pragma unroll
                for (int e = 0; e < 4; ++e) Ap[i * 68 + e * 16 + ti * 4 + qp] = v[e]; }
            else { u32x2 o; o.x = pk2(v[0], v[1]); o.y = pk2(v[2], v[3]); *(u32x2*)((bf16_t*)(ws + WS_AQK) + (size_t)item * 4096 + i * 64 + j0) = o; } }
    }
    }
    if (stage == 1 && (wid >> 2) < nvalid) {
        const int ph = lane & 3, c = 16 * (wid & 3) + (lane >> 2);
        float t[16];
#pragma unroll
        for (int m = 0; m < 16; ++m) t[m] = 0.f;
        f32x4 cf[3][4];
#define LOADROW(ii, slot) do { _Pragma("unroll") for (int m4 = 0; m4 < 4; ++m4) if (m4 * 16 < (ii) && (ii) < 64) cf[slot][m4] = *(const LAS f32x4*)(Ap + (ii) * 68 + ph * 16 + 4 * m4); } while (0)
        LOADROW(0, 0); LOADROW(1, 1); LOADROW(2, 2);
#pragma unroll
        for (int i = 0; i < 64; ++i) {
            float acc0 = 0.f, acc1 = 0.f;
#pragma unroll
            for (int m4 = 0; m4 * 16 < i; ++m4) { const f32x4 av = cf[i % 3][m4];
                acc0 += av[0] * t[4 * m4];
                if ((4 * m4 + 1) * 4 < i) acc1 += av[1] * t[4 * m4 + 1];
                if ((4 * m4 + 2) * 4 < i) acc0 += av[2] * t[4 * m4 + 2];
                if ((4 * m4 + 3) * 4 < i) acc1 += av[3] * t[4 * m4 + 3]; }
            __builtin_amdgcn_sched_barrier(0);
            LOADROW(i + 3, i % 3);
            __builtin_amdgcn_sched_barrier(0);
            float acc = acc0 + acc1;
            acc += __builtin_bit_cast(float, __builtin_amdgcn_update_dpp(0, __builtin_bit_cast(int, acc), 0xB1, 0xF, 0xF, false));
            acc += __builtin_bit_cast(float, __builtin_amdgcn_update_dpp(0, __builtin_bit_cast(int, acc), 0x4E, 0xF, 0xF, false));
            const float val = ((c == i) ? 1.f : 0.f) - acc;
            t[i >> 2] = (ph == (i & 3)) ? val : t[i >> 2];
        }
#undef LOADROW
#pragma unroll
        for (int m = 0; m < 16; ++m) Tb[(4 * m + ph) * 72 + c] = (bf16_t)f2bf(t[m]);
    }
    if (stage == 2) {
        f32x4 cu[4], cwv[4];
#pragma unroll
        for (int ct = 0; ct < 4; ++ct) { cu[ct] = (f32x4){0.f, 0.f, 0.f, 0.f}; cwv[ct] = (f32x4){0.f, 0.f, 0.f, 0.f}; }
#pragma unroll
        for (int ks = 0; ks < 2; ++ks) {
            const bf16x8 vb = *(const LAS bf16x8*)(VbT + (16 * wid + r16) * 72 + ks * 32 + 8 * qp);
            const bf16x8 kb = *(const LAS bf16x8*)(KbgT + (16 * wid + r16) * 72 + ks * 32 + 8 * qp);
#pragma unroll
            for (int ct = 0; ct < 4; ++ct) { const bf16x8 tf = *(const LAS bf16x8*)(Tb + (16 * ct + r16) * 72 + ks * 32 + 8 * qp);
                cu[ct] = MFMA16(tf, vb, cu[ct]); cwv[ct] = MFMA16(kb, tf, cwv[ct]); }
        }
#pragma unroll
        for (int ct = 0; ct < 4; ++ct) {
            u32x2 o; o.x = pk2(cu[ct][0], cu[ct][1]); o.y = pk2(cu[ct][2], cu[ct][3]);
            ((u32x2*)(ws + WS_U))[(((size_t)item * 8 + wid) * 4 + ct) * 64 + lane] = o;
            u32x2 w2; w2.x = pk2(-cwv[ct][0], -cwv[ct][1]); w2.y = pk2(-cwv[ct][2], -cwv[ct][3]);
            *(u32x2*)(QKV + (size_t)M * 1024 + (size_t)(r0 + 16 * ct + r16) * 1024 + h * 128 + 16 * wid + 4 * qp) = w2;
        }
    }
}

__device__ __forceinline__ bf16x8 ldA_perm(const LAS bf16_t* p) {
    const u32x2 lo = *(const LAS u32x2*)p, hi = *(const LAS u32x2*)(p + 16);
    u32x4 v; v.x = lo.x; v.y = lo.y; v.z = hi.x; v.w = hi.y; return __builtin_bit_cast(bf16x8, v);
}
__device__ __forceinline__ bf16x8 packB(f32x4 t0, f32x4 t1) {
    u32x4 v; v.x = pk2(t0[0], t0[1]); v.y = pk2(t0[2], t0[3]); v.z = pk2(t1[0], t1[1]); v.w = pk2(t1[2], t1[3]); return __builtin_bit_cast(bf16x8, v);
}
constexpr int SC_W = 0, SC_QG = 18432, SC_AQK = 36864, SC_KDT = 47104, SC_BUF = 67584, SC_RED = 2 * SC_BUF, SC_RSTD = SC_RED + 2048;

__device__ __forceinline__ void scan_load(const Args& a, int bh, int n, u32x4 (&stg)[7]) {
    const int tid = threadIdx.x, b = bh >> 3, h = bh & 7; const int r0 = b * SEQ + 64 * n; const int item = bh * 32 + n;
    const bf16_t* QKV = (const bf16_t*)(a.ws + WS_QKV);
    const int c = tid >> 4, k8 = tid & 15;
#pragma unroll
    for (int i = 0; i < 2; ++i) {
        stg[i] = *(const u32x4*)(QKV + (size_t)M * 1024 + (size_t)(r0 + c + 32 * i) * 1024 + h * 128 + k8 * 8);
        stg[2 + i] = *(const u32x4*)(QKV + (size_t)(r0 + c + 32 * i) * 1024 + h * 128 + k8 * 8);
        stg[4 + i] = *(const u32x4*)(QKV + (size_t)2 * M * 1024 + (size_t)(r0 + c + 32 * i) * 1024 + h * 128 + k8 * 8);
    }
    stg[6] = *(const u32x4*)((const bf16_t*)(a.ws + WS_AQK) + (size_t)item * 4096 + tid * 8);
}
__device__ __forceinline__ void st_perm(LAS unsigned char* rowp  , int a4  , u32x4 v) {
    const int p0 = (a4 & 1) * 16 + (a4 >> 1) * 4;
    u32x2 lo; lo.x = v.x; lo.y = v.y; u32x2 hi; hi.x = v.z; hi.y = v.w;
    *(LAS u32x2*)(rowp + p0 * 2) = lo; *(LAS u32x2*)(rowp + (p0 + 8) * 2) = hi;
}
__device__ __forceinline__ void scan_store(LAS unsigned char* buf, const u32x4 (&stg)[7]) {
    const int tid = threadIdx.x; const int c = tid >> 4, k8 = tid & 15;
#pragma unroll
    for (int i = 0; i < 2; ++i) {
        st_perm(buf + SC_W + ((c + 32 * i) * 144 + (k8 >> 2) * 32) * 2, k8 & 3, stg[i]);
        st_perm(buf + SC_QG + ((c + 32 * i) * 144 + (k8 >> 2) * 32) * 2, k8 & 3, stg[2 + i]);
        const int line = c + 32 * i, k = line * 2 + (k8 >> 3), c8 = k8 & 7;
        st_perm(buf + SC_KDT + (k * 80 + (c8 >> 2) * 32) * 2, c8 & 3, stg[4 + i]);
    }
    { const int cc = tid >> 3, j8 = tid & 7; st_perm(buf + SC_AQK + (cc * 80 + (j8 >> 2) * 32) * 2, j8 & 3, stg[6]); }
}
__device__ __forceinline__ float dpp_add16(float v) {
    v += __builtin_bit_cast(float, __builtin_amdgcn_update_dpp(0, __builtin_bit_cast(int, v), 0xB1, 0xF, 0xF, false));
    v += __builtin_bit_cast(float, __builtin_amdgcn_update_dpp(0, __builtin_bit_cast(int, v), 0x4E, 0xF, 0xF, false));
    v += __builtin_bit_cast(float, __builtin_amdgcn_update_dpp(0, __builtin_bit_cast(int, v), 0x124, 0xF, 0xF, false));
    v += __builtin_bit_cast(float, __builtin_amdgcn_update_dpp(0, __builtin_bit_cast(int, v), 0x128, 0xF, 0xF, false));
    return v;
}
#define LDA128(p) (*(const LAS bf16x8*)(p))

struct ScanSet { u32x4 stg[7]; u32x2 u[4]; float gl; };
__device__ __forceinline__ void scan_load_set(const Args& a, int bh, int n, ScanSet& t, int lane, int wid) {
    scan_load(a, bh, n, t.stg);
#pragma unroll
    for (int ct = 0; ct < 4; ++ct) t.u[ct] = ((const u32x2*)(a.ws + WS_U))[(((size_t)(bh * 32 + n) * 8 + wid) * 4 + ct) * 64 + lane];
    t.gl = ((const float*)(a.ws + WS_GL))[bh * 32 + n];
}
__device__ __forceinline__ void scan_step(const Args& a, LAS unsigned char* lds, int bh, int n, f32x4 (&S)[8], ScanSet& T, float dnw, int lane, int wid, int r16, int qp, bool accum) {
    const int tid = threadIdx.x, b = bh >> 3, h = bh & 7;
    bf16_t* Y = (bf16_t*)a.out;
    LAS unsigned char* buf = lds + (n & 1) * SC_BUF;
    const float gl = T.gl;
    f32x4 vn[4], o[4];
#pragma unroll
    for (int ct = 0; ct < 4; ++ct) { const u32x2 uu = T.u[ct];
        vn[ct] = (f32x4){bflo(uu.x), bfhi(uu.x), bflo(uu.y), bfhi(uu.y)}; o[ct] = (f32x4){0.f, 0.f, 0.f, 0.f}; }
    __builtin_amdgcn_sched_barrier(0);
    if (n + 1 < 32) scan_load_set(a, bh, n + 1, T, lane, wid);
    __builtin_amdgcn_sched_barrier(0);
    bf16x8 sb[4];
#pragma unroll
    for (int s = 0; s < 4; ++s) sb[s] = packB(S[2 * s], S[2 * s + 1]);
    const LAS bf16_t* Wb = (const LAS bf16_t*)(buf + SC_W); const LAS bf16_t* QGb = (const LAS bf16_t*)(buf + SC_QG);
    const LAS bf16_t* AQb = (const LAS bf16_t*)(buf + SC_AQK); const LAS bf16_t* KDb = (const LAS bf16_t*)(buf + SC_KDT);
    bf16x8 fa[8], fb[8];
#define SB() __builtin_amdgcn_sched_barrier(0)
#define LD_VO2(f, ca, cb, sh) do { _Pragma("unroll") for (int s_ = 0; s_ < 2; ++s_) { \
        f[4 * s_ + 0] = LDA128(Wb + (16 * (ca) + r16) * 144 + 32 * ((sh) + s_) + 8 * qp); f[4 * s_ + 1] = LDA128(Wb + (16 * (cb) + r16) * 144 + 32 * ((sh) + s_) + 8 * qp); \
        f[4 * s_ + 2] = LDA128(QGb + (16 * (ca) + r16) * 144 + 32 * ((sh) + s_) + 8 * qp); f[4 * s_ + 3] = LDA128(QGb + (16 * (cb) + r16) * 144 + 32 * ((sh) + s_) + 8 * qp); } } while (0)
#define MM_VO2(f, ca, cb, sh) do { _Pragma("unroll") for (int s_ = 0; s_ < 2; ++s_) { \
        vn[ca] = MFMA16(f[4 * s_ + 0], sb[(sh) + s_], vn[ca]); vn[cb] = MFMA16(f[4 * s_ + 1], sb[(sh) + s_], vn[cb]); \
        o[ca] = MFMA16(f[4 * s_ + 2], sb[(sh) + s_], o[ca]); o[cb] = MFMA16(f[4 * s_ + 3], sb[(sh) + s_], o[cb]); } } while (0)
#define LD_AQ(f) do { _Pragma("unroll") for (int c_ = 0; c_ < 4; ++c_) { f[c_] = LDA128(AQb + (16 * c_ + r16) * 80 + 8 * qp); f[4 + c_] = LDA128(AQb + (16 * c_ + r16) * 80 + 32 + 8 * qp); } } while (0)
#define MM_AQ(f) do { _Pragma("unroll") for (int c_ = 0; c_ < 4; ++c_) o[c_] = MFMA16(f[c_], vb[0], o[c_]); _Pragma("unroll") for (int c_ = 0; c_ < 4; ++c_) o[c_] = MFMA16(f[4 + c_], vb[1], o[c_]); } while (0)
#define LD_KD(f, k0) do { _Pragma("unroll") for (int c_ = 0; c_ < 4; ++c_) { f[c_] = LDA128(KDb + (16 * ((k0) + c_) + r16) * 80 + 8 * qp); f[4 + c_] = LDA128(KDb + (16 * ((k0) + c_) + r16) * 80 + 32 + 8 * qp); } } while (0)
#define MM_KD(f, k0) do { _Pragma("unroll") for (int c_ = 0; c_ < 4; ++c_) S[(k0) + c_] = MFMA16(f[c_], vb[0], S[(k0) + c_] * gl); _Pragma("unroll") for (int c_ = 0; c_ < 4; ++c_) S[(k0) + c_] = MFMA16(f[4 + c_], vb[1], S[(k0) + c_]); } while (0)
    LD_VO2(fa, 0, 1, 0); LD_VO2(fb, 0, 1, 2); SB();
    MM_VO2(fa, 0, 1, 0); SB(); LD_VO2(fa, 2, 3, 0); SB();
    MM_VO2(fb, 0, 1, 2); SB(); LD_VO2(fb, 2, 3, 2); SB();
    MM_VO2(fa, 2, 3, 0); SB(); LD_AQ(fa); SB();
    MM_VO2(fb, 2, 3, 2); SB(); LD_KD(fb, 0); SB();
    bf16x8 vb[2];
#pragma unroll
    for (int s = 0; s < 2; ++s) vb[s] = packB(vn[2 * s], vn[2 * s + 1]);
    MM_AQ(fa); SB(); LD_KD(fa, 4); SB();
    MM_KD(fb, 0); SB();
    MM_KD(fa, 4); SB();
#undef SB
#undef LD_VO2
#undef MM_VO2
#undef LD_AQ
#undef MM_AQ
#undef LD_KD
#undef MM_KD
    {
        float v16[16];
#pragma unroll
        for (int ct = 0; ct < 4; ++ct)
#pragma unroll
            for (int e = 0; e < 4; ++e) v16[4 * ct + e] = o[ct][e] * o[ct][e];
#define DPPF(x, ctrl) __builtin_bit_cast(float, __builtin_amdgcn_update_dpp(0, __builtin_bit_cast(int, (x)), (ctrl), 0xF, 0xF, false))
        float w8[8], w4[4], w2[2];
        const bool b3 = r16 & 8, b2 = r16 & 4, b1 = r16 & 2, b0 = r16 & 1;
#pragma unroll
        for (int j = 0; j < 8; ++j) { const float keep = b3 ? v16[j + 8] : v16[j], send = b3 ? v16[j] : v16[j + 8]; w8[j] = keep + DPPF(send, 0x128); }
#pragma unroll
        for (int j = 0; j < 4; ++j) { const float keep = b2 ? w8[j + 4] : w8[j], send = b2 ? w8[j] : w8[j + 4]; w4[j] = keep + DPPF(send, 0x141); }
#pragma unroll
        for (int j = 0; j < 2; ++j) { const float keep = b1 ? w4[j + 2] : w4[j], send = b1 ? w4[j] : w4[j + 2]; w2[j] = keep + DPPF(send, 0x1B); }
        const float keep = b0 ? w2[1] : w2[0], send = b0 ? w2[0] : w2[1];
        const float tot = keep + DPPF(send, 0xB1);
#undef DPPF
        if (accum) atomicAdd((float*)(a.ws + WS_SUMSQ) + (size_t)(b * SEQ + 64 * n + 16 * (r16 >> 2) + 4 * qp + (r16 & 3)) * 8 + h, tot);
    }
    if (n + 1 < 32) scan_store(lds + ((n + 1) & 1) * SC_BUF, T.stg);
    const int rowb = b * SEQ + 64 * n;
#pragma unroll
    for (int ct = 0; ct < 4; ++ct)
#pragma unroll
        for (int e = 0; e < 4; ++e) Y[(size_t)(rowb + 16 * ct + 4 * qp + e) * 2048 + 512 + h * 128 + 16 * wid + r16] = (bf16_t)f2bf(o[ct][e] * dnw);
    __syncthreads();
}

__device__ __forceinline__ void scan_bh(const Args& a, LAS unsigned char* lds, int bh, bool accum = true) {
    int tid_ = threadIdx.x; asm volatile("" : "+v"(tid_));
    const int tid = tid_, lane = tid & 63, wid = tid >> 6, r16 = lane & 15, qp = lane >> 4;
    const float dnw = a.dn_w[16 * wid + r16];
    f32x4 S[8];
#pragma unroll
    for (int kt = 0; kt < 8; ++kt) S[kt] = (f32x4){0.f, 0.f, 0.f, 0.f};
    ScanSet T;
    __syncthreads();
    scan_load_set(a, bh, 0, T, lane, wid);
    scan_store(lds, T.stg);
    __syncthreads();
#pragma unroll 1
    for (int n = 0; n < 32; ++n) scan_step(a, lds, bh, n, S, T, dnw, lane, wid, r16, qp, accum);
}

__device__ __forceinline__ void attn_item(const Args& a, LAS unsigned char* lds, int item) {
    int tid_ = threadIdx.x; asm volatile("" : "+v"(tid_));
    const int tid = tid_, lane = tid & 63, wid = tid >> 6, r16 = lane & 15, qp = lane >> 4;
    const int qt = item & 15, head = (item >> 4) & 3, b = item >> 6;
    LAS bf16_t* Ks = (LAS bf16_t*)lds;
    LAS bf16_t* Vt = (LAS bf16_t*)(lds + 69632);
    const bf16_t* KM = (const bf16_t*)(a.ws + WS_KMEM); const bf16_t* VM = (const bf16_t*)(a.ws + WS_VMEMT); const bf16_t* QM = (const bf16_t*)(a.ws + WS_QM);
    __syncthreads();
#pragma unroll
    for (int i = 0; i < 8; ++i) { const int p = tid + 512 * i;
        { const int key = p >> 4, d8 = p & 15; *(LAS u32x4*)(Ks + key * 136 + d8 * 8) = *(const u32x4*)(KM + (size_t)(b * 256 + key) * 512 + head * 128 + d8 * 8); }
        { const int d = p >> 5, k8 = p & 31; *(LAS u32x4*)(Vt + d * 264 + k8 * 8) = *(const u32x4*)(VM + (size_t)(head * 128 + d) * 2048 + b * 256 + k8 * 8); } }
    const int qrow = b * SEQ + qt * 128 + 16 * wid + r16;
    bf16x8 qf[4];
#pragma unroll
    for (int s = 0; s < 4; ++s) qf[s] = *(const bf16x8*)(QM + (size_t)qrow * 512 + head * 128 + 32 * s + 8 * qp);
    __syncthreads();
    f32x4 sc[16];
#pragma unroll
    for (int kt = 0; kt < 16; ++kt) { sc[kt] = (f32x4){0.f, 0.f, 0.f, 0.f};
#pragma unroll
        for (int s = 0; s < 4; ++s) sc[kt] = MFMA16(*(const LAS bf16x8*)(Ks + (16 * kt + r16) * 136 + 32 * s + 8 * qp), qf[s], sc[kt]); }
    float mx = -3.0e38f;
#pragma unroll
    for (int kt = 0; kt < 16; ++kt) mx = fmaxf(fmaxf(fmaxf(sc[kt][0], sc[kt][1]), fmaxf(sc[kt][2], sc[kt][3])), mx);
    mx = fmaxf(mx, __shfl_xor(mx, 16)); mx = fmaxf(mx, __shfl_xor(mx, 32));
    const float scl = 0.08838834764831845f; float sum = 0.f;
#pragma unroll
    for (int kt = 0; kt < 16; ++kt)
#pragma unroll
        for (int e = 0; e < 4; ++e) { const float p = __expf((sc[kt][e] - mx) * scl); sc[kt][e] = p; sum += p; }
    sum += __shfl_xor(sum, 16); sum += __shfl_xor(sum, 32);
    f32x4 o[8];
#pragma unroll
    for (int dt = 0; dt < 8; ++dt) o[dt] = (f32x4){0.f, 0.f, 0.f, 0.f};
#pragma unroll
    for (int s = 0; s < 8; ++s) { const bf16x8 pb = packB(sc[2 * s], sc[2 * s + 1]);
#pragma unroll
        for (int dt = 0; dt < 8; ++dt) o[dt] = MFMA16(ldA_perm(Vt + (16 * dt + r16) * 264 + 32 * s + 4 * qp), pb, o[dt]); }
    const float inv = 1.f / sum;
    bf16_t* Y = (bf16_t*)a.out;
#pragma unroll
    for (int dt = 0; dt < 8; ++dt) { u32x2 w; w.x = pk2(o[dt][0] * inv, o[dt][1] * inv); w.y = pk2(o[dt][2] * inv, o[dt][3] * inv);
        *(u32x2*)(Y + (size_t)qrow * 2048 + 1536 + head * 128 + 16 * dt + 4 * qp) = w; }
}

__device__ __forceinline__ void pool_item(const Args& a, LAS unsigned char* lds, int item) {
    int tid_ = threadIdx.x; asm volatile("" : "+v"(tid_));
    const int tid = tid_, lane = tid & 63, wid = tid >> 6, r16 = lane & 15, qp = lane >> 4;
    const int g = item & 3, tt = (item >> 2) & 31, b = item >> 7;
    LAS bf16_t* Xs = (LAS bf16_t*)lds;
    LAS bf16_t* Ps = (LAS bf16_t*)(lds + 20480);
    const bf16_t* XA = (const bf16_t*)(a.ws + WS_XA);
    const int t0 = tt * 64;
    __syncthreads();
    for (int p = tid; p < 1280; p += 512) { const int row = p >> 4, c8 = p & 15; const int t = t0 - 16 + row; u32x4 v = (u32x4){0u, 0u, 0u, 0u};
        if (t >= 0) v = *(const u32x4*)(XA + (size_t)(b * SEQ + t) * 512 + g * 128 + c8 * 8);
        *(LAS u32x4*)(Xs + row * 128 + c8 * 8) = v; }
    __syncthreads();
    {
        const int c = tid & 127, rgp = tid >> 7, w = 2 << g; float sum = 0.f;
        for (int j = 1; j < w; ++j) sum += bflo((unsigned)Xs[(16 + 16 * rgp - j) * 128 + c]);
        const float invw = 1.f / (float)w;
#pragma unroll 4
        for (int i = 0; i < 16; ++i) { const int row = 16 * rgp + i; const float xv = bflo((unsigned)Xs[(16 + row) * 128 + c]); sum += xv;
            const int t = t0 + row; const float mean = (t + 1 >= w) ? sum * invw : sum / (float)(t + 1);
            Ps[row * 136 + c] = (bf16_t)f2bf(mean - xv);
            sum -= bflo((unsigned)Xs[(16 + row - (w - 1)) * 128 + c]); }
    }
    __syncthreads();
    const bf16_t* WX = (const bf16_t*)(a.ws + WS_WMIX) + g * 16384;
    f32x4 acc[4];
#pragma unroll
    for (int t4 = 0; t4 < 4; ++t4) acc[t4] = (f32x4){0.f, 0.f, 0.f, 0.f};
#pragma unroll
    for (int s = 0; s < 4; ++s) { const bf16x8 af = *(const bf16x8*)(WX + (16 * wid + r16) * 128 + 32 * s + 8 * qp);
#pragma unroll
        for (int t4 = 0; t4 < 4; ++t4) acc[t4] = MFMA16(af, *(const LAS bf16x8*)(Ps + (16 * t4 + r16) * 136 + 32 * s + 8 * qp), acc[t4]); }
    const f32x4 psc = *(const f32x4*)(a.pool_scale + g * 128 + 16 * wid + 4 * qp);
    bf16_t* Y = (bf16_t*)a.out;
#pragma unroll
    for (int t4 = 0; t4 < 4; ++t4) { u32x2 w2; w2.x = pk2(acc[t4][0] * psc[0], acc[t4][1] * psc[1]); w2.y = pk2(acc[t4][2] * psc[2], acc[t4][3] * psc[3]);
        *(u32x2*)(Y + (size_t)(b * SEQ + t0 + 16 * t4 + r16) * 2048 + g * 128 + 16 * wid + 4 * qp) = w2; }
}

#ifndef REP_P0
#define REP_P0 1
#endif
#ifndef REP_P1
#define REP_P1 1
#endif
#ifndef REP_P3
#define REP_P3 1
#endif
#ifndef REP_P5
#define REP_P5 1
#endif
#define P0_BODY if (IN(0)) p0_prologue(a, lds);
#define P1_BODY \
    if (IN(1)) { \
        {   pg8::Gemm g{(const bf16_t*)(ws + WS_H), (const bf16_t*)(ws + WS_WT), 1024, 1024, 1024}; pg8::StaticOrder S; S.init(M, 4096, G, bx); \
            pg8::EpiStage1 E{(bf16_t*)(ws + WS_XA), (bf16_t*)(ws + WS_QM), (bf16_t*)(ws + WS_QKV), (bf16_t*)(ws + WS_HALO)}; \
            pg8::gemm_phase(lds, g, S, E); } \
    }
#ifndef REP_SCAN
#define REP_SCAN 1
#endif
#ifndef REP_ATTN
#define REP_ATTN 1
#endif
#ifndef REP_POOL
#define REP_POOL 1
#endif
#define P3_BODY \
    if (IN(3)) { \
        unsigned* kvcnt = (unsigned*)(ws + WS_CTL) + 8192; \
        if (G >= 128) { \
            if (bx < 64) { for (int rep = 0; rep < REP_SCAN; ++rep) scan_bh(a, lds, bx, rep == 0); } \
            else { const int c = bx - 64, GG = G - 64; \
                if (c < 32) { \
                    pg8::OneUnit S1; \
                    if (c < 16) { S1.u.pm = c >> 1; S1.u.pn = c & 1; pg8::Gemm g{(const bf16_t*)(ws + WS_MEMN), (const bf16_t*)(ws + WS_WKV), 1024, 1024, 1024}; pg8::EpiPlain E{(bf16_t*)(ws + WS_KMEM), 512}; pg8::gemm_phase(lds, g, S1, E); } \
                    else { S1.u.pm = (c - 16) >> 3; S1.u.pn = (c - 16) & 7; pg8::Gemm g{(const bf16_t*)(ws + WS_WKV) + (size_t)512 * 1024, (const bf16_t*)(ws + WS_MEMN), 1024, 1024, 1024}; pg8::EpiPlain E{(bf16_t*)(ws + WS_VMEMT), 2048}; pg8::gemm_phase(lds, g, S1, E); } \
                    asm volatile("s_waitcnt vmcnt(0)" ::: "memory"); __syncthreads(); \
                    if (tid == 0) { __builtin_amdgcn_fence(__ATOMIC_RELEASE, "agent"); asm volatile("s_waitcnt vmcnt(0)" ::: "memory"); __hip_atomic_fetch_add(kvcnt, 1u, __ATOMIC_RELAXED, __HIP_MEMORY_SCOPE_AGENT); } \
                } \
                bool kv_ok = false; \
                for (int it = c; it < 1024 * REP_POOL + 512 * REP_ATTN; it += GG) { \
                    if (it < 1024 * REP_POOL) pool_item(a, lds, it & 1023); \
                    else { \
                        if (!kv_ok) { if (tid == 0) { unsigned sp = 0; while (__hip_atomic_load(kvcnt, __ATOMIC_RELAXED, __HIP_MEMORY_SCOPE_AGENT) < 32u) { __builtin_amdgcn_s_sleep(2); if (++sp > (1u << 20)) break; } \
                                __builtin_amdgcn_fence(__ATOMIC_ACQUIRE, "agent"); asm volatile("s_waitcnt vmcnt(0)" ::: "memory"); } __syncthreads(); kv_ok = true; } \
                        attn_item(a, lds, (it - 1024 * REP_POOL) & 511); } } \
                late_transposes(a, lds, c, GG); } \
        } else { \
            for (int it = bx; it < 32; it += G) { pg8::OneUnit S1; \
                    if (it < 16) { S1.u.pm = it >> 1; S1.u.pn = it & 1; pg8::Gemm g{(const bf16_t*)(ws + WS_MEMN), (const bf16_t*)(ws + WS_WKV), 1024, 1024, 1024}; pg8::EpiPlain E{(bf16_t*)(ws + WS_KMEM), 512}; pg8::gemm_phase(lds, g, S1, E); } \
                    else { S1.u.pm = (it - 16) >> 3; S1.u.pn = (it - 16) & 7; pg8::Gemm g{(const bf16_t*)(ws + WS_WKV) + (size_t)512 * 1024, (const bf16_t*)(ws + WS_MEMN), 1024, 1024, 1024}; pg8::EpiPlain E{(bf16_t*)(ws + WS_VMEMT), 2048}; pg8::gemm_phase(lds, g, S1, E); } } \
            xcd_barrier(xbar); \
            for (int it = bx; it < 64 + 512 + 1024; it += G) { if (it < 64) scan_bh(a, lds, it); else if (it < 576) attn_item(a, lds, it - 64); else pool_item(a, lds, it - 576); } \
            late_transposes(a, lds, bx, G); \
        } \
    }
#define P5_BODY \
    if (IN(5)) { \
        pg8::StaticOrder SO; SO.init(M, 1024, G, bx); \
        pg8::OneUnit S1; \
        if (SO.next(0, S1.u)) { \
            bf16_t* Y = (bf16_t*)(ws + WS_Y); const bf16_t* YC = (const bf16_t*)a.out; const bf16_t* GT = (const bf16_t*)(ws + WS_GATE); \
            {   pg8::Gemm g{YC, (const bf16_t*)(ws + WS_WP), 2048, 512, 512}; pg8::EpiProj<0> E{GT, Y}; pg8::gemm_phase(lds, g, S1, E); } \
            {   pg8::Gemm g{YC + 512, (const bf16_t*)(ws + WS_WD), 2048, 1024, 1024}; pg8::EpiProj<1> E{GT, Y}; pg8::gemm_phase(lds, g, S1, E); } \
            {   pg8::Gemm g{YC + 1536, (const bf16_t*)(ws + WS_WM), 2048, 512, 512}; pg8::EpiProj<2> E{GT, Y}; pg8::gemm_phase(lds, g, S1, E); } \
        } \
    }
__global__ void __launch_bounds__(512, 2) hybrid_fwd(Args a) {
    extern __shared__ __attribute__((aligned(16))) unsigned char lds_raw[];
    LAS unsigned char* lds = (LAS unsigned char*)lds_raw;
    const int G = gridDim.x, bx = blockIdx.x, tid = threadIdx.x;
    unsigned char* ws = a.ws;
    const int lo = a.ph_lo, hi = a.ph_hi;
    volatile LAS unsigned* xst = (volatile LAS unsigned*)(lds + LDS_BYTES - 16);
    if (tid < 4) xst[tid] = 0u;
    __syncthreads();
    XcdBarrier xbar; xbar.bar = (unsigned*)(ws + WS_CTL); xbar.x = 0; xbar.st = xst;
    if (hi - lo > 1) xbar = xcd_barrier_post((unsigned*)(ws + WS_CTL), xst);
    if (lo == 0x7fffffff) cg::this_grid().sync();
#define IN(k) (lo <= (k) && (k) < hi)
#define SEAM(k) do { if (IN(k) && IN((k) + 1)) xcd_barrier(xbar); } while (0)
    P0_BODY
#if REP_P0 > 1
    xcd_barrier(xbar);
    P0_BODY
#endif
    SEAM(0);
#ifndef REP_P12
#define REP_P12 1
#endif
    for (int rep12 = 0; rep12 < REP_P12; ++rep12) {
    if (rep12) xcd_barrier(xbar);
    P1_BODY
#if REP_P1 > 1
    xcd_barrier(xbar);
    P1_BODY
#endif
    SEAM(1);
#ifndef NO_P2
    if (IN(2)) { u32x4 raw[11]; float gpre = 0.f, bpre = 0.f; if (bx < 2048) { chunk_load_raw(a, bx, raw, tid); if (tid < 64) { const int n2 = bx & 31, h2 = (bx >> 5) & 7, b2 = bx >> 8; const int r2 = b2 * SEQ + 64 * n2; gpre = ((const float*)(ws + WS_G))[(size_t)(r2 + tid) * 8 + h2]; bpre = ((const float*)(ws + WS_BETA))[(size_t)(r2 + tid) * 8 + h2]; } }
#pragma unroll 1
        for (int it0 = bx; it0 < 2048; it0 += 2 * G) {
            const int it1 = it0 + G; const int nvalid = (it1 < 2048) ? 2 : 1;
#pragma unroll 1
            for (int ms = 0; ms < 5; ++ms) {
                const int st = (ms < 2) ? 0 : (ms == 2 ? 1 : 2); const int st_set = (ms == 1 || ms == 4) ? 1 : 0;
                if (st != 1 && st_set == 1 && nvalid < 2) continue;
                const int itc = st_set ? it1 : it0;
                chunk_prep_item(a, lds, itc, raw, (itc + G < 2048) ? itc + G : -1, gpre, bpre, st_set, st, nvalid);
            }
        } }
#endif
    }
    SEAM(2);
    P3_BODY
#if REP_P3 > 1
    xcd_barrier(xbar);
    P3_BODY
#endif
    SEAM(3);
    if (IN(4)) {
        {   pg8::Gemm g{(const bf16_t*)(ws + WS_H), (const bf16_t*)(ws + WS_WT) + (size_t)4096 * 1024, 1024, 1024, 1024}; pg8::StaticOrder S; S.init(M, 2048, G, bx);
            pg8::EpiZ E{(bf16_t*)a.out, (const float*)(ws + WS_SUMSQ)}; pg8::gemm_phase(lds, g, S, E); }
        {   pg8::Gemm g{(const bf16_t*)(ws + WS_H), (const bf16_t*)(ws + WS_WT) + (size_t)6144 * 1024, 1024, 1024, 1024}; pg8::StaticOrder S; S.init(M, 3072, G, bx);
            pg8::EpiGate E{(bf16_t*)(ws + WS_GATE)}; pg8::gemm_phase(lds, g, S, E); }
    }
    SEAM(4);
    P5_BODY
#if REP_P5 > 1
    xcd_barrier(xbar);
    P5_BODY
#endif
    SEAM(5);
    if (IN(6)) {
        pg8::Gemm g{(const bf16_t*)(ws + WS_Y), (const bf16_t*)(ws + WS_WOUT), 1024, 1024, 1024}; pg8::StaticOrder S; S.init(M, 1024, G, bx);
        pg8::EpiOutNorm E{a.out, a.x, a.post_w, (float*)(ws + WS_ROWSS), (unsigned*)(ws + WS_CTL) + 4096};
        pg8::gemm_phase(lds, g, S, E);
    }
#undef IN
#undef SEAM
}

extern "C" void kernel_launch(void* const* d_in, const int* in_sizes, int n_in, void* d_out, int out_size, void* d_ws, size_t ws_size, hipStream_t stream) {
    static int grid = 0;
    if (grid == 0) {
        if (n_in != 17 || out_size != M * DM || ws_size < WS_END) { fprintf(stderr, "kernel_launch: unexpected shapes (n_in %d out %d ws %zu)\n", n_in, out_size, ws_size); grid = -1; return; }
        int dev = 0, cus = 0, per_cu = 0;
        hipGetDevice(&dev); hipDeviceGetAttribute(&cus, hipDeviceAttributeMultiprocessorCount, dev);
        if (hipFuncSetAttribute((const void*)hybrid_fwd, hipFuncAttributeMaxDynamicSharedMemorySize, LDS_BYTES) != hipSuccess) { fprintf(stderr, "kernel_launch: hipFuncSetAttribute failed\n"); grid = -1; return; }
        if (hipOccupancyMaxActiveBlocksPerMultiprocessor(&per_cu, (const void*)hybrid_fwd, 512, LDS_BYTES) != hipSuccess || per_cu < 1) { fprintf(stderr, "kernel_launch: occupancy query gives %d\n", per_cu); per_cu = 1; }
        (void)hipGetLastError();
        grid = cus * 1;
        if (grid > 256) grid = 256;
    }
    if (grid < 0) return;
    Args a{};
    a.x = (const float*)d_in[0]; a.mem = (const float*)d_in[1]; a.pre_w = (const float*)d_in[2]; a.mem_w = (const float*)d_in[3]; a.w_in = (const float*)d_in[4];
    a.conv_w = (const float*)d_in[5]; a.a_log = (const float*)d_in[6]; a.dt_bias = (const float*)d_in[7]; a.dn_w = (const float*)d_in[8]; a.mix_w = (const float*)d_in[9];
    a.pool_scale = (const float*)d_in[10]; a.w_kv = (const float*)d_in[11]; a.w_pp = (const float*)d_in[12]; a.w_pd = (const float*)d_in[13]; a.w_pm = (const float*)d_in[14];
    a.w_out = (const float*)d_in[15]; a.post_w = (const float*)d_in[16];
    a.out = (float*)d_out; a.ws = (unsigned char*)d_ws;
#if MK_PER_PHASE
    for (int p = 0; p < 7; ++p) { a.ph_lo = p; a.ph_hi = p + 1; hipLaunchKernelGGL(hybrid_fwd, dim3(grid), dim3(512), LDS_BYTES, stream, a); }
#else
    a.ph_lo = 0; a.ph_hi = 7;
    if (hipMemsetAsync((char*)d_ws + WS_CTL, 0, 65536, stream) != hipSuccess) { fprintf(stderr, "kernel_launch: memset of the barrier words failed\n"); return; }
    void* args[] = {&a};
    hipError_t e = hipLaunchCooperativeKernel((const void*)hybrid_fwd, dim3(grid), dim3(512), args, LDS_BYTES, stream);
    if (e != hipSuccess) fprintf(stderr, "kernel_launch: cooperative launch failed: %s (grid %d)\n", hipGetErrorString(e), grid);
#endif
}
```

```cpp
#include <hip/hip_runtime.h>
#include <hip/hip_cooperative_groups.h>
#include <cstdio>
#include <cstdint>
namespace cg = cooperative_groups;

#ifndef MK_PER_PHASE
#define MK_PER_PHASE 0
#endif

#define LAS __attribute__((address_space(3)))
typedef unsigned short bf16_t;
typedef short bf16x8 __attribute__((ext_vector_type(8)));
typedef float f32x4 __attribute__((ext_vector_type(4)));
typedef unsigned u32x4 __attribute__((ext_vector_type(4)));
typedef unsigned u32x2 __attribute__((ext_vector_type(2)));

constexpr int DM = 1024, NB = 8, SEQ = 2048, M = NB * SEQ, INW = 9232, MEML = 256;
constexpr float EPS = 1e-6f;
constexpr size_t MiB = 1u << 20;
constexpr size_t WS_WT = 0;
constexpr size_t WS_WKV = 18 * MiB;
constexpr size_t WS_WP = 20 * MiB;
constexpr size_t WS_WD = 21 * MiB;
constexpr size_t WS_WM = 23 * MiB;
constexpr size_t WS_WOUT = 24 * MiB;
constexpr size_t WS_WMIX = 26 * MiB;
constexpr size_t WS_G = 26 * MiB + 256 * 1024;
constexpr size_t WS_BETA = WS_G + 512 * 1024;
constexpr size_t WS_ROWSS = WS_BETA + 512 * 1024;
constexpr size_t WS_GL = WS_ROWSS + 64 * 1024;
constexpr size_t WS_SUMSQ = 27 * MiB + 384 * 1024;
constexpr size_t WS_H = 28 * MiB;
constexpr size_t WS_MEMN = 60 * MiB;
constexpr size_t WS_KMEM = 64 * MiB;
constexpr size_t WS_VMEMT = 66 * MiB;
constexpr size_t WS_XA = 68 * MiB;
constexpr size_t WS_QM = 84 * MiB;
constexpr size_t WS_QKV = 100 * MiB;
constexpr size_t WS_HALO = 196 * MiB;
constexpr size_t WS_U = 201 * MiB;
constexpr size_t WS_AQK = 233 * MiB;
constexpr size_t WS_CTL = 250 * MiB;
constexpr size_t WS_END = 251 * MiB;
constexpr size_t WS_Y = WS_XA;
constexpr size_t WS_GATE = WS_QKV;
constexpr int LDS_BYTES = 147456;

__device__ __forceinline__ unsigned f2bf(float f) { unsigned u = __float_as_uint(f); return (u + 0x7fffu + ((u >> 16) & 1u)) >> 16; }
typedef __bf16 bf16x2_t __attribute__((ext_vector_type(2)));
typedef float f32x2_t __attribute__((ext_vector_type(2)));
__device__ __forceinline__ unsigned pk2(float lo, float hi) { f32x2_t v = {lo, hi}; bf16x2_t b = __builtin_convertvector(v, bf16x2_t); return __builtin_bit_cast(unsigned, b); }
__device__ __forceinline__ float bflo(unsigned u) { return __uint_as_float(u << 16); }
__device__ __forceinline__ float bfhi(unsigned u) { return __uint_as_float(u & 0xffff0000u); }
__device__ __forceinline__ unsigned cvt_pk_bf16(float lo, float hi) { unsigned r; asm volatile("v_cvt_pk_bf16_f32 %0, %1, %2" : "=v"(r) : "v"(lo), "v"(hi)); return r; }
__device__ __forceinline__ float silu_f(float z) { return z * __builtin_amdgcn_rcpf(1.f + __expf(-z)); }
__device__ __forceinline__ float sigm_f(float z) { return __builtin_amdgcn_rcpf(1.f + __expf(-z)); }
#define LDS_WAIT() asm volatile("s_waitcnt lgkmcnt(0)" ::: "memory")
#define MFMA16(a, b, c) __builtin_amdgcn_mfma_f32_16x16x32_bf16((a), (b), (c), 0, 0, 0)

namespace pg8 {
constexpr int BM = 256, BK = 64, HALF = 128, HTB = HALF * BK * 2, STAGE_BYTES = 8 * HTB, NXCD = 8, WGM = 4;
__host__ __device__ __forceinline__ int lds_byte(int r, int c) { const int st = (r >> 4) * 2 + (c >> 5), rr = r & 15, cc = c & 31, ob = rr * 64 + cc * 2; return st * 1024 + (ob ^ (((ob >> 9) & 1) << 5)); }
__host__ __device__ __forceinline__ void stage_rc(int b, int& R, int& C) { const int st = b / 1024, sb = b % 1024, swz = sb ^ (((sb >> 9) & 1) << 5); R = (st >> 1) * 16 + swz / 64; C = (st & 1) * 32 + (swz % 64) / 2; }
__host__ __device__ __forceinline__ int perm32(int rho) { const int n = rho >> 4, i = rho & 15; return 8 * (i >> 2) + 4 * n + (i & 3); }
struct Unit { int pm, pn; };
struct Gemm { const bf16_t* A; const bf16_t* Bt; int lda, ldb, K; };
struct StaticOrder {
    int nM, nN, nwg, G, c;
    __device__ void init(int Mr, int Nc, int G_, int c_) { nM = Mr / BM; nN = Nc / BM; nwg = nM * nN; G = G_; c = c_; }
    __device__ bool next(int i, Unit& u) const {
        const long L = (long)i * G + c; if (L >= nwg) return false;
        int wgid = (int)L; { const int q = nwg / NXCD, r = nwg % NXCD, xcd = wgid % NXCD, off = wgid / NXCD; wgid = (xcd < r ? xcd * (q + 1) : r * (q + 1) + (xcd - r) * q) + off; }
        const int nig = WGM * nN, gid = wgid / nig, fm = gid * WGM, gsz = (nM - fm) < WGM ? (nM - fm) : WGM;
        u.pm = fm + ((wgid % nig) % gsz); u.pn = (wgid % nig) / gsz; return true;
    }
};
struct OneUnit {
    Unit u;
    __device__ bool next(int i, Unit& o) const { if (i) return false; o = u; return true; }
};

template <class Epi, class Sched>
__device__ __forceinline__ void gemm_phase(LAS unsigned char* lds, const Gemm g, const Sched& S, const Epi& E) {
    int tid_ = threadIdx.x; asm volatile("" : "+v"(tid_));
    const int tid = tid_, wid = __builtin_amdgcn_readfirstlane(tid >> 6), lane = tid & 63, wr = wid >> 2, wc = wid & 3, fr = lane & 15, fq = lane >> 4;
    const int K = g.K, nt = K / BK;
    unsigned voffA[2], voffB[2];
#pragma unroll
    for (int i = 0; i < 2; ++i) { int R, C; stage_rc(tid * 16 + i * 8192, R, C); const int Rb = (R & ~31) + perm32(R & 31);
        voffA[i] = (unsigned)(R * g.lda + C) * 2u; voffB[i] = (unsigned)(Rb * g.ldb + C) * 2u; }
    const size_t kstep = (size_t)(BK * 2);
    const size_t hstepA = (size_t)HALF * g.lda * 2, hstepB = (size_t)HALF * g.ldb * 2;
    const size_t tstepA = 2 * hstepA, tstepB = 2 * hstepB;
    const unsigned ldsw = (unsigned)wid * 1024u;
    const int aoff = lds_byte(wr * 64 + fr, fq * 8), boff = lds_byte(wc * 32 + fr, fq * 8);
#define PG8_SA(b, h) (((b) * 2 + (h)) * HTB)
#define PG8_SB(b, h) ((4 + (b) * 2 + (h)) * HTB)
#define PG8_STAGE(bufoff, gbase, voff) do { _Pragma("unroll") for (int _i = 0; _i < 2; ++_i) \
        __builtin_amdgcn_global_load_lds((const unsigned*)((const char*)(gbase) + (voff)[_i]), (LAS unsigned*)(lds + (bufoff) + ldsw + _i * 8192), 16, 0, 0); } while (0)
#define PG8_LDA(dst, b, h) do { _Pragma("unroll") for (int m = 0; m < 4; ++m) _Pragma("unroll") for (int k = 0; k < 2; ++k) dst[m][k] = *(const LAS bf16x8*)(lds + PG8_SA(b, h) + aoff + m * 2048 + k * 1024); } while (0)
#define PG8_LDB(dst, b, h) do { _Pragma("unroll") for (int n = 0; n < 2; ++n) _Pragma("unroll") for (int k = 0; k < 2; ++k) dst[n][k] = *(const LAS bf16x8*)(lds + PG8_SB(b, h) + boff + n * 2048 + k * 1024); } while (0)
#define PG8_MMA(ai, bj, At, Bt) do { __builtin_amdgcn_s_setprio(1); _Pragma("unroll") for (int m = 0; m < 4; ++m) _Pragma("unroll") for (int n = 0; n < 2; ++n) _Pragma("unroll") for (int k = 0; k < 2; ++k) \
        acc[ai][bj][m][n] = __builtin_amdgcn_mfma_f32_16x16x32_bf16(Bt[n][k], At[m][k], acc[ai][bj][m][n], 0, 0, 0); __builtin_amdgcn_s_setprio(0); } while (0)
#define PG8_WAIT_V(n) asm volatile("s_waitcnt vmcnt(" #n ")" ::: "memory")
#define PG8_WAIT_L(n) asm volatile("s_waitcnt lgkmcnt(" #n ")" ::: "memory")
#define PG8_BAR __builtin_amdgcn_s_barrier()
#define PG8_SCHED __builtin_amdgcn_sched_barrier(0)
    Unit cur, nxt; int ui = 0;
    if (!S.next(0, cur)) return;
    f32x4 acc[2][2][4][2];
#pragma unroll
    for (int a = 0; a < 2; ++a)
#pragma unroll
        for (int b = 0; b < 2; ++b)
#pragma unroll
            for (int m = 0; m < 4; ++m)
#pragma unroll
                for (int n = 0; n < 2; ++n) acc[a][b][m][n] = (f32x4){0.f, 0.f, 0.f, 0.f};
    bf16x8 At[4][2], B0[2][2], B1[2][2];
    const char* cA = (const char*)g.A + (size_t)cur.pm * tstepA; const char* cB = (const char*)g.Bt + (size_t)cur.pn * tstepB;
    {
        PG8_STAGE(PG8_SB(0, 0), cB, voffB); PG8_STAGE(PG8_SB(0, 1), cB + hstepB, voffB); PG8_STAGE(PG8_SA(0, 0), cA, voffA); PG8_STAGE(PG8_SA(0, 1), cA + hstepA, voffA);
        if (wr == 1) PG8_BAR;
        PG8_WAIT_V(2); PG8_BAR;
        PG8_STAGE(PG8_SB(1, 0), cB + kstep, voffB); PG8_STAGE(PG8_SA(1, 0), cA + kstep, voffA); PG8_STAGE(PG8_SB(1, 1), cB + hstepB + kstep, voffB);
        PG8_WAIT_V(6); PG8_BAR;
    }
    for (;;) {
        const bool has_next = S.next(ui + 1, nxt);
        const char* nA = has_next ? (const char*)g.A + (size_t)nxt.pm * tstepA : cA; const char* nB = has_next ? (const char*)g.Bt + (size_t)nxt.pn * tstepB : cB;
        for (int t = 0; t < nt; t += 2) {
            const bool last = (t == nt - 2);
            const char* a1 = cA + (size_t)(t + 1) * kstep;
            const char* a2 = last ? nA : cA + (size_t)(t + 2) * kstep; const char* b2 = last ? nB : cB + (size_t)(t + 2) * kstep;
            const char* a3 = a2 + kstep; const char* b3 = b2 + kstep;
            PG8_LDB(B0, 0, 0); PG8_LDB(B1, 0, 1); PG8_SCHED; PG8_LDA(At, 0, 0); PG8_STAGE(PG8_SA(1, 1), a1 + hstepA, voffA);
            PG8_WAIT_V(8); PG8_WAIT_L(0); PG8_BAR; PG8_MMA(0, 0, At, B0); PG8_MMA(0, 1, At, B1); PG8_BAR; PG8_SCHED;
            PG8_LDA(At, 0, 1); PG8_STAGE(PG8_SB(0, 0), b2, voffB); PG8_STAGE(PG8_SB(0, 1), b2 + hstepB, voffB); PG8_STAGE(PG8_SA(0, 0), a2, voffA);
            PG8_WAIT_V(8); PG8_WAIT_L(0); PG8_BAR; PG8_MMA(1, 0, At, B0); PG8_MMA(1, 1, At, B1); PG8_BAR; PG8_SCHED;
            PG8_LDB(B0, 1, 0); PG8_LDB(B1, 1, 1); PG8_SCHED; PG8_LDA(At, 1, 0); PG8_STAGE(PG8_SA(0, 1), a2 + hstepA, voffA);
            PG8_WAIT_V(8); PG8_WAIT_L(0); PG8_BAR; PG8_MMA(0, 0, At, B0); PG8_MMA(0, 1, At, B1); PG8_BAR; PG8_SCHED;
            PG8_LDA(At, 1, 1); PG8_STAGE(PG8_SB(1, 0), b3, voffB); PG8_STAGE(PG8_SB(1, 1), b3 + hstepB, voffB); PG8_STAGE(PG8_SA(1, 0), a3, voffA);
            PG8_WAIT_V(8); PG8_WAIT_L(0); PG8_BAR; PG8_MMA(1, 0, At, B0); PG8_MMA(1, 1, At, B1); PG8_BAR; PG8_SCHED;
        }
        if (wr == 0) PG8_BAR;
        E(acc, cur, wr, wc, fr, fq);
        if (!has_next) break;
#pragma unroll
        for (int a = 0; a < 2; ++a)
#pragma unroll
            for (int b = 0; b < 2; ++b)
#pragma unroll
                for (int m = 0; m < 4; ++m)
#pragma unroll
                    for (int n = 0; n < 2; ++n) acc[a][b][m][n] = (f32x4){0.f, 0.f, 0.f, 0.f};
        cur = nxt; cA = nA; cB = nB; ++ui;
        if (wr == 1) PG8_BAR;
    }
    PG8_WAIT_V(0);
    PG8_BAR;
#undef PG8_SA
#undef PG8_SB
#undef PG8_STAGE
#undef PG8_LDA
#undef PG8_LDB
#undef PG8_MMA
#undef PG8_WAIT_V
#undef PG8_WAIT_L
#undef PG8_BAR
#undef PG8_SCHED
}

typedef const f32x4 (&AccRef)[2][2][4][2];
__device__ __forceinline__ u32x4 pack8(f32x4 v0, f32x4 v1) { u32x4 w; w.x = pk2(v0[0], v0[1]); w.y = pk2(v0[2], v0[3]); w.z = pk2(v1[0], v1[1]); w.w = pk2(v1[2], v1[3]); return w; }

struct EpiPlain {
    bf16_t* O; int ldc;
    __device__ __forceinline__ void operator()(AccRef acc, const Unit& u, int wr, int wc, int fr, int fq) const {
        const int row0 = u.pm * BM + wr * 64 + fr, col0 = u.pn * BM + wc * 32 + 8 * fq;
#pragma unroll
        for (int ai = 0; ai < 2; ++ai)
#pragma unroll
            for (int m = 0; m < 4; ++m) { bf16_t* rowp = O + (size_t)(row0 + ai * HALF + m * 16) * ldc + col0;
#pragma unroll
                for (int bj = 0; bj < 2; ++bj) *(u32x4*)(rowp + bj * HALF) = pack8(acc[ai][bj][m][0], acc[ai][bj][m][1]); }
    }
};
struct EpiStage1 {
    bf16_t *xa, *qm, *qkv, *halo;
    __device__ __forceinline__ void operator()(AccRef acc, const Unit& u, int wr, int wc, int fr, int fq) const {
        const int pn = u.pn; bf16_t* base; int ldc, colt;
        if (pn < 2) { base = xa; ldc = 512; colt = pn * 256; }
        else if (pn < 4) { base = qm; ldc = 512; colt = (pn - 2) * 256; }
        else { const int t = (pn - 4) >> 2; base = qkv + (size_t)t * M * 1024; ldc = 1024; colt = ((pn - 4) & 3) * 256; }
        const int row0 = u.pm * BM + wr * 64 + fr, col0 = colt + wc * 32 + 8 * fq;
#pragma unroll
        for (int ai = 0; ai < 2; ++ai)
#pragma unroll
            for (int m = 0; m < 4; ++m) { const int row = row0 + ai * HALF + m * 16; bf16_t* rowp = base + (size_t)row * ldc + col0;
#pragma unroll
                for (int bj = 0; bj < 2; ++bj) { const u32x4 w = pack8(acc[ai][bj][m][0], acc[ai][bj][m][1]);
                    *(u32x4*)(rowp + bj * HALF) = w;
                    if (m == 3 && pn >= 4 && fr >= 13) *(u32x4*)(halo + ((size_t)(row >> 6) * 3 + (fr - 13)) * 3072 + (pn - 4) * 256 + bj * HALF + wc * 32 + 8 * fq) = w; } }
    }
};
struct EpiZ {
    bf16_t* Y; const float* SUMSQ;
    __device__ __forceinline__ void operator()(AccRef acc, const Unit& u, int wr, int wc, int fr, int fq) const {
        int tid = threadIdx.x; asm volatile("" : "+v"(tid)); fr = tid & 15; fq = (tid >> 4) & 3;
        const int row0 = u.pm * BM + wr * 64 + fr, col0 = u.pn * BM + wc * 32 + 8 * fq;
        const bool isdn = (col0 >= 512) && (col0 < 1536); const int hd = isdn ? ((col0 - 512) >> 7) : 0;
#pragma unroll
        for (int ai = 0; ai < 2; ++ai)
#pragma unroll
            for (int mh = 0; mh < 2; ++mh) {
                u32x4 o[2][2]; float sq[2][2];
#pragma unroll
                for (int mm = 0; mm < 2; ++mm)
#pragma unroll
                    for (int bj = 0; bj < 2; ++bj) { const size_t row = (size_t)(row0 + ai * HALF + (2 * mh + mm) * 16);
                        o[mm][bj] = *(const u32x4*)(Y + row * 2048 + col0 + bj * HALF); sq[mm][bj] = SUMSQ[row * 8 + (isdn ? hd + bj : 0)]; }
#pragma unroll
                for (int mm = 0; mm < 2; ++mm)
#pragma unroll
                    for (int bj = 0; bj < 2; ++bj) { const int m = 2 * mh + mm; const size_t row = (size_t)(row0 + ai * HALF + m * 16);
                        const f32x4 a0 = acc[ai][bj][m][0], a1 = acc[ai][bj][m][1]; const u32x4 ov = o[mm][bj];
                        const float fac = isdn ? (1.0f / sqrtf(sq[mm][bj] * (1.f / 128.f) + EPS)) : 1.f;
                        f32x4 v0, v1;
                        v0[0] = bflo(ov.x) * silu_f(a0[0]); v0[1] = bfhi(ov.x) * silu_f(a0[1]); v0[2] = bflo(ov.y) * silu_f(a0[2]); v0[3] = bfhi(ov.y) * silu_f(a0[3]);
                        v1[0] = bflo(ov.z) * silu_f(a1[0]); v1[1] = bfhi(ov.z) * silu_f(a1[1]); v1[2] = bflo(ov.w) * silu_f(a1[2]); v1[3] = bfhi(ov.w) * silu_f(a1[3]);
                        *(u32x4*)(Y + row * 2048 + col0 + bj * HALF) = pack8(v0 * fac, v1 * fac); }
                asm volatile("" ::: "memory"); __builtin_amdgcn_sched_barrier(0);
            }
    }
};
struct EpiGate {
    bf16_t* GATE;
    __device__ __forceinline__ void operator()(AccRef acc, const Unit& u, int wr, int wc, int fr, int fq) const {
        int tid = threadIdx.x; asm volatile("" : "+v"(tid)); fr = tid & 15; fq = (tid >> 4) & 3;
        const int row0 = u.pm * BM + wr * 64 + fr, col0 = u.pn * BM + wc * 32 + 8 * fq;
#pragma unroll
        for (int ai = 0; ai < 2; ++ai)
#pragma unroll
            for (int m = 0; m < 4; ++m) { bf16_t* rowp = GATE + (size_t)(row0 + ai * HALF + m * 16) * 3072 + col0;
#pragma unroll
                for (int bj = 0; bj < 2; ++bj) { const f32x4 a0 = acc[ai][bj][m][0], a1 = acc[ai][bj][m][1]; f32x4 v0, v1;
#pragma unroll
                    for (int e = 0; e < 4; ++e) { v0[e] = sigm_f(a0[e]); v1[e] = sigm_f(a1[e]); }
                    *(u32x4*)(rowp + bj * HALF) = pack8(v0, v1); } }
    }
};
template <int BR> struct EpiProj {
    const bf16_t* GATE; bf16_t* Y;
    __device__ __forceinline__ void operator()(AccRef acc, const Unit& u, int wr, int wc, int fr, int fq) const {
        int tid = threadIdx.x; asm volatile("" : "+v"(tid)); fr = tid & 15; fq = (tid >> 4) & 3;
        const int row0 = u.pm * BM + wr * 64 + fr, col0 = u.pn * BM + wc * 32 + 8 * fq;
#pragma unroll
        for (int ai = 0; ai < 2; ++ai)
#pragma unroll
            for (int mh = 0; mh < 2; ++mh) {
                u32x4 gq[2][2], yo[2][2];
#pragma unroll
                for (int mm = 0; mm < 2; ++mm)
#pragma unroll
                    for (int bj = 0; bj < 2; ++bj) { const size_t row = (size_t)(row0 + ai * HALF + (2 * mh + mm) * 16);
                        gq[mm][bj] = *(const u32x4*)(GATE + row * 3072 + BR * 1024 + col0 + bj * HALF);
                        if (BR > 0) yo[mm][bj] = *(const u32x4*)(Y + row * 1024 + col0 + bj * HALF); }
#pragma unroll
                for (int mm = 0; mm < 2; ++mm)
#pragma unroll
                    for (int bj = 0; bj < 2; ++bj) { const int m = 2 * mh + mm; const size_t row = (size_t)(row0 + ai * HALF + m * 16);
                        const f32x4 a0 = acc[ai][bj][m][0], a1 = acc[ai][bj][m][1]; const u32x4 g4 = gq[mm][bj];
                        f32x4 v0, v1;
                        v0[0] = bflo(g4.x) * a0[0]; v0[1] = bfhi(g4.x) * a0[1]; v0[2] = bflo(g4.y) * a0[2]; v0[3] = bfhi(g4.y) * a0[3];
                        v1[0] = bflo(g4.z) * a1[0]; v1[1] = bfhi(g4.z) * a1[1]; v1[2] = bflo(g4.w) * a1[2]; v1[3] = bfhi(g4.w) * a1[3];
                        if (BR > 0) { const u32x4 y4 = yo[mm][bj];
                            v0[0] += bflo(y4.x); v0[1] += bfhi(y4.x); v0[2] += bflo(y4.y); v0[3] += bfhi(y4.y); v1[0] += bflo(y4.z); v1[1] += bfhi(y4.z); v1[2] += bflo(y4.w); v1[3] += bfhi(y4.w); }
                        *(u32x4*)(Y + row * 1024 + col0 + bj * HALF) = pack8(v0, v1); }
                asm volatile("" ::: "memory"); __builtin_amdgcn_sched_barrier(0);
            }
    }
};
struct EpiOutNorm {
    float* O; const float* X; const float* PW; float* rowss; unsigned* cnt;
    __device__ __forceinline__ void operator()(AccRef acc, const Unit& u, int wr, int wc, int fr, int fq) const {
        int tid = threadIdx.x; asm volatile("" : "+v"(tid)); fr = tid & 15; fq = (tid >> 4) & 3;
        const int row0 = u.pm * BM + wr * 64 + fr, col0 = u.pn * BM + wc * 32 + 8 * fq;
#pragma unroll
        for (int ai = 0; ai < 2; ++ai)
#pragma unroll
            for (int m = 0; m < 4; ++m) { const int row = row0 + ai * HALF + m * 16; float ss = 0.f;
#pragma unroll
                for (int bj = 0; bj < 2; ++bj) { const f32x4 a0 = acc[ai][bj][m][0], a1 = acc[ai][bj][m][1];
                    ss += (a0[0] * a0[0] + a0[1] * a0[1]) + (a0[2] * a0[2] + a0[3] * a0[3]) + (a1[0] * a1[0] + a1[1] * a1[1]) + (a1[2] * a1[2] + a1[3] * a1[3]); }
                ss += __shfl_xor(ss, 16); ss += __shfl_xor(ss, 32);
                if (fq == 0) atomicAdd(rowss + row, ss); }
        asm volatile("s_waitcnt vmcnt(0)" ::: "memory");
        __syncthreads();
        if (threadIdx.x == 0) {
            __hip_atomic_fetch_add(cnt + u.pm * 16, 1u, __ATOMIC_RELAXED, __HIP_MEMORY_SCOPE_AGENT);
            unsigned sp = 0;
            while (__hip_atomic_load(cnt + u.pm * 16, __ATOMIC_RELAXED, __HIP_MEMORY_SCOPE_AGENT) < 4u) { __builtin_amdgcn_s_sleep(1); if (++sp > (1u << 20)) break; }
        }
        __syncthreads();
#pragma unroll
        for (int ai = 0; ai < 2; ++ai)
#pragma unroll
            for (int m = 0; m < 4; ++m) { const int row = row0 + ai * HALF + m * 16;
                const float rs = 1.0f / sqrtf(__hip_atomic_load(rowss + row, __ATOMIC_RELAXED, __HIP_MEMORY_SCOPE_AGENT) * (1.f / 1024.f) + EPS);
                f32x4 xv[2][2];
#pragma unroll
                for (int bj = 0; bj < 2; ++bj) { const size_t off = (size_t)row * 1024 + col0 + bj * HALF; xv[bj][0] = *(const f32x4*)(X + off); xv[bj][1] = *(const f32x4*)(X + off + 4); }
#pragma unroll
                for (int bj = 0; bj < 2; ++bj) { const size_t off = (size_t)row * 1024 + col0 + bj * HALF;
                    const f32x4 w0 = *(const f32x4*)(PW + col0 + bj * HALF), w1 = *(const f32x4*)(PW + col0 + bj * HALF + 4);
                    *(f32x4*)(O + off) = xv[bj][0] + acc[ai][bj][m][0] * rs * w0; *(f32x4*)(O + off + 4) = xv[bj][1] + acc[ai][bj][m][1] * rs * w1; }
                if (m & 1) { asm volatile("" ::: "memory"); __builtin_amdgcn_sched_barrier(0); } }
    }
};
}

#define XB_TMO      128
#define XB_XCNT(j)  (256  + 64 * (j))
#define XB_XSUB(j)  (1280 + 64 * (j))
#define XB_XGEN(j)  (2304 + 64 * (j))
#define XB_TOP      3328
#define XB_TOPGEN   3392
#define XCD_BAR_WORDS 3456
#define XB_SPIN_CAP (1u << 18)

__device__ __forceinline__ unsigned xb_ld(unsigned* p)              { return __hip_atomic_load(p, __ATOMIC_RELAXED, __HIP_MEMORY_SCOPE_AGENT); }
__device__ __forceinline__ unsigned xb_add(unsigned* p, unsigned v) { return __hip_atomic_fetch_add(p, v, __ATOMIC_RELAXED, __HIP_MEMORY_SCOPE_AGENT); }
__device__ __forceinline__ unsigned xb_xcc_id() { return (unsigned)__builtin_amdgcn_s_getreg((3 << 11) | 20) & 0xFu; }
#define XB_SPIN(cond, bar) do { unsigned _sp = 0; while (cond) { __builtin_amdgcn_s_sleep(1); \
    if ((++_sp & 255u) == 0u) { if (xb_ld(&(bar)[XB_TMO])) break; if (_sp > XB_SPIN_CAP) { atomicAdd(&(bar)[XB_TMO], 1u); break; } } } } while (0)

struct XcdBarrier {
    unsigned* bar; unsigned x;
    volatile LAS unsigned* st;
};

__device__ __forceinline__ XcdBarrier xcd_barrier_post(unsigned* bar, volatile LAS unsigned* st) {
    XcdBarrier b; b.bar = bar; b.x = xb_xcc_id(); b.st = st;
    if (threadIdx.x == 0) (void)xb_add(&bar[XB_XCNT(b.x)], 1u);
    return b;
}
__device__ __forceinline__ void xcd_barrier_complete(unsigned* bar, unsigned x, unsigned& nloc, unsigned& nx) {
    const unsigned G = gridDim.x * gridDim.y * gridDim.z;
    unsigned sum, cnt, mine, sp = 0u;
    for (;;) {
        sum = 0u; cnt = 0u; mine = 0u;
#pragma unroll
        for (unsigned j = 0; j < 16; ++j) { const unsigned c = xb_ld(&bar[XB_XCNT(j)]); sum += c; cnt += (c > 0u) ? 1u : 0u; mine = (j == x) ? c : mine; }
        if (sum == G) break;
        __builtin_amdgcn_s_sleep(1);
        if ((++sp & 255u) == 0u) { if (xb_ld(&bar[XB_TMO])) break; if (sp > XB_SPIN_CAP) { atomicAdd(&bar[XB_TMO], 1u); break; } }
    }
    nloc = mine > 0u ? mine : 1u; nx = cnt > 0u ? cnt : 1u;
}

__device__ __forceinline__ void xcd_barrier(const XcdBarrier& b) {
    asm volatile("s_waitcnt vmcnt(0)" ::: "memory");
    __syncthreads();
    if (threadIdx.x == 0) {
        unsigned* bar = b.bar;
        __builtin_amdgcn_s_waitcnt(0);
        unsigned nloc = b.st[0], nx = b.st[1];
        if (nloc == 0u) { xcd_barrier_complete(bar, b.x, nloc, nx); b.st[0] = nloc; b.st[1] = nx; }
        const unsigned old = xb_add(&bar[XB_XSUB(b.x)], 1u);
        const unsigned gen = old / nloc;
        if (old + 1u == (gen + 1u) * nloc) {
            __builtin_amdgcn_fence(__ATOMIC_RELEASE, "agent");
            asm volatile("s_waitcnt vmcnt(0)" ::: "memory");
            const unsigned og = xb_add(&bar[XB_TOP], 1u);
            const unsigned tg = og / nx;
            if (og + 1u == (tg + 1u) * nx) xb_add(&bar[XB_TOPGEN], 1u);
            else XB_SPIN(xb_ld(&bar[XB_TOPGEN]) == tg, bar);
            __builtin_amdgcn_fence(__ATOMIC_ACQUIRE, "agent");
            xb_add(&bar[XB_XGEN(b.x)], 1u);
            asm volatile("s_waitcnt vmcnt(0)" ::: "memory");
        } else {
            XB_SPIN(xb_ld(&bar[XB_XGEN(b.x)]) == gen, bar);
            __builtin_amdgcn_fence(__ATOMIC_ACQUIRE, "agent");
            asm volatile("s_waitcnt vmcnt(0)" ::: "memory");
        }
    }
    __syncthreads();
}


struct Args {
    const float *x, *mem, *pre_w, *mem_w, *w_in, *conv_w, *a_log, *dt_bias, *dn_w, *mix_w, *pool_scale, *w_kv, *w_pp, *w_pd, *w_pm, *w_out, *post_w;
    float* out; unsigned char* ws; int ph_lo, ph_hi;
};

__device__ __forceinline__ float wave_sum(float v) {
    v += __builtin_bit_cast(float, __builtin_amdgcn_update_dpp(0, __builtin_bit_cast(int, v), 0xB1, 0xF, 0xF, false));
    v += __builtin_bit_cast(float, __builtin_amdgcn_update_dpp(0, __builtin_bit_cast(int, v), 0x4E, 0xF, 0xF, false));
    v += __builtin_bit_cast(float, __builtin_amdgcn_update_dpp(0, __builtin_bit_cast(int, v), 0x124, 0xF, 0xF, false));
    v += __builtin_bit_cast(float, __builtin_amdgcn_update_dpp(0, __builtin_bit_cast(int, v), 0x128, 0xF, 0xF, false));
    const int vi = __builtin_bit_cast(int, v);
    const float s0 = __builtin_bit_cast(float, __builtin_amdgcn_readlane(vi, 0)), s1 = __builtin_bit_cast(float, __builtin_amdgcn_readlane(vi, 16));
    const float s2 = __builtin_bit_cast(float, __builtin_amdgcn_readlane(vi, 32)), s3 = __builtin_bit_cast(float, __builtin_amdgcn_readlane(vi, 48));
    return (s0 + s1) + (s2 + s3);
}

__device__ __forceinline__ void p0_transpose_item(const float* W, int ldw, int K, bf16_t* WT, LAS float* scr, int kb, int nb, int lane) {
    const int k0 = 64 * kb, n0 = 32 * nb;
    float tv[32];
#pragma unroll
    for (int i = 0; i < 32; ++i) tv[i] = W[(size_t)(k0 + 2 * i + (lane >> 5)) * ldw + n0 + (lane & 31)];
#pragma unroll
    for (int i = 0; i < 32; ++i) scr[(2 * i + (lane >> 5)) * 33 + (lane & 31)] = tv[i];
    LDS_WAIT();
    const int c = lane & 7;
#pragma unroll
    for (int j = 0; j < 4; ++j) { const int n = (lane >> 3) + 8 * j; const LAS float* s = scr + (8 * c) * 33 + n;
        u32x4 o; o.x = pk2(s[0 * 33], s[1 * 33]); o.y = pk2(s[2 * 33], s[3 * 33]); o.z = pk2(s[4 * 33], s[5 * 33]); o.w = pk2(s[6 * 33], s[7 * 33]);
        *(u32x4*)(WT + (size_t)(n0 + n) * K + k0 + 8 * c) = o; }
    LDS_WAIT();
}

__device__ __forceinline__ void p0_prologue(const Args& a, LAS unsigned char* lds) {
    int tid_ = threadIdx.x; asm volatile("" : "+v"(tid_));
    const int tid = tid_, lane = tid & 63, wave = tid >> 6, G = gridDim.x;
    unsigned char* ws = a.ws;
    LAS float* W16 = (LAS float*)lds;
    LAS float* scr = (LAS float*)(lds + 65536 + wave * 8448);
    f32x4 wtmp[8];
#pragma unroll
    for (int t8 = 0; t8 < 8; ++t8) { const int idx = tid + 512 * t8, i = idx >> 2, q = idx & 3; wtmp[t8] = *(const f32x4*)(a.w_in + (size_t)i * INW + 4096 + 4 * q); }
    for (int i = blockIdx.x * 512 + tid; i < M; i += G * 512) ((float*)(ws + WS_ROWSS))[i] = 0.f;
    for (int i = blockIdx.x * 512 + tid; i < M * 8; i += G * 512) ((float*)(ws + WS_SUMSQ))[i] = 0.f;
    const int gw = blockIdx.x * 8 + wave, NGW = G * 8;
    bf16_t* WT = (bf16_t*)(ws + WS_WT);
#define SEG(src, ldw, Kk, Nseg, dst) { const int ni = ((Kk) / 64) * ((Nseg) / 32); if (r < ni) { const int nblk = (Nseg) / 32; p0_transpose_item((src), (ldw), (Kk), (dst), scr, r / nblk, r % nblk, lane); continue; } r -= ni; }
    constexpr int NITEMS = 16 * 128 + 512 + 32;
    for (int it = wave * G + (int)blockIdx.x; it < NITEMS; it += NGW) {
        int r = it;
        SEG(a.w_in + 0, INW, 1024, 512, WT)
        SEG(a.w_in + 5136, INW, 1024, 512, WT + (size_t)512 * 1024)
        SEG(a.w_in + 1024, INW, 1024, 3072, WT + (size_t)1024 * 1024)
        SEG(a.w_kv, 1024, 1024, 1024, (bf16_t*)(ws + WS_WKV))
        SEG(a.mix_w + 0 * 16384, 128, 128, 128, (bf16_t*)(ws + WS_WMIX) + 0 * 16384)
        SEG(a.mix_w + 1 * 16384, 128, 128, 128, (bf16_t*)(ws + WS_WMIX) + 1 * 16384)
        SEG(a.mix_w + 2 * 16384, 128, 128, 128, (bf16_t*)(ws + WS_WMIX) + 2 * 16384)
        SEG(a.mix_w + 3 * 16384, 128, 128, 128, (bf16_t*)(ws + WS_WMIX) + 3 * 16384)
    }
#pragma unroll
    for (int t8 = 0; t8 < 8; ++t8) { const int idx = tid + 512 * t8, i = idx >> 2, q = idx & 3; const int p = ((i >> 8) * 4 + (i & 3)) * 64 + ((i >> 2) & 63);
        *(LAS f32x4*)(W16 + (q * 1024 + p) * 4) = wtmp[t8]; }
    __syncthreads();
    const float dtb_l = a.dt_bias[lane & 7], alog_l = a.a_log[lane & 7];
    f32x4 nwx[4], nwm[4];
#pragma unroll
    for (int j = 0; j < 4; ++j) { nwx[j] = ((const f32x4*)a.pre_w)[lane + 64 * j]; nwm[j] = ((const f32x4*)a.mem_w)[lane + 64 * j]; }
    f32x4 vnx[4];
    {   const int m = gw; const float* src = (m >= M) ? a.mem + (size_t)(m - M) * 1024 : a.x + (size_t)m * 1024;
#pragma unroll
        for (int j = 0; j < 4; ++j) vnx[j] = ((const f32x4*)src)[lane + 64 * j]; }
    for (int m = gw; m < M + NB * MEML; m += NGW) {
        const bool is_mem = m >= M;
        bf16_t* dst = is_mem ? (bf16_t*)(ws + WS_MEMN) + (size_t)(m - M) * 1024 : (bf16_t*)(ws + WS_H) + (size_t)m * 1024;
        f32x4 v[4]; float s = 0.f;
#pragma unroll
        for (int j = 0; j < 4; ++j) { v[j] = vnx[j]; s += (v[j].x * v[j].x + v[j].y * v[j].y) + (v[j].z * v[j].z + v[j].w * v[j].w); }
        {   const int m2 = (m + NGW < M + NB * MEML) ? m + NGW : m; const float* src = (m2 >= M) ? a.mem + (size_t)(m2 - M) * 1024 : a.x + (size_t)m2 * 1024;
#pragma unroll
            for (int j = 0; j < 4; ++j) vnx[j] = ((const f32x4*)src)[lane + 64 * j]; }
        const float rstd = 1.0f / sqrtf(wave_sum(s) * (1.f / 1024.f) + EPS);
#pragma unroll
        for (int j = 0; j < 4; ++j) { const f32x4 wv = is_mem ? nwm[j] : nwx[j]; v[j] = v[j] * rstd * wv;
            u32x2 o; o.x = pk2(v[j].x, v[j].y); o.y = pk2(v[j].z, v[j].w); ((u32x2*)dst)[lane + 64 * j] = o; }
        if (!is_mem) {
            f32x4 acc[4];
#pragma unroll
            for (int q = 0; q < 4; ++q) acc[q] = (f32x4){0.f, 0.f, 0.f, 0.f};
#pragma unroll
            for (int j = 0; j < 4; ++j)
#pragma unroll
                for (int e = 0; e < 4; ++e) { const float xv = v[j][e];
#pragma unroll
                    for (int q = 0; q < 4; ++q) { const f32x4 wv = *(const LAS f32x4*)(W16 + (q * 1024 + (j * 4 + e) * 64 + lane) * 4); acc[q] += xv * wv; } }
            float val = 0.f;
#pragma unroll
            for (int q = 0; q < 4; ++q)
#pragma unroll
                for (int e = 0; e < 4; ++e) { const float t = wave_sum(acc[q][e]); if (lane == q * 4 + e) val = t; }
            if (lane < 8) { const float z = val + dtb_l; const float sp = z > 20.f ? z : log1pf(expf(z));
                ((float*)(ws + WS_G))[(size_t)m * 8 + lane] = -expf(alog_l) * sp; }
            else if (lane < 16) ((float*)(ws + WS_BETA))[(size_t)m * 8 + lane - 8] = 1.f / (1.f + expf(-val));
        }
    }
}

__device__ __forceinline__ void late_transposes(const Args& a, LAS unsigned char* lds, int c, int GG) {
    int tid_ = threadIdx.x; asm volatile("" : "+v"(tid_));
    const int tid = tid_, lane = tid & 63, wave = tid >> 6;
    unsigned char* ws = a.ws; bf16_t* WT = (bf16_t*)(ws + WS_WT);
    LAS float* scr = (LAS float*)(lds + wave * 8448);
    __syncthreads();
    const int gw = c * 8 + wave, NGW = GG * 8;
    constexpr int NITEMS = 16 * 160 + 256 + 512 + 256 + 512;
    for (int it = gw; it < NITEMS; it += NGW) {
        int r = it;
        SEG(a.w_in + 512, INW, 1024, 512, WT + (size_t)4096 * 1024)
        SEG(a.w_in + 4112, INW, 1024, 1024, WT + (size_t)4608 * 1024)
        SEG(a.w_in + 5648, INW, 1024, 512, WT + (size_t)5632 * 1024)
        SEG(a.w_in + 6160, INW, 1024, 3072, WT + (size_t)6144 * 1024)
        SEG(a.w_pp, 1024, 512, 1024, (bf16_t*)(ws + WS_WP))
        SEG(a.w_pd, 1024, 1024, 1024, (bf16_t*)(ws + WS_WD))
        SEG(a.w_pm, 1024, 512, 1024, (bf16_t*)(ws + WS_WM))
        SEG(a.w_out, 1024, 1024, 1024, (bf16_t*)(ws + WS_WOUT))
    }
    __syncthreads();
}
#undef SEG

__device__ __forceinline__ void chunk_load_raw(const Args& a, int item, u32x4 (&raw)[11], int tid) {
    const int n = item & 31, h = (item >> 5) & 7, b = item >> 8; const int r0 = b * SEQ + 64 * n, gci = b * 32 + n;
    const int ten = tid >> 7, cgp = tid & 15, rg = (tid >> 4) & 7;
    if (tid < 384) {
        const bf16_t* src = (const bf16_t*)(a.ws + WS_QKV) + (size_t)ten * M * 1024 + h * 128 + cgp * 8;
#pragma unroll
        for (int i = 0; i < 11; ++i) { const int rr = 8 * rg - 3 + i;
            if (rr >= 0) raw[i] = *(const u32x4*)(src + (size_t)(r0 + rr) * 1024);
            else if (n > 0) raw[i] = *(const u32x4*)((const bf16_t*)(a.ws + WS_HALO) + ((size_t)(gci - 1) * 3 + (rr + 3)) * 3072 + ten * 1024 + h * 128 + cgp * 8);
            else raw[i] = (u32x4){0u, 0u, 0u, 0u}; }
    }
}
__device__ __forceinline__ void chunk_prep_item(const Args& a, LAS unsigned char* lds, int item, u32x4 (&raw)[11], int item_next, float& gpre, float& bpre, int set, int stage, int nvalid) {
    int tid_ = threadIdx.x; asm volatile("" : "+v"(tid_));
    const int tid = tid_, lane = tid & 63, wid = tid >> 6, r16 = lane & 15, qp = lane >> 4;
    const int n = item & 31, h = (item >> 5) & 7, b = item >> 8;
    const int r0 = b * SEQ + 64 * n, gci = b * 32 + n;
    unsigned char* ws = a.ws;
    bf16_t* QKV = (bf16_t*)(ws + WS_QKV);
    LAS bf16_t* Kn = (LAS bf16_t*)(lds);
    LAS bf16_t* Qn = (LAS bf16_t*)(lds + 17408);
    const int sset = (stage == 1) ? (wid >> 2) : set;
    LAS bf16_t* Tb = (LAS bf16_t*)(lds + sset * 9216);
    LAS bf16_t* VbT = (LAS bf16_t*)(lds + 34816 + sset * 36864);
    LAS bf16_t* KbgT = (LAS bf16_t*)(lds + 53248 + sset * 36864);
    LAS float* Ap = (LAS float*)(lds + 108544 + sset * 17408);
    LAS float* gcs = (LAS float*)(lds + 143360 + sset * 512);
    LAS float* bts = gcs + 64;
    __syncthreads();
    if (stage == 0) {
    if (wid == 0) {
        float g = gpre;
        const float bt = bpre;
        if (item_next >= 0) { const int n2 = item_next & 31, h2 = (item_next >> 5) & 7, b2 = item_next >> 8; const int r2 = b2 * SEQ + 64 * n2;
            gpre = ((const float*)(ws + WS_G))[(size_t)(r2 + lane) * 8 + h2]; bpre = ((const float*)(ws + WS_BETA))[(size_t)(r2 + lane) * 8 + h2]; }
#pragma unroll
        for (int o = 1; o < 64; o <<= 1) { const float t = __shfl_up(g, o); if (lane >= o) g += t; }
        gcs[lane] = g; bts[lane] = bt;
        if (lane == 63) ((float*)(ws + WS_GL))[item] = __expf(g);
    }
    __syncthreads();
    u32x4 outA[8];
    const int ten = tid >> 7, cgp = tid & 15, rg = (tid >> 4) & 7;
    if (tid < 384) {
        f32x4 cw[4][2];
#pragma unroll
        for (int j = 0; j < 4; ++j) { const float* cp = a.conv_w + (size_t)j * 3072 + ten * 1024 + h * 128 + cgp * 8; cw[j][0] = *(const f32x4*)cp; cw[j][1] = *(const f32x4*)(cp + 4); }
        float y[8][8];
#pragma unroll
        for (int i = 0; i < 8; ++i) {
#pragma unroll
            for (int e = 0; e < 8; ++e) y[i][e] = 0.f;
#pragma unroll
            for (int j = 0; j < 4; ++j) { const u32x4 rv = raw[i + j];
                y[i][0] += cw[j][0][0] * bflo(rv.x); y[i][1] += cw[j][0][1] * bfhi(rv.x); y[i][2] += cw[j][0][2] * bflo(rv.y); y[i][3] += cw[j][0][3] * bfhi(rv.y);
                y[i][4] += cw[j][1][0] * bflo(rv.z); y[i][5] += cw[j][1][1] * bfhi(rv.z); y[i][6] += cw[j][1][2] * bflo(rv.w); y[i][7] += cw[j][1][3] * bfhi(rv.w); }
#pragma unroll
            for (int e = 0; e < 8; ++e) y[i][e] = silu_f(y[i][e]);
        }
        if (item_next >= 0) chunk_load_raw(a, item_next, raw, tid);
        const float gl = gcs[63];
        if (ten < 2) {
#pragma unroll
            for (int i = 0; i < 8; ++i) { float ss = 0.f;
#pragma unroll
                for (int e = 0; e < 8; ++e) ss += y[i][e] * y[i][e];
                ss += __shfl_xor(ss, 1); ss += __shfl_xor(ss, 2); ss += __shfl_xor(ss, 4); ss += __shfl_xor(ss, 8);
                const float sc = (1.0f / sqrtf(ss + EPS)) * (ten == 0 ? 0.08838834764831845f : 1.f);
#pragma unroll
                for (int e = 0; e < 8; ++e) y[i][e] *= sc; }
        }
        if (ten == 0) {
#pragma unroll
            for (int i = 0; i < 8; ++i) { const int row = 8 * rg + i; const float eg = __expf(gcs[row]);
                u32x4 w; w.x = pk2(y[i][0], y[i][1]); w.y = pk2(y[i][2], y[i][3]); w.z = pk2(y[i][4], y[i][5]); w.w = pk2(y[i][6], y[i][7]);
                *(LAS u32x4*)(Qn + row * 136 + cgp * 8) = w;
                outA[i].x = pk2(y[i][0] * eg, y[i][1] * eg); outA[i].y = pk2(y[i][2] * eg, y[i][3] * eg); outA[i].z = pk2(y[i][4] * eg, y[i][5] * eg); outA[i].w = pk2(y[i][6] * eg, y[i][7] * eg); }
        } else if (ten == 1) {
            float f1[8], f2[8];
#pragma unroll
            for (int i = 0; i < 8; ++i) { const int row = 8 * rg + i; const float gc = gcs[row]; f1[i] = bts[row] * __expf(gc); f2[i] = __expf(gl - gc);
                u32x4 w; w.x = pk2(y[i][0], y[i][1]); w.y = pk2(y[i][2], y[i][3]); w.z = pk2(y[i][4], y[i][5]); w.w = pk2(y[i][6], y[i][7]);
                *(LAS u32x4*)(Kn + row * 136 + cgp * 8) = w; }
#pragma unroll
            for (int e = 0; e < 8; ++e) { u32x4 w;
                w.x = pk2(y[0][e] * f1[0], y[1][e] * f1[1]); w.y = pk2(y[2][e] * f1[2], y[3][e] * f1[3]); w.z = pk2(y[4][e] * f1[4], y[5][e] * f1[5]); w.w = pk2(y[6][e] * f1[6], y[7][e] * f1[7]);
                *(LAS u32x4*)(KbgT + (cgp * 8 + e) * 72 + 8 * rg) = w;
                outA[e].x = pk2(y[0][e] * f2[0], y[1][e] * f2[1]); outA[e].y = pk2(y[2][e] * f2[2], y[3][e] * f2[3]); outA[e].z = pk2(y[4][e] * f2[4], y[5][e] * f2[5]); outA[e].w = pk2(y[6][e] * f2[6], y[7][e] * f2[7]); }
        } else {
            float f1[8];
#pragma unroll
            for (int i = 0; i < 8; ++i) f1[i] = bts[8 * rg + i];
#pragma unroll
            for (int e = 0; e < 8; ++e) { u32x4 w;
                w.x = pk2(y[0][e] * f1[0], y[1][e] * f1[1]); w.y = pk2(y[2][e] * f1[2], y[3][e] * f1[3]); w.z = pk2(y[4][e] * f1[4], y[5][e] * f1[5]); w.w = pk2(y[6][e] * f1[6], y[7][e] * f1[7]);
                *(LAS u32x4*)(VbT + (cgp * 8 + e) * 72 + 8 * rg) = w; }
        }
    }
    __syncthreads();
    if (tid < 128) {
#pragma unroll
        for (int i = 0; i < 8; ++i) *(u32x4*)(QKV + (size_t)(r0 + 8 * rg + i) * 1024 + h * 128 + cgp * 8) = outA[i];
    } else if (tid < 256) {
#pragma unroll
        for (int e = 0; e < 8; ++e) { const int k = cgp * 8 + e;
            *(u32x4*)((unsigned char*)(QKV + (size_t)2 * M * 1024 + (size_t)(r0 + (k >> 1)) * 1024 + h * 128) + (k & 1) * 128 + 16 * rg) = outA[e]; }
    }
    {
        const int mat = wid >> 2, ti = wid & 3;
        const LAS bf16_t* Bm = mat ? Qn : Kn;
        f32x4 c4[4];
#pragma unroll
        for (int tj = 0; tj < 4; ++tj) c4[tj] = (f32x4){0.f, 0.f, 0.f, 0.f};
#pragma unroll
        for (int ks = 0; ks < 4; ++ks) { const bf16x8 af = *(const LAS bf16x8*)(Kn + (ti * 16 + r16) * 136 + ks * 32 + 8 * qp);
#pragma unroll
            for (int tj = 0; tj < 4; ++tj) { const bf16x8 bf = *(const LAS bf16x8*)(Bm + (tj * 16 + r16) * 136 + ks * 32 + 8 * qp); c4[tj] = MFMA16(af, bf, c4[tj]); } }
        const int j0 = ti * 16 + 4 * qp;
        const f32x4 gj = *(const LAS f32x4*)(gcs + j0);
#pragma unroll
        for (int tj = 0; tj < 4; ++tj) { const int i = tj * 16 + r16; const float gi = gcs[i]; f32x4 v;
#pragma unroll
            for (int e = 0; e < 4; ++e) { const int j = j0 + e; const float d = __expf(fminf(gi - gj[e], 0.f)); const bool keep = mat ? (j <= i) : (j < i); v[e] = keep ? c4[tj][e] * d : 0.f; }
            if (mat == 0) { v = v * bts[i];
#pragma unroll
                for (int e = 0; e < 4; ++e) Ap[i * 68 + e * 16 + ti * 4 + qp] = v[e]; }
            else { u32x2 o; o.x = pk2(v[0], v[1]); o.y = pk2(v[2], v[3]); *(u32x2*)((bf16_t*)(ws + WS_AQK) + (size_t)item * 4096 + i * 64 + j0) = o; } }
    }
    }
    if (stage == 1 && (wid >> 2) < nvalid) {
        const int ph = lane & 3, c = 16 * (wid & 3) + (lane >> 2);
        float t[16];
#pragma unroll
        for (int m = 0; m < 16; ++m) t[m] = 0.f;
        f32x4 cf[3][4];
#define LOADROW(ii, slot) do { _Pragma("unroll") for (int m4 = 0; m4 < 4; ++m4) if (m4 * 16 < (ii) && (ii) < 64) cf[slot][m4] = *(const LAS f32x4*)(Ap + (ii) * 68 + ph * 16 + 4 * m4); } while (0)
        LOADROW(0, 0); LOADROW(1, 1); LOADROW(2, 2);
#pragma unroll
        for (int i = 0; i < 64; ++i) {
            float acc0 = 0.f, acc1 = 0.f;
#pragma unroll
            for (int m4 = 0; m4 * 16 < i; ++m4) { const f32x4 av = cf[i % 3][m4];
                acc0 += av[0] * t[4 * m4];
                if ((4 * m4 + 1) * 4 < i) acc1 += av[1] * t[4 * m4 + 1];
                if ((4 * m4 + 2) * 4 < i) acc0 += av[2] * t[4 * m4 + 2];
                if ((4 * m4 + 3) * 4 < i) acc1 += av[3] * t[4 * m4 + 3]; }
            __builtin_amdgcn_sched_barrier(0);
            LOADROW(i + 3, i % 3);
            __builtin_amdgcn_sched_barrier(0);
            float acc = acc0 + acc1;
            acc += __builtin_bit_cast(float, __builtin_amdgcn_update_dpp(0, __builtin_bit_cast(int, acc), 0xB1, 0xF, 0xF, false));
            acc += __builtin_bit_cast(float, __builtin_amdgcn_update_dpp(0, __builtin_bit_cast(int, acc), 0x4E, 0xF, 0xF, false));
            const float val = ((c == i) ? 1.f : 0.f) - acc;
            t[i >> 2] = (ph == (i & 3)) ? val : t[i >> 2];
        }
#undef LOADROW
#pragma unroll
        for (int m = 0; m < 16; ++m) Tb[(4 * m + ph) * 72 + c] = (bf16_t)f2bf(t[m]);
    }
    if (stage == 2) {
        f32x4 cu[4], cwv[4];
#pragma unroll
        for (int ct = 0; ct < 4; ++ct) { cu[ct] = (f32x4){0.f, 0.f, 0.f, 0.f}; cwv[ct] = (f32x4){0.f, 0.f, 0.f, 0.f}; }
#pragma unroll
        for (int ks = 0; ks < 2; ++ks) {
            const bf16x8 vb = *(const LAS bf16x8*)(VbT + (16 * wid + r16) * 72 + ks * 32 + 8 * qp);
            const bf16x8 kb = *(const LAS bf16x8*)(KbgT + (16 * wid + r16) * 72 + ks * 32 + 8 * qp);
#pragma unroll
            for (int ct = 0; ct < 4; ++ct) { const bf16x8 tf = *(const LAS bf16x8*)(Tb + (16 * ct + r16) * 72 + ks * 32 + 8 * qp);
                cu[ct] = MFMA16(tf, vb, cu[ct]); cwv[ct] = MFMA16(kb, tf, cwv[ct]); }
        }
#pragma unroll
        for (int ct = 0; ct < 4; ++ct) {
            u32x2 o; o.x = pk2(cu[ct][0], cu[ct][1]); o.y = pk2(cu[ct][2], cu[ct][3]);
            ((u32x2*)(ws + WS_U))[(((size_t)item * 8 + wid) * 4 + ct) * 64 + lane] = o;
            u32x2 w2; w2.x = pk2(-cwv[ct][0], -cwv[ct][1]); w2.y = pk2(-cwv[ct][2], -cwv[ct][3]);
            *(u32x2*)(QKV + (size_t)M * 1024 + (size_t)(r0 + 16 * ct + r16) * 1024 + h * 128 + 16 * wid + 4 * qp) = w2;
        }
    }
}

__device__ __forceinline__ bf16x8 ldA_perm(const LAS bf16_t* p) {
    const u32x2 lo = *(const LAS u32x2*)p, hi = *(const LAS u32x2*)(p + 16);
    u32x4 v; v.x = lo.x; v.y = lo.y; v.z = hi.x; v.w = hi.y; return __builtin_bit_cast(bf16x8, v);
}
__device__ __forceinline__ bf16x8 packB(f32x4 t0, f32x4 t1) {
    u32x4 v; v.x = pk2(t0[0], t0[1]); v.y = pk2(t0[2], t0[3]); v.z = pk2(t1[0], t1[1]); v.w = pk2(t1[2], t1[3]); return __builtin_bit_cast(bf16x8, v);
}
constexpr int SC_W = 0, SC_QG = 18432, SC_AQK = 36864, SC_KDT = 47104, SC_BUF = 67584, SC_RED = 2 * SC_BUF, SC_RSTD = SC_RED + 2048;

__device__ __forceinline__ void scan_load(const Args& a, int bh, int n, u32x4 (&stg)[7]) {
    const int tid = threadIdx.x, b = bh >> 3, h = bh & 7; const int r0 = b * SEQ + 64 * n; const int item = bh * 32 + n;
    const bf16_t* QKV = (const bf16_t*)(a.ws + WS_QKV);
    const int c = tid >> 4, k8 = tid & 15;
#pragma unroll
    for (int i = 0; i < 2; ++i) {
        stg[i] = *(const u32x4*)(QKV + (size_t)M * 1024 + (size_t)(r0 + c + 32 * i) * 1024 + h * 128 + k8 * 8);
        stg[2 + i] = *(const u32x4*)(QKV + (size_t)(r0 + c + 32 * i) * 1024 + h * 128 + k8 * 8);
        stg[4 + i] = *(const u32x4*)(QKV + (size_t)2 * M * 1024 + (size_t)(r0 + c + 32 * i) * 1024 + h * 128 + k8 * 8);
    }
    stg[6] = *(const u32x4*)((const bf16_t*)(a.ws + WS_AQK) + (size_t)item * 4096 + tid * 8);
}
__device__ __forceinline__ void st_perm(LAS unsigned char* rowp  , int a4  , u32x4 v) {
    const int p0 = (a4 & 1) * 16 + (a4 >> 1) * 4;
    u32x2 lo; lo.x = v.x; lo.y = v.y; u32x2 hi; hi.x = v.z; hi.y = v.w;
    *(LAS u32x2*)(rowp + p0 * 2) = lo; *(LAS u32x2*)(rowp + (p0 + 8) * 2) = hi;
}
__device__ __forceinline__ void scan_store(LAS unsigned char* buf, const u32x4 (&stg)[7]) {
    const int tid = threadIdx.x; const int c = tid >> 4, k8 = tid & 15;
#pragma unroll
    for (int i = 0; i < 2; ++i) {
        st_perm(buf + SC_W + ((c + 32 * i) * 144 + (k8 >> 2) * 32) * 2, k8 & 3, stg[i]);
        st_perm(buf + SC_QG + ((c + 32 * i) * 144 + (k8 >> 2) * 32) * 2, k8 & 3, stg[2 + i]);
        const int line = c + 32 * i, k = line * 2 + (k8 >> 3), c8 = k8 & 7;
        st_perm(buf + SC_KDT + (k * 80 + (c8 >> 2) * 32) * 2, c8 & 3, stg[4 + i]);
    }
    { const int cc = tid >> 3, j8 = tid & 7; st_perm(buf + SC_AQK + (cc * 80 + (j8 >> 2) * 32) * 2, j8 & 3, stg[6]); }
}
__device__ __forceinline__ float dpp_add16(float v) {
    v += __builtin_bit_cast(float, __builtin_amdgcn_update_dpp(0, __builtin_bit_cast(int, v), 0xB1, 0xF, 0xF, false));
    v += __builtin_bit_cast(float, __builtin_amdgcn_update_dpp(0, __builtin_bit_cast(int, v), 0x4E, 0xF, 0xF, false));
    v += __builtin_bit_cast(float, __builtin_amdgcn_update_dpp(0, __builtin_bit_cast(int, v), 0x124, 0xF, 0xF, false));
    v += __builtin_bit_cast(float, __builtin_amdgcn_update_dpp(0, __builtin_bit_cast(int, v), 0x128, 0xF, 0xF, false));
    return v;
}
#define LDA128(p) (*(const LAS bf16x8*)(p))

struct ScanSet { u32x4 stg[7]; u32x2 u[4]; float gl; };
__device__ __forceinline__ void scan_load_set(const Args& a, int bh, int n, ScanSet& t, int lane, int wid) {
    scan_load(a, bh, n, t.stg);
#pragma unroll
    for (int ct = 0; ct < 4; ++ct) t.u[ct] = ((const u32x2*)(a.ws + WS_U))[(((size_t)(bh * 32 + n) * 8 + wid) * 4 + ct) * 64 + lane];
    t.gl = ((const float*)(a.ws + WS_GL))[bh * 32 + n];
}
__device__ __forceinline__ void scan_step(const Args& a, LAS unsigned char* lds, int bh, int n, f32x4 (&S)[8], ScanSet& T, float dnw, int lane, int wid, int r16, int qp, bool accum) {
    const int tid = threadIdx.x, b = bh >> 3, h = bh & 7;
    bf16_t* Y = (bf16_t*)a.out;
    LAS unsigned char* buf = lds + (n & 1) * SC_BUF;
    const float gl = T.gl;
    f32x4 vn[4], o[4];
#pragma unroll
    for (int ct = 0; ct < 4; ++ct) { const u32x2 uu = T.u[ct];
        vn[ct] = (f32x4){bflo(uu.x), bfhi(uu.x), bflo(uu.y), bfhi(uu.y)}; o[ct] = (f32x4){0.f, 0.f, 0.f, 0.f}; }
    __builtin_amdgcn_sched_barrier(0);
    if (n + 1 < 32) scan_load_set(a, bh, n + 1, T, lane, wid);
    __builtin_amdgcn_sched_barrier(0);
    bf16x8 sb[4];
#pragma unroll
    for (int s = 0; s < 4; ++s) sb[s] = packB(S[2 * s], S[2 * s + 1]);
    const LAS bf16_t* Wb = (const LAS bf16_t*)(buf + SC_W); const LAS bf16_t* QGb = (const LAS bf16_t*)(buf + SC_QG);
    const LAS bf16_t* AQb = (const LAS bf16_t*)(buf + SC_AQK); const LAS bf16_t* KDb = (const LAS bf16_t*)(buf + SC_KDT);
    bf16x8 fa[8], fb[8];
#define SB() __builtin_amdgcn_sched_barrier(0)
#define LD_VO2(f, ca, cb, sh) do { _Pragma("unroll") for (int s_ = 0; s_ < 2; ++s_) { \
        f[4 * s_ + 0] = LDA128(Wb + (16 * (ca) + r16) * 144 + 32 * ((sh) + s_) + 8 * qp); f[4 * s_ + 1] = LDA128(Wb + (16 * (cb) + r16) * 144 + 32 * ((sh) + s_) + 8 * qp); \
        f[4 * s_ + 2] = LDA128(QGb + (16 * (ca) + r16) * 144 + 32 * ((sh) + s_) + 8 * qp); f[4 * s_ + 3] = LDA128(QGb + (16 * (cb) + r16) * 144 + 32 * ((sh) + s_) + 8 * qp); } } while (0)
#define MM_VO2(f, ca, cb, sh) do { _Pragma("unroll") for (int s_ = 0; s_ < 2; ++s_) { \
        vn[ca] = MFMA16(f[4 * s_ + 0], sb[(sh) + s_], vn[ca]); vn[cb] = MFMA16(f[4 * s_ + 1], sb[(sh) + s_], vn[cb]); \
        o[ca] = MFMA16(f[4 * s_ + 2], sb[(sh) + s_], o[ca]); o[cb] = MFMA16(f[4 * s_ + 3], sb[(sh) + s_], o[cb]); } } while (0)
#define LD_AQ(f) do { _Pragma("unroll") for (int c_ = 0; c_ < 4; ++c_) { f[c_] = LDA128(AQb + (16 * c_ + r16) * 80 + 8 * qp); f[4 + c_] = LDA128(AQb + (16 * c_ + r16) * 80 + 32 + 8 * qp); } } while (0)
#define MM_AQ(f) do { _Pragma("unroll") for (int c_ = 0; c_ < 4; ++c_) o[c_] = MFMA16(f[c_], vb[0], o[c_]); _Pragma("unroll") for (int c_ = 0; c_ < 4; ++c_) o[c_] = MFMA16(f[4 + c_], vb[1], o[c_]); } while (0)
#define LD_KD(f, k0) do { _Pragma("unroll") for (int c_ = 0; c_ < 4; ++c_) { f[c_] = LDA128(KDb + (16 * ((k0) + c_) + r16) * 80 + 8 * qp); f[4 + c_] = LDA128(KDb + (16 * ((k0) + c_) + r16) * 80 + 32 + 8 * qp); } } while (0)
#define MM_KD(f, k0) do { _Pragma("unroll") for (int c_ = 0; c_ < 4; ++c_) S[(k0) + c_] = MFMA16(f[c_], vb[0], S[(k0) + c_] * gl); _Pragma("unroll") for (int c_ = 0; c_ < 4; ++c_) S[(k0) + c_] = MFMA16(f[4 + c_], vb[1], S[(k0) + c_]); } while (0)
    LD_VO2(fa, 0, 1, 0); LD_VO2(fb, 0, 1, 2); SB();
    MM_VO2(fa, 0, 1, 0); SB(); LD_VO2(fa, 2, 3, 0); SB();
    MM_VO2(fb, 0, 1, 2); SB(); LD_VO2(fb, 2, 3, 2); SB();
    MM_VO2(fa, 2, 3, 0); SB(); LD_AQ(fa); SB();
    MM_VO2(fb, 2, 3, 2); SB(); LD_KD(fb, 0); SB();
    bf16x8 vb[2];
#pragma unroll
    for (int s = 0; s < 2; ++s) vb[s] = packB(vn[2 * s], vn[2 * s + 1]);
    MM_AQ(fa); SB(); LD_KD(fa, 4); SB();
    MM_KD(fb, 0); SB();
    MM_KD(fa, 4); SB();
#undef SB
#undef LD_VO2
#undef MM_VO2
#undef LD_AQ
#undef MM_AQ
#undef LD_KD
#undef MM_KD
    {
        float v16[16];
#pragma unroll
        for (int ct = 0; ct < 4; ++ct)
#pragma unroll
            for (int e = 0; e < 4; ++e) v16[4 * ct + e] = o[ct][e] * o[ct][e];
#define DPPF(x, ctrl) __builtin_bit_cast(float, __builtin_amdgcn_update_dpp(0, __builtin_bit_cast(int, (x)), (ctrl), 0xF, 0xF, false))
        float w8[8], w4[4], w2[2];
        const bool b3 = r16 & 8, b2 = r16 & 4, b1 = r16 & 2, b0 = r16 & 1;
#pragma unroll
        for (int j = 0; j < 8; ++j) { const float keep = b3 ? v16[j + 8] : v16[j], send = b3 ? v16[j] : v16[j + 8]; w8[j] = keep + DPPF(send, 0x128); }
#pragma unroll
        for (int j = 0; j < 4; ++j) { const float keep = b2 ? w8[j + 4] : w8[j], send = b2 ? w8[j] : w8[j + 4]; w4[j] = keep + DPPF(send, 0x141); }
#pragma unroll
        for (int j = 0; j < 2; ++j) { const float keep = b1 ? w4[j + 2] : w4[j], send = b1 ? w4[j] : w4[j + 2]; w2[j] = keep + DPPF(send, 0x1B); }
        const float keep = b0 ? w2[1] : w2[0], send = b0 ? w2[0] : w2[1];
        const float tot = keep + DPPF(send, 0xB1);
#undef DPPF
        if (accum) atomicAdd((float*)(a.ws + WS_SUMSQ) + (size_t)(b * SEQ + 64 * n + 16 * (r16 >> 2) + 4 * qp + (r16 & 3)) * 8 + h, tot);
    }
    if (n + 1 < 32) scan_store(lds + ((n + 1) & 1) * SC_BUF, T.stg);
    const int rowb = b * SEQ + 64 * n;
#pragma unroll
    for (int ct = 0; ct < 4; ++ct)
#pragma unroll
        for (int e = 0; e < 4; ++e) Y[(size_t)(rowb + 16 * ct + 4 * qp + e) * 2048 + 512 + h * 128 + 16 * wid + r16] = (bf16_t)f2bf(o[ct][e] * dnw);
    __syncthreads();
}

__device__ __forceinline__ void scan_bh(const Args& a, LAS unsigned char* lds, int bh, bool accum = true) {
    int tid_ = threadIdx.x; asm volatile("" : "+v"(tid_));
    const int tid = tid_, lane = tid & 63, wid = tid >> 6, r16 = lane & 15, qp = lane >> 4;
    const float dnw = a.dn_w[16 * wid + r16];
    f32x4 S[8];
#pragma unroll
    for (int kt = 0; kt < 8; ++kt) S[kt] = (f32x4){0.f, 0.f, 0.f, 0.f};
    ScanSet T;
    __syncthreads();
    scan_load_set(a, bh, 0, T, lane, wid);
    scan_store(lds, T.stg);
    __syncthreads();
#pragma unroll 1
    for (int n = 0; n < 32; ++n) scan_step(a, lds, bh, n, S, T, dnw, lane, wid, r16, qp, accum);
}

__device__ __forceinline__ void attn_item(const Args& a, LAS unsigned char* lds, int item) {
    int tid_ = threadIdx.x; asm volatile("" : "+v"(tid_));
    const int tid = tid_, lane = tid & 63, wid = tid >> 6, r16 = lane & 15, qp = lane >> 4;
    const int qt = item & 15, head = (item >> 4) & 3, b = item >> 6;
    LAS bf16_t* Ks = (LAS bf16_t*)lds;
    LAS bf16_t* Vt = (LAS bf16_t*)(lds + 69632);
    const bf16_t* KM = (const bf16_t*)(a.ws + WS_KMEM); const bf16_t* VM = (const bf16_t*)(a.ws + WS_VMEMT); const bf16_t* QM = (const bf16_t*)(a.ws + WS_QM);
    __syncthreads();
#pragma unroll
    for (int i = 0; i < 8; ++i) { const int p = tid + 512 * i;
        { const int key = p >> 4, d8 = p & 15; *(LAS u32x4*)(Ks + key * 136 + d8 * 8) = *(const u32x4*)(KM + (size_t)(b * 256 + key) * 512 + head * 128 + d8 * 8); }
        { const int d = p >> 5, k8 = p & 31; *(LAS u32x4*)(Vt + d * 264 + k8 * 8) = *(const u32x4*)(VM + (size_t)(head * 128 + d) * 2048 + b * 256 + k8 * 8); } }
    const int qrow = b * SEQ + qt * 128 + 16 * wid + r16;
    bf16x8 qf[4];
#pragma unroll
    for (int s = 0; s < 4; ++s) qf[s] = *(const bf16x8*)(QM + (size_t)qrow * 512 + head * 128 + 32 * s + 8 * qp);
    __syncthreads();
    f32x4 sc[16];
#pragma unroll
    for (int kt = 0; kt < 16; ++kt) { sc[kt] = (f32x4){0.f, 0.f, 0.f, 0.f};
#pragma unroll
        for (int s = 0; s < 4; ++s) sc[kt] = MFMA16(*(const LAS bf16x8*)(Ks + (16 * kt + r16) * 136 + 32 * s + 8 * qp), qf[s], sc[kt]); }
    float mx = -3.0e38f;
#pragma unroll
    for (int kt = 0; kt < 16; ++kt) mx = fmaxf(fmaxf(fmaxf(sc[kt][0], sc[kt][1]), fmaxf(sc[kt][2], sc[kt][3])), mx);
    mx = fmaxf(mx, __shfl_xor(mx, 16)); mx = fmaxf(mx, __shfl_xor(mx, 32));
    const float scl = 0.08838834764831845f; float sum = 0.f;
#pragma unroll
    for (int kt = 0; kt < 16; ++kt)
#pragma unroll
        for (int e = 0; e < 4; ++e) { const float p = __expf((sc[kt][e] - mx) * scl); sc[kt][e] = p; sum += p; }
    sum += __shfl_xor(sum, 16); sum += __shfl_xor(sum, 32);
    f32x4 o[8];
#pragma unroll
    for (int dt = 0; dt < 8; ++dt) o[dt] = (f32x4){0.f, 0.f, 0.f, 0.f};
#pragma unroll
    for (int s = 0; s < 8; ++s) { const bf16x8 pb = packB(sc[2 * s], sc[2 * s + 1]);
#pragma unroll
        for (int dt = 0; dt < 8; ++dt) o[dt] = MFMA16(ldA_perm(Vt + (16 * dt + r16) * 264 + 32 * s + 4 * qp), pb, o[dt]); }
    const float inv = 1.f / sum;
    bf16_t* Y = (bf16_t*)a.out;
#pragma unroll
    for (int dt = 0; dt < 8; ++dt) { u32x2 w; w.x = pk2(o[dt][0] * inv, o[dt][1] * inv); w.y = pk2(o[dt][2] * inv, o[dt][3] * inv);
        *(u32x2*)(Y + (size_t)qrow * 2048 + 1536 + head * 128 + 16 * dt + 4 * qp) = w; }
}

__device__ __forceinline__ void pool_item(const Args& a, LAS unsigned char* lds, int item) {
    int tid_ = threadIdx.x; asm volatile("" : "+v"(tid_));
    const int tid = tid_, lane = tid & 63, wid = tid >> 6, r16 = lane & 15, qp = lane >> 4;
    const int g = item & 3, tt = (item >> 2) & 31, b = item >> 7;
    LAS bf16_t* Xs = (LAS bf16_t*)lds;
    LAS bf16_t* Ps = (LAS bf16_t*)(lds + 20480);
    const bf16_t* XA = (const bf16_t*)(a.ws + WS_XA);
    const int t0 = tt * 64;
    __syncthreads();
    for (int p = tid; p < 1280; p += 512) { const int row = p >> 4, c8 = p & 15; const int t = t0 - 16 + row; u32x4 v = (u32x4){0u, 0u, 0u, 0u};
        if (t >= 0) v = *(const u32x4*)(XA + (size_t)(b * SEQ + t) * 512 + g * 128 + c8 * 8);
        *(LAS u32x4*)(Xs + row * 128 + c8 * 8) = v; }
    __syncthreads();
    {
        const int c = tid & 127, rgp = tid >> 7, w = 2 << g; float sum = 0.f;
        for (int j = 1; j < w; ++j) sum += bflo((unsigned)Xs[(16 + 16 * rgp - j) * 128 + c]);
        const float invw = 1.f / (float)w;
#pragma unroll 4
        for (int i = 0; i < 16; ++i) { const int row = 16 * rgp + i; const float xv = bflo((unsigned)Xs[(16 + row) * 128 + c]); sum += xv;
            const int t = t0 + row; const float mean = (t + 1 >= w) ? sum * invw : sum / (float)(t + 1);
            Ps[row * 136 + c] = (bf16_t)f2bf(mean - xv);
            sum -= bflo((unsigned)Xs[(16 + row - (w - 1)) * 128 + c]); }
    }
    __syncthreads();
    const bf16_t* WX = (const bf16_t*)(a.ws + WS_WMIX) + g * 16384;
    f32x4 acc[4];
#pragma unroll
    for (int t4 = 0; t4 < 4; ++t4) acc[t4] = (f32x4){0.f, 0.f, 0.f, 0.f};
#pragma unroll
    for (int s = 0; s < 4; ++s) { const bf16x8 af = *(const bf16x8*)(WX + (16 * wid + r16) * 128 + 32 * s + 8 * qp);
#pragma unroll
        for (int t4 = 0; t4 < 4; ++t4) acc[t4] = MFMA16(af, *(const LAS bf16x8*)(Ps + (16 * t4 + r16) * 136 + 32 * s + 8 * qp), acc[t4]); }
    const f32x4 psc = *(const f32x4*)(a.pool_scale + g * 128 + 16 * wid + 4 * qp);
    bf16_t* Y = (bf16_t*)a.out;
#pragma unroll
    for (int t4 = 0; t4 < 4; ++t4) { u32x2 w2; w2.x = pk2(acc[t4][0] * psc[0], acc[t4][1] * psc[1]); w2.y = pk2(acc[t4][2] * psc[2], acc[t4][3] * psc[3]);
        *(u32x2*)(Y + (size_t)(b * SEQ + t0 + 16 * t4 + r16) * 2048 + g * 128 + 16 * wid + 4 * qp) = w2; }
}

#ifndef REP_P0
#define REP_P0 1
#endif
#ifndef REP_P1
#define REP_P1 1
#endif
#ifndef REP_P3
#define REP_P3 1
#endif
#ifndef REP_P5
#define REP_P5 1
#endif
#define P0_BODY if (IN(0)) p0_prologue(a, lds);
#define P1_BODY \
    if (IN(1)) { \
        {   pg8::Gemm g{(const bf16_t*)(ws + WS_H), (const bf16_t*)(ws + WS_WT), 1024, 1024, 1024}; pg8::StaticOrder S; S.init(M, 4096, G, bx); \
            pg8::EpiStage1 E{(bf16_t*)(ws + WS_XA), (bf16_t*)(ws + WS_QM), (bf16_t*)(ws + WS_QKV), (bf16_t*)(ws + WS_HALO)}; \
            pg8::gemm_phase(lds, g, S, E); } \
    }
#ifndef REP_SCAN
#define REP_SCAN 1
#endif
#ifndef REP_ATTN
#define REP_ATTN 1
#endif
#ifndef REP_POOL
#define REP_POOL 1
#endif
#define P3_BODY \
    if (IN(3)) { \
        unsigned* kvcnt = (unsigned*)(ws + WS_CTL) + 8192; \
        if (G >= 128) { \
            if (bx < 64) { for (int rep = 0; rep < REP_SCAN; ++rep) scan_bh(a, lds, bx, rep == 0); } \
            else { const int c = bx - 64, GG = G - 64; \
                if (c < 32) { \
                    pg8::OneUnit S1; \
                    if (c < 16) { S1.u.pm = c >> 1; S1.u.pn = c & 1; pg8::Gemm g{(const bf16_t*)(ws + WS_MEMN), (const bf16_t*)(ws + WS_WKV), 1024, 1024, 1024}; pg8::EpiPlain E{(bf16_t*)(ws + WS_KMEM), 512}; pg8::gemm_phase(lds, g, S1, E); } \
                    else { S1.u.pm = (c - 16) >> 3; S1.u.pn = (c - 16) & 7; pg8::Gemm g{(const bf16_t*)(ws + WS_WKV) + (size_t)512 * 1024, (const bf16_t*)(ws + WS_MEMN), 1024, 1024, 1024}; pg8::EpiPlain E{(bf16_t*)(ws + WS_VMEMT), 2048}; pg8::gemm_phase(lds, g, S1, E); } \
                    asm volatile("s_waitcnt vmcnt(0)" ::: "memory"); __syncthreads(); \
                    if (tid == 0) { __builtin_amdgcn_fence(__ATOMIC_RELEASE, "agent"); asm volatile("s_waitcnt vmcnt(0)" ::: "memory"); __hip_atomic_fetch_add(kvcnt, 1u, __ATOMIC_RELAXED, __HIP_MEMORY_SCOPE_AGENT); } \
                } \
                bool kv_ok = false; \
                for (int it = c; it < 1024 * REP_POOL + 512 * REP_ATTN; it += GG) { \
                    if (it < 1024 * REP_POOL) pool_item(a, lds, it & 1023); \
                    else { \
                        if (!kv_ok) { if (tid == 0) { unsigned sp = 0; while (__hip_atomic_load(kvcnt, __ATOMIC_RELAXED, __HIP_MEMORY_SCOPE_AGENT) < 32u) { __builtin_amdgcn_s_sleep(2); if (++sp > (1u << 20)) break; } \
                                __builtin_amdgcn_fence(__ATOMIC_ACQUIRE, "agent"); asm volatile("s_waitcnt vmcnt(0)" ::: "memory"); } __syncthreads(); kv_ok = true; } \
                        attn_item(a, lds, (it - 1024 * REP_POOL) & 511); } } \
                late_transposes(a, lds, c, GG); } \
        } else { \
            for (int it = bx; it < 32; it += G) { pg8::OneUnit S1; \
                    if (it < 16) { S1.u.pm = it >> 1; S1.u.pn = it & 1; pg8::Gemm g{(const bf16_t*)(ws + WS_MEMN), (const bf16_t*)(ws + WS_WKV), 1024, 1024, 1024}; pg8::EpiPlain E{(bf16_t*)(ws + WS_KMEM), 512}; pg8::gemm_phase(lds, g, S1, E); } \
                    else { S1.u.pm = (it - 16) >> 3; S1.u.pn = (it - 16) & 7; pg8::Gemm g{(const bf16_t*)(ws + WS_WKV) + (size_t)512 * 1024, (const bf16_t*)(ws + WS_MEMN), 1024, 1024, 1024}; pg8::EpiPlain E{(bf16_t*)(ws + WS_VMEMT), 2048}; pg8::gemm_phase(lds, g, S1, E); } } \
            xcd_barrier(xbar); \
            for (int it = bx; it < 64 + 512 + 1024; it += G) { if (it < 64) scan_bh(a, lds, it); else if (it < 576) attn_item(a, lds, it - 64); else pool_item(a, lds, it - 576); } \
            late_transposes(a, lds, bx, G); \
        } \
    }
#define P5_BODY \
    if (IN(5)) { \
        pg8::StaticOrder SO; SO.init(M, 1024, G, bx); \
        pg8::OneUnit S1; \
        if (SO.next(0, S1.u)) { \
            bf16_t* Y = (bf16_t*)(ws + WS_Y); const bf16_t* YC = (const bf16_t*)a.out; const bf16_t* GT = (const bf16_t*)(ws + WS_GATE); \
            {   pg8::Gemm g{YC, (const bf16_t*)(ws + WS_WP), 2048, 512, 512}; pg8::EpiProj<0> E{GT, Y}; pg8::gemm_phase(lds, g, S1, E); } \
            {   pg8::Gemm g{YC + 512, (const bf16_t*)(ws + WS_WD), 2048, 1024, 1024}; pg8::EpiProj<1> E{GT, Y}; pg8::gemm_phase(lds, g, S1, E); } \
            {   pg8::Gemm g{YC + 1536, (const bf16_t*)(ws + WS_WM), 2048, 512, 512}; pg8::EpiProj<2> E{GT, Y}; pg8::gemm_phase(lds, g, S1, E); } \
        } \
    }
__global__ void __launch_bounds__(512, 2) hybrid_fwd(Args a) {
    extern __shared__ __attribute__((aligned(16))) unsigned char lds_raw[];
    LAS unsigned char* lds = (LAS unsigned char*)lds_raw;
    const int G = gridDim.x, bx = blockIdx.x, tid = threadIdx.x;
    unsigned char* ws = a.ws;
    const int lo = a.ph_lo, hi = a.ph_hi;
    volatile LAS unsigned* xst = (volatile LAS unsigned*)(lds + LDS_BYTES - 16);
    if (tid < 4) xst[tid] = 0u;
    __syncthreads();
    XcdBarrier xbar; xbar.bar = (unsigned*)(ws + WS_CTL); xbar.x = 0; xbar.st = xst;
    if (hi - lo > 1) xbar = xcd_barrier_post((unsigned*)(ws + WS_CTL), xst);
    if (lo == 0x7fffffff) cg::this_grid().sync();
#define IN(k) (lo <= (k) && (k) < hi)
#define SEAM(k) do { if (IN(k) && IN((k) + 1)) xcd_barrier(xbar); } while (0)
    P0_BODY
#if REP_P0 > 1
    xcd_barrier(xbar);
    P0_BODY
#endif
    SEAM(0);
#ifndef REP_P12
#define REP_P12 1
#endif
    for (int rep12 = 0; rep12 < REP_P12; ++rep12) {
    if (rep12) xcd_barrier(xbar);
    P1_BODY
#if REP_P1 > 1
    xcd_barrier(xbar);
    P1_BODY
#endif
    SEAM(1);
#ifndef NO_P2
    if (IN(2)) { u32x4 raw[11]; float gpre = 0.f, bpre = 0.f; if (bx < 2048) { chunk_load_raw(a, bx, raw, tid); if (tid < 64) { const int n2 = bx & 31, h2 = (bx >> 5) & 7, b2 = bx >> 8; const int r2 = b2 * SEQ + 64 * n2; gpre = ((const float*)(ws + WS_G))[(size_t)(r2 + tid) * 8 + h2]; bpre = ((const float*)(ws + WS_BETA))[(size_t)(r2 + tid) * 8 + h2]; } }
#pragma unroll 1
        for (int it0 = bx; it0 < 2048; it0 += 2 * G) {
            const int it1 = it0 + G; const int nvalid = (it1 < 2048) ? 2 : 1;
#pragma unroll 1
            for (int ms = 0; ms < 5; ++ms) {
                const int st = (ms < 2) ? 0 : (ms == 2 ? 1 : 2); const int st_set = (ms == 1 || ms == 4) ? 1 : 0;
                if (st != 1 && st_set == 1 && nvalid < 2) continue;
                const int itc = st_set ? it1 : it0;
                chunk_prep_item(a, lds, itc, raw, (itc + G < 2048) ? itc + G : -1, gpre, bpre, st_set, st, nvalid);
            }
        } }
#endif
    }
    SEAM(2);
    P3_BODY
#if REP_P3 > 1
    xcd_barrier(xbar);
    P3_BODY
#endif
    SEAM(3);
    if (IN(4)) {
        {   pg8::Gemm g{(const bf16_t*)(ws + WS_H), (const bf16_t*)(ws + WS_WT) + (size_t)4096 * 1024, 1024, 1024, 1024}; pg8::StaticOrder S; S.init(M, 2048, G, bx);
            pg8::EpiZ E{(bf16_t*)a.out, (const float*)(ws + WS_SUMSQ)}; pg8::gemm_phase(lds, g, S, E); }
        {   pg8::Gemm g{(const bf16_t*)(ws + WS_H), (const bf16_t*)(ws + WS_WT) + (size_t)6144 * 1024, 1024, 1024, 1024}; pg8::StaticOrder S; S.init(M, 3072, G, bx);
            pg8::EpiGate E{(bf16_t*)(ws + WS_GATE)}; pg8::gemm_phase(lds, g, S, E); }
    }
    SEAM(4);
    P5_BODY
#if REP_P5 > 1
    xcd_barrier(xbar);
    P5_BODY
#endif
    SEAM(5);
    if (IN(6)) {
        pg8::Gemm g{(const bf16_t*)(ws + WS_Y), (const bf16_t*)(ws + WS_WOUT), 1024, 1024, 1024}; pg8::StaticOrder S; S.init(M, 1024, G, bx);
        pg8::EpiOutNorm E{a.out, a.x, a.post_w, (float*)(ws + WS_ROWSS), (unsigned*)(ws + WS_CTL) + 4096};
        pg8::gemm_phase(lds, g, S, E);
    }
#undef IN
#undef SEAM
}

extern "C" void kernel_launch(void* const* d_in, const int* in_sizes, int n_in, void* d_out, int out_size, void* d_ws, size_t ws_size, hipStream_t stream) {
    static int grid = 0;
    if (grid == 0) {
        if (n_in != 17 || out_size != M * DM || ws_size < WS_END) { fprintf(stderr, "kernel_launch: unexpected shapes (n_in %d out %d ws %zu)\n", n_in, out_size, ws_size); grid = -1; return; }
        int dev = 0, cus = 0, per_cu = 0;
        hipGetDevice(&dev); hipDeviceGetAttribute(&cus, hipDeviceAttributeMultiprocessorCount, dev);
        if (hipFuncSetAttribute((const void*)hybrid_fwd, hipFuncAttributeMaxDynamicSharedMemorySize, LDS_BYTES) != hipSuccess) { fprintf(stderr, "kernel_launch: hipFuncSetAttribute failed\n"); grid = -1; return; }
        if (hipOccupancyMaxActiveBlocksPerMultiprocessor(&per_cu, (const void*)hybrid_fwd, 512, LDS_BYTES) != hipSuccess || per_cu < 1) { fprintf(stderr, "kernel_launch: occupancy query gives %d\n", per_cu); per_cu = 1; }
        (void)hipGetLastError();
        grid = cus * 1;
        if (grid > 256) grid = 256;
    }
    if (grid < 0) return;
    Args a{};
    a.x = (const float*)d_in[0]; a.mem = (const float*)d_in[1]; a.pre_w = (const float*)d_in[2]; a.mem_w = (const float*)d_in[3]; a.w_in = (const float*)d_in[4];
    a.conv_w = (const float*)d_in[5]; a.a_log = (const float*)d_in[6]; a.dt_bias = (const float*)d_in[7]; a.dn_w = (const float*)d_in[8]; a.mix_w = (const float*)d_in[9];
    a.pool_scale = (const float*)d_in[10]; a.w_kv = (const float*)d_in[11]; a.w_pp = (const float*)d_in[12]; a.w_pd = (const float*)d_in[13]; a.w_pm = (const float*)d_in[14];
    a.w_out = (const float*)d_in[15]; a.post_w = (const float*)d_in[16];
    a.out = (float*)d_out; a.ws = (unsigned char*)d_ws;
#if MK_PER_PHASE
    for (int p = 0; p < 7; ++p) { a.ph_lo = p; a.ph_hi = p + 1; hipLaunchKernelGGL(hybrid_fwd, dim3(grid), dim3(512), LDS_BYTES, stream, a); }
#else
    a.ph_lo = 0; a.ph_hi = 7;
    if (hipMemsetAsync((char*)d_ws + WS_CTL, 0, 65536, stream) != hipSuccess) { fprintf(stderr, "kernel_launch: memset of the barrier words failed\n"); return; }
    void* args[] = {&a};
    hipError_t e = hipLaunchCooperativeKernel((const void*)hybrid_fwd, dim3(grid), dim3(512), args, LDS_BYTES, stream);
    if (e != hipSuccess) fprintf(stderr, "kernel_launch: cooperative launch failed: %s (grid %d)\n", hipGetErrorString(e), grid);
#endif
}
```
